# Optimizing an MI355X kernel written in HIP

```python
import math
import jax, jax.numpy as jnp
from jax import lax
import numpy as np

D_MODEL = 1024
BATCH = 8
SEQ = 2048
DEPTH = 2

GRID_W = 64
CTX_LEN = 256
S5_WIDTH = 512
S5_GROUP = 16
S5_GROUPS = S5_WIDTH // S5_GROUP
S5_STATE = 64
RET_HEADS = 4
RET_DK = 64
RET_DV = 128
RET_QK_WIDTH = RET_HEADS * RET_DK
RET_WIDTH = RET_HEADS * RET_DV
RET_CHUNK = 128
NA_HEADS = 8
NA_HEAD_DIM = 64
NA_WIDTH = NA_HEADS * NA_HEAD_DIM
NA_ROWS = 8
NA_COLS = 16
N_BRANCH = 3
FFN_HIDDEN = ((8 * D_MODEL + 3 * 256 - 1) // (3 * 256)) * 256
ROPE_BASE = 10000.0
RMS_EPS = 1e-6
GN_EPS = 1e-5
IN_SPLIT = (S5_WIDTH, RET_QK_WIDTH, RET_WIDTH, NA_WIDTH, NA_WIDTH,
            RET_QK_WIDTH, RET_WIDTH, NA_WIDTH, N_BRANCH * D_MODEL)
N_CTX_KV = 5
N_IN = sum(IN_SPLIT)

kernel_name = 'hybrid_s5_retention_natten_dit_block'


def rms_norm(x):
    xf = x.astype(jnp.float32)
    return (xf * lax.rsqrt(jnp.mean(xf * xf, axis=-1, keepdims=True) + RMS_EPS)).astype(x.dtype)


def split_cols(t, sizes):
    return jnp.split(t, np.cumsum(sizes)[:-1].tolist(), axis=-1)


def heads(t, n):
    return t.reshape(t.shape[:-1] + (n, t.shape[-1] // n))


def seq_order(t, reverse):
    return jnp.flip(t, axis=1) if reverse else t


def axial_rotary(t):
    L, d = t.shape[1], t.shape[-1]
    half, quarter = d // 2, d // 4
    pos = jnp.arange(L)
    inv_freq = ROPE_BASE ** (-jnp.arange(quarter, dtype=jnp.float32) / quarter)

    def rotate(part, coord):
        ang = coord.astype(jnp.float32)[:, None] * inv_freq[None, :]
        cos = jnp.cos(ang)[None, :, None, :].astype(t.dtype)
        sin = jnp.sin(ang)[None, :, None, :].astype(t.dtype)
        a, b = part[..., :quarter], part[..., quarter:]
        return jnp.concatenate([a * cos - b * sin, a * sin + b * cos], axis=-1)

    return jnp.concatenate([rotate(t[..., :half], pos // GRID_W),
                            rotate(t[..., half:], pos % GRID_W)], axis=-1)


def _ssm_combine(e1, e2):
    a1r, a1i, b1r, b1i = e1
    a2r, a2i, b2r, b2i = e2
    return (a1r * a2r - a1i * a2i, a1r * a2i + a1i * a2r,
            a2r * b1r - a2i * b1i + b2r, a2r * b1i + a2i * b1r + b2i)


def s5_discretize(lam_re, lam_im, log_dt, b_re, b_im):
    f32 = jnp.float32
    lam_re, lam_im = lam_re.astype(f32), lam_im.astype(f32)
    dt = jnp.exp(log_dt.astype(f32))[:, None]
    mag, ang = jnp.exp(lam_re * dt), lam_im * dt
    ab_re, ab_im = mag * jnp.cos(ang), mag * jnp.sin(ang)
    den = lam_re * lam_re + lam_im * lam_im
    f_re = ((ab_re - 1.0) * lam_re + ab_im * lam_im) / den
    f_im = (ab_im * lam_re - (ab_re - 1.0) * lam_im) / den
    b_re, b_im = b_re.astype(f32), b_im.astype(f32)
    bb_re = f_re[..., None] * b_re - f_im[..., None] * b_im
    bb_im = f_re[..., None] * b_im + f_im[..., None] * b_re
    return ab_re, ab_im, bb_re, bb_im


def s5_states(u, disc, x0):
    ab_re, ab_im, bb_re, bb_im = disc
    u = u.astype(jnp.float32)
    bu_re = jnp.einsum('blgh,gph->blgp', u, bb_re)
    bu_im = jnp.einsum('blgh,gph->blgp', u, bb_im)
    shape = (1, u.shape[1]) + ab_re.shape
    a_re, a_im, x_re, x_im = lax.associative_scan(
        _ssm_combine, (jnp.broadcast_to(ab_re, shape), jnp.broadcast_to(ab_im, shape), bu_re, bu_im), axis=1)
    if x0 is not None:
        x0_re, x0_im = x0[0][:, None], x0[1][:, None]
        x_re, x_im = x_re + a_re * x0_re - a_im * x0_im, x_im + a_re * x0_im + a_im * x0_re
    return x_re, x_im


def s5_readout(x_re, x_im, c_re, c_im):
    f32 = jnp.float32
    return (jnp.einsum('ghp,blgp->blgh', c_re.astype(f32), x_re)
            - jnp.einsum('ghp,blgp->blgh', c_im.astype(f32), x_im))


def s5_glu(y, w_glu, b_glu):
    g = jax.nn.gelu(y)
    return g * jax.nn.sigmoid(g @ w_glu + b_glu)


def s5_mixer(u_lat, u_ctx, lam_re, lam_im, log_dt, b_re, b_im, c_re, c_im, d_skip, w_glu, b_glu, need_ctx):
    bsz, L, _ = u_lat.shape
    n_ctx = u_ctx.shape[1]
    ul = u_lat.reshape(bsz, L, S5_GROUPS, S5_GROUP)
    uc = u_ctx.reshape(bsz, n_ctx, S5_GROUPS, S5_GROUP)
    d32 = d_skip.astype(jnp.float32)
    y_lat = d32 * u_lat.astype(jnp.float32)
    y_ctx = d32 * u_ctx.astype(jnp.float32) if need_ctx else None
    for dirn in range(2):
        rev = dirn == 1
        disc = s5_discretize(lam_re[dirn], lam_im[dirn], log_dt[dirn], b_re[dirn], b_im[dirn])
        xc_re, xc_im = s5_states(seq_order(uc, rev), disc, None)
        xl_re, xl_im = s5_states(seq_order(ul, rev), disc, (xc_re[:, -1], xc_im[:, -1]))
        y_lat = y_lat + seq_order(s5_readout(xl_re, xl_im, c_re[dirn], c_im[dirn]), rev).reshape(bsz, L, S5_WIDTH)
        if need_ctx:
            y_ctx = y_ctx + seq_order(s5_readout(xc_re, xc_im, c_re[dirn], c_im[dirn]), rev).reshape(bsz, n_ctx, S5_WIDTH)
    out_lat = s5_glu(y_lat.astype(u_lat.dtype), w_glu, b_glu)
    out_ctx = s5_glu(y_ctx.astype(u_ctx.dtype), w_glu, b_glu) if need_ctx else None
    return out_lat, out_ctx


def retention_chunkwise(q, k, v, log_gamma, s0, strict):
    bsz, L, H, dk = q.shape
    dv = v.shape[-1]
    cs = RET_CHUNK
    n = L // cs
    qc = q.reshape(bsz, n, cs, H, dk)
    kc = k.reshape(bsz, n, cs, H, dk)
    vc = v.reshape(bsz, n, cs, H, dv)
    idx = jnp.arange(cs, dtype=jnp.float32)
    diff = idx[:, None] - idx[None, :]
    mask = diff > 0 if strict else diff >= 0
    intra = jnp.where(mask[None], jnp.exp(jnp.where(mask, diff, 0.0)[None] * log_gamma[:, None, None]), 0.0)
    scores = jnp.einsum('bcihd,bcjhd->bchij', qc, kc) * intra
    o = jnp.einsum('bchij,bcjhe->bcihe', scores, vc)
    k_dec = kc * jnp.exp((cs - 1 - idx)[:, None] * log_gamma[None, :])[:, :, None]
    kv = jnp.einsum('bcjhd,bcjhe->bchde', k_dec, vc)
    chunk_decay = jnp.exp(cs * log_gamma)[:, None, None]

    def step(s, kv_c):
        return chunk_decay * s + kv_c, s

    s_final, s_in = lax.scan(step, s0, jnp.moveaxis(kv, 1, 0))
    q_dec = qc * jnp.exp((idx + 1.0)[:, None] * log_gamma[None, :])[:, :, None]
    o = o + jnp.einsum('bcihd,cbhde->bcihe', q_dec, s_in)
    return o.reshape(bsz, L, H, dv), s_final


def retention_final_state(k, v, log_gamma):
    L = k.shape[1]
    w = jnp.exp((L - 1 - jnp.arange(L, dtype=jnp.float32))[:, None] * log_gamma[None, :])
    return jnp.einsum('blhd,blhe->bhde', k * w[:, :, None], v)


def head_norm(o):
    mu = jnp.mean(o, axis=-1, keepdims=True)
    var = jnp.mean(jnp.square(o - mu), axis=-1, keepdims=True)
    return (o - mu) * lax.rsqrt(var + GN_EPS)


def retention_mixer(q, k, v, g, q_c, k_c, v_c, g_c, theta, need_ctx):
    f32 = jnp.float32
    scale = RET_DK ** -0.5
    q = axial_rotary(q).astype(f32)
    k = (axial_rotary(k) * scale).astype(f32)
    v = v.astype(f32)
    k_c = (k_c * scale).astype(f32)
    v_c = v_c.astype(f32)
    log_gamma = jax.nn.log_sigmoid(theta.astype(f32))
    bsz = q.shape[0]
    o_lat, o_ctx = [], []
    for dirn in range(2):
        rev = dirn == 1
        lg = log_gamma[dirn]
        if need_ctx:
            s0 = jnp.zeros((bsz, RET_HEADS, RET_DK, RET_DV), f32)
            oc, s_ctx = retention_chunkwise(seq_order(q_c.astype(f32), rev), seq_order(k_c, rev),
                                            seq_order(v_c, rev), lg, s0, rev)
            o_ctx.append(seq_order(oc, rev))
        else:
            s_ctx = retention_final_state(seq_order(k_c, rev), seq_order(v_c, rev), lg)
        ol, _ = retention_chunkwise(seq_order(q, rev), seq_order(k, rev), seq_order(v, rev), lg, s_ctx, rev)
        o_lat.append(seq_order(ol, rev))
    y_lat = jax.nn.silu(g) * head_norm(o_lat[0] + o_lat[1]).reshape(g.shape).astype(g.dtype)
    y_ctx = (jax.nn.silu(g_c) * head_norm(o_ctx[0] + o_ctx[1]).reshape(g_c.shape).astype(g_c.dtype)
             if need_ctx else None)
    return y_lat, y_ctx


def neighborhood_attention(q, k, v, k_c, v_c, rpb):
    f32 = jnp.float32
    bsz, L, H, d = q.shape
    rows = L // GRID_W
    wr = min(NA_ROWS, rows)
    n_win = wr * NA_COLS
    qg = (q * d ** -0.5).reshape(bsz, rows, GRID_W, H, d)
    kg = k.reshape(bsz, rows, GRID_W, H, d)
    vg = v.reshape(bsz, rows, GRID_W, H, d)
    row_start = jnp.clip(jnp.arange(rows) - wr // 2, 0, rows - wr)
    cols = jnp.arange(GRID_W)
    col_idx = jnp.clip(cols - NA_COLS // 2, 0, GRID_W - NA_COLS)[:, None] + jnp.arange(NA_COLS)[None, :]
    col_bias_idx = col_idx - cols[:, None] + NA_COLS - 1
    rpb32 = rpb.astype(f32)

    def row_block(args):
        q_r, r = args
        rs = row_start[r]
        k_win = lax.dynamic_slice_in_dim(kg, rs, wr, axis=1)[:, :, col_idx]
        v_win = lax.dynamic_slice_in_dim(vg, rs, wr, axis=1)[:, :, col_idx]
        row_bias_idx = rs + jnp.arange(wr) - r + NA_ROWS - 1
        bias = rpb32[:, row_bias_idx[:, None, None], col_bias_idx[None]]
        s_win = jnp.einsum('bqhd,brqchd->bhqrc', q_r, k_win).astype(f32) + jnp.transpose(bias, (0, 2, 1, 3))[None]
        s_ctx = jnp.einsum('bqhd,bkhd->bhqk', q_r, k_c).astype(f32)
        s = jnp.concatenate([s_win.reshape(bsz, H, GRID_W, n_win), s_ctx], axis=-1)
        p = jax.nn.softmax(s, axis=-1).astype(v.dtype)
        p_win = p[..., :n_win].reshape(bsz, H, GRID_W, wr, NA_COLS)
        return (jnp.einsum('bhqrc,brqchd->bqhd', p_win, v_win)
                + jnp.einsum('bhqk,bkhd->bqhd', p[..., n_win:], v_c))

    out = lax.map(row_block, (jnp.moveaxis(qg, 1, 0), jnp.arange(rows)))
    return jnp.moveaxis(out, 0, 1).reshape(bsz, L, H * d)


def context_attention(q, k, v):
    bsz, n, H, d = q.shape
    s = jnp.einsum('bqhd,bkhd->bhqk', q * d ** -0.5, k).astype(jnp.float32)
    p = jax.nn.softmax(s, axis=-1).astype(v.dtype)
    return jnp.einsum('bhqk,bkhd->bqhd', p, v).reshape(bsz, n, H * d)


def merge_branches(y_s5, y_ret, y_na, gates, w_bs5, w_bret, w_bna, w_out):
    g_s5, g_ret, g_na = jnp.split(jax.nn.sigmoid(gates), N_BRANCH, axis=-1)
    m = g_s5 * (y_s5 @ w_bs5) + g_ret * (y_ret @ w_bret) + g_na * (y_na @ w_bna)
    return m @ w_out


def swiglu(h, w_gate, w_up, w_down):
    return (jax.nn.silu(h @ w_gate) * (h @ w_up)) @ w_down


def setup_inputs(seed: int = 0) -> dict:
    key = jax.random.key(seed)
    ks = iter(jax.random.split(key, 32))
    f32 = jnp.float32

    def normal(shape, std):
        return jax.random.normal(next(ks), shape, f32) * std

    G, P, HG = S5_GROUPS, S5_STATE, S5_GROUP
    ret_init = jnp.log(2.0 ** (5.0 + jnp.arange(RET_HEADS, dtype=f32)) - 1.0)
    return {
        'x': normal((BATCH, SEQ, D_MODEL), 1.0),
        'c': normal((BATCH, D_MODEL), 1.0),
        'ctx': normal((BATCH, CTX_LEN, D_MODEL), 1.0),
        'c_ctx': normal((D_MODEL,), 1.0),
        'w_ada': normal((DEPTH, D_MODEL, 6 * D_MODEL), 0.5 * D_MODEL ** -0.5),
        'b_ada': normal((DEPTH, 6 * D_MODEL), 0.01),
        'w_in': normal((DEPTH, D_MODEL, N_IN), D_MODEL ** -0.5),
        's5_lam_re': -0.5 + normal((DEPTH, 2, G, P), 0.01),
        's5_lam_im': jnp.pi * jnp.arange(P, dtype=f32) + normal((DEPTH, 2, G, P), 0.01),
        's5_log_dt': jax.random.uniform(next(ks), (DEPTH, 2, G), f32, math.log(1e-3), math.log(1e-1)),
        's5_b_re': normal((DEPTH, 2, G, P, HG), (2.0 * HG) ** -0.5),
        's5_b_im': normal((DEPTH, 2, G, P, HG), (2.0 * HG) ** -0.5),
        's5_c_re': normal((DEPTH, 2, G, HG, P), (2.0 * P) ** -0.5),
        's5_c_im': normal((DEPTH, 2, G, HG, P), (2.0 * P) ** -0.5),
        's5_d': normal((DEPTH, S5_WIDTH), 1.0),
        's5_w_glu': normal((DEPTH, S5_WIDTH, S5_WIDTH), S5_WIDTH ** -0.5),
        's5_b_glu': normal((DEPTH, S5_WIDTH), 0.01),
        'ret_theta': ret_init + normal((DEPTH, 2, RET_HEADS), 0.01),
        'na_rpb': normal((DEPTH, NA_HEADS, 2 * NA_ROWS - 1, 2 * NA_COLS - 1), 0.02),
        'w_branch_s5': normal((DEPTH, S5_WIDTH, D_MODEL), S5_WIDTH ** -0.5),
        'w_branch_ret': normal((DEPTH, RET_WIDTH, D_MODEL), RET_WIDTH ** -0.5),
        'w_branch_na': normal((DEPTH, NA_WIDTH, D_MODEL), NA_WIDTH ** -0.5),
        'w_out': normal((DEPTH, D_MODEL, D_MODEL), D_MODEL ** -0.5),
        'w_ffn_gate': normal((DEPTH, D_MODEL, FFN_HIDDEN), D_MODEL ** -0.5),
        'w_ffn_up': normal((DEPTH, D_MODEL, FFN_HIDDEN), D_MODEL ** -0.5),
        'w_ffn_down': normal((DEPTH, FFN_HIDDEN, D_MODEL), FFN_HIDDEN ** -0.5),
        'final_norm': 1.0 + normal((D_MODEL,), 0.01),
    }


def reference(x, c, ctx, c_ctx, w_ada, b_ada, w_in, s5_lam_re, s5_lam_im, s5_log_dt, s5_b_re, s5_b_im,
              s5_c_re, s5_c_im, s5_d, s5_w_glu, s5_b_glu, ret_theta, na_rpb, w_branch_s5, w_branch_ret,
              w_branch_na, w_out, w_ffn_gate, w_ffn_up, w_ffn_down, final_norm):
    silu_c = jax.nn.silu(c)
    silu_cc = jax.nn.silu(c_ctx)
    for l in range(DEPTH):
        need_ctx = l < DEPTH - 1
        mod = (silu_c @ w_ada[l] + b_ada[l])[:, None, :]
        mod_c = silu_cc @ w_ada[l] + b_ada[l]
        sh1, sc1, g1, sh2, sc2, g2 = jnp.split(mod, 6, axis=-1)
        csh1, csc1, cg1, csh2, csc2, cg2 = jnp.split(mod_c, 6, axis=-1)

        h = rms_norm(x) * (1.0 + sc1) + sh1
        hc = rms_norm(ctx) * (1.0 + csc1) + csh1
        u, rk, rv, nk, nv, rq, rg, nq, gates = split_cols(h @ w_in[l], IN_SPLIT)
        n_pieces = len(IN_SPLIT) if need_ctx else N_CTX_KV
        ctx_cols = sum(IN_SPLIT[:n_pieces])
        cp = split_cols(hc @ w_in[l][:, :ctx_cols], IN_SPLIT[:n_pieces])
        cu, crk, crv, cnk, cnv = cp[:N_CTX_KV]
        crq, crg, cnq, cgates = cp[N_CTX_KV:] if need_ctx else (None, None, None, None)

        y_s5, y_s5_c = s5_mixer(u, cu, s5_lam_re[l], s5_lam_im[l], s5_log_dt[l], s5_b_re[l], s5_b_im[l],
                                s5_c_re[l], s5_c_im[l], s5_d[l], s5_w_glu[l], s5_b_glu[l], need_ctx)
        y_ret, y_ret_c = retention_mixer(
            heads(rq, RET_HEADS), heads(rk, RET_HEADS), heads(rv, RET_HEADS), rg,
            heads(crq, RET_HEADS) if need_ctx else None, heads(crk, RET_HEADS), heads(crv, RET_HEADS),
            crg, ret_theta[l], need_ctx)
        k_na_c, v_na_c = heads(cnk, NA_HEADS), heads(cnv, NA_HEADS)
        y_na = neighborhood_attention(heads(nq, NA_HEADS), heads(nk, NA_HEADS), heads(nv, NA_HEADS),
                                      k_na_c, v_na_c, na_rpb[l])
        x = x + g1 * merge_branches(y_s5, y_ret, y_na, gates, w_branch_s5[l], w_branch_ret[l],
                                    w_branch_na[l], w_out[l])
        if need_ctx:
            y_na_c = context_attention(heads(cnq, NA_HEADS), k_na_c, v_na_c)
            ctx = ctx + cg1 * merge_branches(y_s5_c, y_ret_c, y_na_c, cgates, w_branch_s5[l],
                                             w_branch_ret[l], w_branch_na[l], w_out[l])

        x = x + g2 * swiglu(rms_norm(x) * (1.0 + sc2) + sh2, w_ffn_gate[l], w_ffn_up[l], w_ffn_down[l])
        if need_ctx:
            ctx = ctx + cg2 * swiglu(rms_norm(ctx) * (1.0 + csc2) + csh2, w_ffn_gate[l], w_ffn_up[l],
                                     w_ffn_down[l])
    return rms_norm(x) * final_norm
```

```cpp
#include <hip/hip_runtime.h>
#include <hip/hip_cooperative_groups.h>
#include <cstdio>
#include <cstdint>
namespace cg = cooperative_groups;

typedef unsigned short bf16_t;
using bf16x8 = __attribute__((ext_vector_type(8))) short;
using f32x4 = __attribute__((ext_vector_type(4))) float;

#ifndef PROBE
#define PROBE 0
#endif
#define REPS(n) ((PROBE == (n)) ? (1 + (int)(p.fnorm != nullptr)) : 1)
#define REPS61 ((PROBE == 6 || PROBE == 61) ? (1 + (int)(p.fnorm != nullptr)) : 1)
#define REPS62 ((PROBE == 6 || PROBE == 62) ? (1 + (int)(p.fnorm != nullptr)) : 1)
#define REPS63 ((PROBE == 6 || PROBE == 63) ? (1 + (int)(p.fnorm != nullptr)) : 1)
#define MFMA16(a, b, c) __builtin_amdgcn_mfma_f32_16x16x32_bf16((a), (b), (c), 0, 0, 0)

constexpr int NB = 8, SEQ = 2048, CTXL = 256;
constexpr int R_CTX = NB * CTXL;
constexpr int R_ALL = R_CTX + NB * SEQ;
constexpr int N_IN = 6656, FFN = 2816;
constexpr int PJ = 2560;
constexpr int PC_U = 0, PC_RK = 512, PC_NK = 768, PC_RQ = 1280, PC_RG = 1536, PC_NQ = 2048;

constexpr size_t OFF_CTXS = 0;
constexpr size_t OFF_MOD = 8388608;
constexpr size_t OFF_ROT = OFF_MOD + 442368;
constexpr size_t OFF_CNT = OFF_ROT + 8192;
constexpr size_t OFF_BAR = OFF_CNT + 256;
constexpr size_t OFF_S5BB = OFF_BAR + 16384;
constexpr size_t OFF_S5CM = OFF_S5BB + 524288;
constexpr size_t OFF_S5AB = OFF_S5CM + 524288;
constexpr size_t OFF_S5AT = OFF_S5AB + 65536;
constexpr size_t OFF_W = OFF_S5AT + 65536;
constexpr size_t OFF_H = OFF_W + 36700160;
constexpr size_t OFF_G = OFF_H + 37748736;
constexpr size_t OFF_PROJ = OFF_G + 18874368;
constexpr size_t OFF_VT = OFF_PROJ + 94371840;
constexpr size_t OFF_UT = OFF_VT + 37748736;
constexpr size_t OFF_S5V = OFF_UT + 18874368;
constexpr size_t WS_END = OFF_S5V + 4194304;

constexpr int W_IN = 0, W_GLU = 6815744, W_BS5 = 7077888, W_BRET = 7602176, W_BNA = 8126464,
              W_OUT = 8650752, W_FG = 9699328, W_FU = 12582912, W_FD = 15466496;

constexpr int SMEM_BYTES = 73728;

struct Params {
  const float *x, *c, *ctx, *c_ctx, *w_ada, *b_ada, *w_in, *lam_re, *lam_im, *log_dt, *b_re, *b_im,
      *c_re, *c_im, *s5_d, *w_glu, *b_glu, *theta, *rpb, *w_bs5, *w_bret, *w_bna, *w_out, *w_fg,
      *w_fu, *w_fd, *fnorm;
  float* out;
  unsigned char* ws;
};

__device__ __forceinline__ bf16_t f2bf(float f) {
  unsigned u = __float_as_uint(f);
  u += 0x7fffu + ((u >> 16) & 1u);
  return (bf16_t)(u >> 16);
}
__device__ __forceinline__ float bf2f(bf16_t h) { return __uint_as_float(((unsigned)h) << 16); }
__device__ __forceinline__ float sigm(float x) { return __builtin_amdgcn_rcpf(1.f + __expf(-x)); }
__device__ __forceinline__ float siluf_(float x) { return x * sigm(x); }
typedef __bf16 bf16x2_t __attribute__((ext_vector_type(2)));
typedef float f32x2_t __attribute__((ext_vector_type(2)));
__device__ __forceinline__ unsigned pack2(float a, float b) {
  f32x2_t v = {a, b};
  bf16x2_t r = __builtin_convertvector(v, bf16x2_t);
  return __builtin_bit_cast(unsigned, r);
}
__device__ __forceinline__ bf16x8 pack8(const float (&v)[8]) {
  union { unsigned u[4]; bf16x8 h; } x;
  x.u[0] = pack2(v[0], v[1]);
  x.u[1] = pack2(v[2], v[3]);
  x.u[2] = pack2(v[4], v[5]);
  x.u[3] = pack2(v[6], v[7]);
  return x.h;
}

__device__ __forceinline__ int opaque_tid() {
  int x = threadIdx.x;
  asm volatile("" : "+v"(x));
  return x;
}
#define TIDVARS                                                                          \
  const int tid = opaque_tid(), lane = tid & 63, w = tid >> 6, wm = w >> 1, wn = w & 1; \
  const int l15 = lane & 15, quad = lane >> 4;                                           \
  (void)wm; (void)wn; (void)l15; (void)quad; (void)lane; (void)w;

#define XB_TMO      128
#define XB_XCNT(j)  (256  + 64 * (j))
#define XB_XSUB(j)  (1280 + 64 * (j))
#define XB_XGEN(j)  (2304 + 64 * (j))
#define XB_TOP      3328
#define XB_TOPGEN   3392
#define XCD_BAR_WORDS 3456
#define XB_SPIN_CAP (1u << 22)
#define LAS __attribute__((address_space(3)))

__device__ __forceinline__ unsigned xb_ld(unsigned* p) { return __hip_atomic_load(p, __ATOMIC_RELAXED, __HIP_MEMORY_SCOPE_AGENT); }
__device__ __forceinline__ unsigned xb_add(unsigned* p, unsigned v) { return __hip_atomic_fetch_add(p, v, __ATOMIC_RELAXED, __HIP_MEMORY_SCOPE_AGENT); }
__device__ __forceinline__ unsigned xb_xcc_id() { return (unsigned)__builtin_amdgcn_s_getreg((3 << 11) | 20) & 0xFu; }
#define XB_SPIN(cond, bar) do { unsigned _sp = 0; while (cond) { __builtin_amdgcn_s_sleep(1); \
    if ((++_sp & 255u) == 0u) { if (xb_ld(&(bar)[XB_TMO])) break; if (_sp > XB_SPIN_CAP) { atomicAdd(&(bar)[XB_TMO], 1u); break; } } } } while (0)

struct XcdBarrier {
  unsigned* bar; unsigned x;
  volatile LAS unsigned* st;
};
__device__ __forceinline__ XcdBarrier xcd_barrier_post(unsigned* bar, volatile LAS unsigned* st) {
  XcdBarrier b; b.bar = bar; b.x = xb_xcc_id(); b.st = st;
  if (threadIdx.x == 0) (void)xb_add(&bar[XB_XCNT(b.x)], 1u);
  return b;
}
__device__ __forceinline__ void xcd_barrier_complete(unsigned* bar, unsigned x, unsigned& nloc, unsigned& nx) {
  const unsigned G = gridDim.x * gridDim.y * gridDim.z;
  unsigned sum, cnt_, mine, sp = 0u;
  for (;;) {
    sum = 0u; cnt_ = 0u; mine = 0u;
#pragma unroll
    for (unsigned j = 0; j < 16; ++j) { const unsigned c = xb_ld(&bar[XB_XCNT(j)]); sum += c; cnt_ += (c > 0u) ? 1u : 0u; mine = (j == x) ? c : mine; }
    if (sum == G) break;
    __builtin_amdgcn_s_sleep(1);
    if ((++sp & 255u) == 0u) { if (xb_ld(&bar[XB_TMO])) break; if (sp > XB_SPIN_CAP) { atomicAdd(&bar[XB_TMO], 1u); break; } }
  }
  nloc = mine > 0u ? mine : 1u; nx = cnt_ > 0u ? cnt_ : 1u;
}
__device__ __forceinline__ void xcd_barrier(const XcdBarrier& b) {
  asm volatile("s_waitcnt vmcnt(0)" ::: "memory");
  __syncthreads();
  if (threadIdx.x == 0) {
    unsigned* bar = b.bar;
    __builtin_amdgcn_s_waitcnt(0);
    unsigned nloc = b.st[0], nx = b.st[1];
    if (nloc == 0u) { xcd_barrier_complete(bar, b.x, nloc, nx); b.st[0] = nloc; b.st[1] = nx; }
    const unsigned old = xb_add(&bar[XB_XSUB(b.x)], 1u);
    const unsigned gen = old / nloc;
    if (old + 1u == (gen + 1u) * nloc) {
      __builtin_amdgcn_fence(__ATOMIC_RELEASE, "agent");
      asm volatile("s_waitcnt vmcnt(0)" ::: "memory");
      const unsigned og = xb_add(&bar[XB_TOP], 1u);
      const unsigned tg = og / nx;
      if (og + 1u == (tg + 1u) * nx) xb_add(&bar[XB_TOPGEN], 1u);
      else XB_SPIN(xb_ld(&bar[XB_TOPGEN]) == tg, bar);
      __builtin_amdgcn_fence(__ATOMIC_ACQUIRE, "agent");
      xb_add(&bar[XB_XGEN(b.x)], 1u);
      asm volatile("s_waitcnt vmcnt(0)" ::: "memory");
    } else {
      XB_SPIN(xb_ld(&bar[XB_XGEN(b.x)]) == gen, bar);
      __builtin_amdgcn_fence(__ATOMIC_ACQUIRE, "agent");
      asm volatile("s_waitcnt vmcnt(0)" ::: "memory");
    }
  }
  __syncthreads();
}

constexpr int GEMM_STG = 18432;
template <int NI, bool SWAP>
__device__ __forceinline__ void gemm_core(f32x4 (&acc)[4][NI], const bf16_t* __restrict__ A, int lda,
                                          const bf16_t* __restrict__ Bt, int ldb, int K, bf16_t* sm) {
  constexpr int LS = 72;
  TIDVARS
  const int lrow = tid >> 3, lcc = tid & 7;
  const bf16_t* ap = A + (size_t)lrow * lda + lcc * 8;
  const bf16_t* bp = Bt + (size_t)lrow * ldb + lcc * 8;
  const size_t as = (size_t)32 * lda, bs = (size_t)32 * ldb;
  const int nk = K >> 6;
  uint4 xa0, xa1, xa2, xa3, xb0, xb1, xb2, xb3, ya0, ya1, ya2, ya3, yb0, yb1, yb2, yb3;
#define G_ISSUE(P, kt)                                              \
  {                                                                 \
    const int k_ = (((kt) < nk) ? (kt) : nk - 1) << 6;              \
    P##a0 = *(const uint4*)(ap + k_);                               \
    P##a1 = *(const uint4*)(ap + as + k_);                          \
    P##a2 = *(const uint4*)(ap + 2 * as + k_);                      \
    P##a3 = *(const uint4*)(ap + 3 * as + k_);                      \
    P##b0 = *(const uint4*)(bp + k_);                               \
    P##b1 = *(const uint4*)(bp + bs + k_);                          \
    if (NI > 2) {                                                   \
      P##b2 = *(const uint4*)(bp + 2 * bs + k_);                    \
      P##b3 = *(const uint4*)(bp + 3 * bs + k_);                    \
    }                                                               \
  }
#define G_WRITE(P, stage)                                           \
  {                                                                 \
    bf16_t* d_ = sm + (stage) * GEMM_STG + lrow * LS + lcc * 8;     \
    *(uint4*)(d_) = P##a0;                                          \
    *(uint4*)(d_ + 32 * LS) = P##a1;                                \
    *(uint4*)(d_ + 64 * LS) = P##a2;                                \
    *(uint4*)(d_ + 96 * LS) = P##a3;                                \
    *(uint4*)(d_ + 128 * LS) = P##b0;                               \
    *(uint4*)(d_ + 160 * LS) = P##b1;                               \
    if (NI > 2) {                                                   \
      *(uint4*)(d_ + 192 * LS) = P##b2;                             \
      *(uint4*)(d_ + 224 * LS) = P##b3;                             \
    }                                                               \
  }
#define G_COMPUTE(stage)                                                                           \
  {                                                                                                \
    const bf16_t* sra_ = sm + (stage) * GEMM_STG + (wm * 64 + l15) * LS + quad * 8;                \
    const bf16_t* srb_ = sm + (stage) * GEMM_STG + (128 + wn * 16 * NI + l15) * LS + quad * 8;     \
    __builtin_amdgcn_s_setprio(1);                                                                 \
    _Pragma("unroll") for (int ks = 0; ks < 2; ++ks) {                                             \
      bf16x8 a_[4], b_[NI];                                                                        \
      _Pragma("unroll") for (int mi = 0; mi < 4; ++mi) a_[mi] = *(const bf16x8*)(sra_ + mi * 16 * LS + ks * 32); \
      _Pragma("unroll") for (int ni = 0; ni < NI; ++ni) b_[ni] = *(const bf16x8*)(srb_ + ni * 16 * LS + ks * 32); \
      _Pragma("unroll") for (int mi = 0; mi < 4; ++mi)                                             \
      _Pragma("unroll") for (int ni = 0; ni < NI; ++ni)                                            \
        acc[mi][ni] = SWAP ? MFMA16(b_[ni], a_[mi], acc[mi][ni]) : MFMA16(a_[mi], b_[ni], acc[mi][ni]); \
    }                                                                                              \
    __builtin_amdgcn_s_setprio(0);                                                                 \
  }
  G_ISSUE(x, 0)
  G_ISSUE(y, 1)
  __syncthreads();
  G_WRITE(x, 0)
  G_ISSUE(x, 2)
  __syncthreads();
#pragma unroll 1
  for (int kt = 0; kt < nk; kt += 2) {
    G_WRITE(y, 1)
    G_ISSUE(y, kt + 3)
    G_COMPUTE(0)
    __syncthreads();
    G_WRITE(x, 0)
    G_ISSUE(x, kt + 4)
    G_COMPUTE(1)
    __syncthreads();
  }
#undef G_ISSUE
#undef G_WRITE
#undef G_COMPUTE
}

template <bool SWAP>
__device__ __forceinline__ void gemm_core_big(f32x4 (&acc)[8][4], const bf16_t* __restrict__ A, int lda,
                                              const bf16_t* __restrict__ Bt, int ldb, int K, bf16_t* sm) {
  constexpr int LS = 80;
  TIDVARS
  const int lrow = tid >> 3, lcc = tid & 7;
  const bf16_t* ap = A + (size_t)lrow * lda + lcc * 8;
  const bf16_t* bp = Bt + (size_t)lrow * ldb + lcc * 8;
  const size_t as = (size_t)32 * lda, bs = (size_t)32 * ldb;
  uint4 ra0, ra1, ra2, ra3, ra4, ra5, ra6, ra7, rb0, rb1, rb2, rb3;
#define GB_ISSUE(k_)                              \
  ra0 = *(const uint4*)(ap + (k_));               \
  ra1 = *(const uint4*)(ap + as + (k_));          \
  ra2 = *(const uint4*)(ap + 2 * as + (k_));      \
  ra3 = *(const uint4*)(ap + 3 * as + (k_));      \
  ra4 = *(const uint4*)(ap + 4 * as + (k_));      \
  ra5 = *(const uint4*)(ap + 5 * as + (k_));      \
  ra6 = *(const uint4*)(ap + 6 * as + (k_));      \
  ra7 = *(const uint4*)(ap + 7 * as + (k_));      \
  rb0 = *(const uint4*)(bp + (k_));               \
  rb1 = *(const uint4*)(bp + bs + (k_));          \
  rb2 = *(const uint4*)(bp + 2 * bs + (k_));      \
  rb3 = *(const uint4*)(bp + 3 * bs + (k_));
  GB_ISSUE(0)
  bf16_t* swa = sm + lrow * LS + lcc * 8;
  const bf16_t* sra = sm + (wm * 128 + l15) * LS + quad * 8;
  const bf16_t* srb = sm + (256 + wn * 64 + l15) * LS + quad * 8;
#pragma unroll 1
  for (int k0 = 0; k0 < K; k0 += 64) {
    __syncthreads();
    *(uint4*)(swa) = ra0;
    *(uint4*)(swa + 32 * LS) = ra1;
    *(uint4*)(swa + 64 * LS) = ra2;
    *(uint4*)(swa + 96 * LS) = ra3;
    *(uint4*)(swa + 128 * LS) = ra4;
    *(uint4*)(swa + 160 * LS) = ra5;
    *(uint4*)(swa + 192 * LS) = ra6;
    *(uint4*)(swa + 224 * LS) = ra7;
    *(uint4*)(swa + 256 * LS) = rb0;
    *(uint4*)(swa + 288 * LS) = rb1;
    *(uint4*)(swa + 320 * LS) = rb2;
    *(uint4*)(swa + 352 * LS) = rb3;
    __syncthreads();
    const int kn = (k0 + 64 < K) ? k0 + 64 : k0;
    GB_ISSUE(kn)
    __builtin_amdgcn_s_setprio(1);
#pragma unroll
    for (int ks = 0; ks < 2; ++ks) {
      bf16x8 b_[4];
#pragma unroll
      for (int ni = 0; ni < 4; ++ni) b_[ni] = *(const bf16x8*)(srb + ni * 16 * LS + ks * 32);
#pragma unroll
      for (int mh = 0; mh < 2; ++mh) {
        bf16x8 a_[4];
#pragma unroll
        for (int mi = 0; mi < 4; ++mi) a_[mi] = *(const bf16x8*)(sra + (mh * 4 + mi) * 16 * LS + ks * 32);
#pragma unroll
        for (int mi = 0; mi < 4; ++mi)
#pragma unroll
          for (int ni = 0; ni < 4; ++ni)
            acc[mh * 4 + mi][ni] = SWAP ? MFMA16(b_[ni], a_[mi], acc[mh * 4 + mi][ni]) : MFMA16(a_[mi], b_[ni], acc[mh * 4 + mi][ni]);
      }
    }
    __builtin_amdgcn_s_setprio(0);
  }
#undef GB_ISSUE
}

template <int NI, bool SWAP>
__device__ __forceinline__ void gemm_core_v1(f32x4 (&acc)[4][NI], const bf16_t* __restrict__ A, int lda,
                                             const bf16_t* __restrict__ Bt, int ldb, int K, bf16_t* sm) {
  constexpr int LS = 80;
  TIDVARS
  bf16_t* sA_ = sm;
  bf16_t* sB_ = sm + 128 * LS;
  const int lrow = tid >> 3, lcc = tid & 7;
  const bf16_t* ap = A + (size_t)lrow * lda + lcc * 8;
  const bf16_t* bp = Bt + (size_t)lrow * ldb + lcc * 8;
  const size_t as = (size_t)32 * lda, bs = (size_t)32 * ldb;
  uint4 ra0, ra1, ra2, ra3, rb0, rb1, rb2, rb3;
  ra0 = *(const uint4*)(ap);
  ra1 = *(const uint4*)(ap + as);
  ra2 = *(const uint4*)(ap + 2 * as);
  ra3 = *(const uint4*)(ap + 3 * as);
  rb0 = *(const uint4*)(bp);
  rb1 = *(const uint4*)(bp + bs);
  if (NI > 2) {
    rb2 = *(const uint4*)(bp + 2 * bs);
    rb3 = *(const uint4*)(bp + 3 * bs);
  } else {
    rb2 = rb0;
    rb3 = rb0;
  }
  bf16_t* swa = sA_ + lrow * LS + lcc * 8;
  bf16_t* swb = sB_ + lrow * LS + lcc * 8;
  const bf16_t* sra = sA_ + (wm * 64 + l15) * LS + quad * 8;
  const bf16_t* srb = sB_ + (wn * 16 * NI + l15) * LS + quad * 8;
  for (int k0 = 0; k0 < K; k0 += 64) {
    __syncthreads();
    *(uint4*)(swa) = ra0;
    *(uint4*)(swa + 32 * LS) = ra1;
    *(uint4*)(swa + 64 * LS) = ra2;
    *(uint4*)(swa + 96 * LS) = ra3;
    *(uint4*)(swb) = rb0;
    *(uint4*)(swb + 32 * LS) = rb1;
    if (NI > 2) {
      *(uint4*)(swb + 64 * LS) = rb2;
      *(uint4*)(swb + 96 * LS) = rb3;
    }
    __syncthreads();
    const int kn = (k0 + 64 < K) ? k0 + 64 : k0;
    ra0 = *(const uint4*)(ap + kn);
    ra1 = *(const uint4*)(ap + as + kn);
    ra2 = *(const uint4*)(ap + 2 * as + kn);
    ra3 = *(const uint4*)(ap + 3 * as + kn);
    rb0 = *(const uint4*)(bp + kn);
    rb1 = *(const uint4*)(bp + bs + kn);
    if (NI > 2) {
      rb2 = *(const uint4*)(bp + 2 * bs + kn);
      rb3 = *(const uint4*)(bp + 3 * bs + kn);
    }
    __builtin_amdgcn_s_setprio(1);
#pragma unroll
    for (int ks = 0; ks < 2; ++ks) {
      bf16x8 a[4], b[NI];
#pragma unroll
      for (int mi = 0; mi < 4; ++mi) a[mi] = *(const bf16x8*)(sra + mi * 16 * LS + ks * 32);
#pragma unroll
      for (int ni = 0; ni < NI; ++ni) b[ni] = *(const bf16x8*)(srb + ni * 16 * LS + ks * 32);
#pragma unroll
      for (int mi = 0; mi < 4; ++mi)
#pragma unroll
        for (int ni = 0; ni < NI; ++ni)
          acc[mi][ni] = SWAP ? MFMA16(b[ni], a[mi], acc[mi][ni]) : MFMA16(a[mi], b[ni], acc[mi][ni]);
    }
    __builtin_amdgcn_s_setprio(0);
  }
}

__device__ __forceinline__ void gemm_core_g3(f32x4 (&acc)[3][4][2], const bf16_t* __restrict__ A, int lda,
                                             const bf16_t* __restrict__ Bt, size_t gstride, int ldb, int K, bf16_t* sm) {
  constexpr int LS = 80;
  TIDVARS
  const int lrow = tid >> 3, lcc = tid & 7;
  const bf16_t* ap = A + (size_t)lrow * lda + lcc * 8;
  const bf16_t* bp = Bt + (size_t)lrow * ldb + lcc * 8;
  const size_t as = (size_t)32 * lda, bs = (size_t)32 * ldb;
  uint4 ra0, ra1, ra2, ra3, rb0, rb1, rb2, rb3, rb4, rb5;
#define G3_ISSUE(k_)                                    \
  ra0 = *(const uint4*)(ap + (k_));                     \
  ra1 = *(const uint4*)(ap + as + (k_));                \
  ra2 = *(const uint4*)(ap + 2 * as + (k_));            \
  ra3 = *(const uint4*)(ap + 3 * as + (k_));            \
  rb0 = *(const uint4*)(bp + (k_));                     \
  rb1 = *(const uint4*)(bp + bs + (k_));                \
  rb2 = *(const uint4*)(bp + gstride + (k_));           \
  rb3 = *(const uint4*)(bp + gstride + bs + (k_));      \
  rb4 = *(const uint4*)(bp + 2 * gstride + (k_));       \
  rb5 = *(const uint4*)(bp + 2 * gstride + bs + (k_));
  G3_ISSUE(0)
  bf16_t* swa = sm + lrow * LS + lcc * 8;
  const bf16_t* sra = sm + (wm * 64 + l15) * LS + quad * 8;
  const bf16_t* srb = sm + (128 + wn * 32 + l15) * LS + quad * 8;
#pragma unroll 1
  for (int k0 = 0; k0 < K; k0 += 64) {
    __syncthreads();
    *(uint4*)(swa) = ra0;
    *(uint4*)(swa + 32 * LS) = ra1;
    *(uint4*)(swa + 64 * LS) = ra2;
    *(uint4*)(swa + 96 * LS) = ra3;
    *(uint4*)(swa + 128 * LS) = rb0;
    *(uint4*)(swa + 160 * LS) = rb1;
    *(uint4*)(swa + 192 * LS) = rb2;
    *(uint4*)(swa + 224 * LS) = rb3;
    *(uint4*)(swa + 256 * LS) = rb4;
    *(uint4*)(swa + 288 * LS) = rb5;
    __syncthreads();
    const int kn = (k0 + 64 < K) ? k0 + 64 : k0;
    G3_ISSUE(kn)
    __builtin_amdgcn_s_setprio(1);
#pragma unroll
    for (int ks = 0; ks < 2; ++ks) {
      bf16x8 a_[4];
#pragma unroll
      for (int mi = 0; mi < 4; ++mi) a_[mi] = *(const bf16x8*)(sra + mi * 16 * LS + ks * 32);
#pragma unroll
      for (int g = 0; g < 3; ++g) {
        bf16x8 b_[2];
#pragma unroll
        for (int ni = 0; ni < 2; ++ni) b_[ni] = *(const bf16x8*)(srb + (g * 64 + ni * 16) * LS + ks * 32);
#pragma unroll
        for (int mi = 0; mi < 4; ++mi)
#pragma unroll
          for (int ni = 0; ni < 2; ++ni) acc[g][mi][ni] = MFMA16(b_[ni], a_[mi], acc[g][mi][ni]);
        __builtin_amdgcn_sched_barrier(0);
      }
    }
    __builtin_amdgcn_s_setprio(0);
  }
#undef G3_ISSUE
}

template <int NI>
__device__ __forceinline__ void zero_acc(f32x4 (&acc)[4][NI]) {
#pragma unroll
  for (int mi = 0; mi < 4; ++mi)
#pragma unroll
    for (int ni = 0; ni < NI; ++ni) acc[mi][ni] = f32x4{0.f, 0.f, 0.f, 0.f};
}

__device__ __forceinline__ float wave_sum(float v) {
#pragma unroll
  for (int off = 32; off >= 1; off >>= 1) v += __shfl_xor(v, off);
  return v;
}

__device__ void s5_tables(const Params& p, int idx) {
  bf16_t* bbt = (bf16_t*)(p.ws + OFF_S5BB);
  bf16_t* cm = (bf16_t*)(p.ws + OFF_S5CM);
  float* ab = (float*)(p.ws + OFF_S5AB);
  float* at = (float*)(p.ws + OFF_S5AT);
  const int pp = idx & 63, ldg = idx >> 6;
  const float lr = p.lam_re[idx], li = p.lam_im[idx];
  const float dt = expf(p.log_dt[ldg]);
  const float mag = expf(lr * dt), ang = li * dt;
  const float abr = mag * cosf(ang), abi = mag * sinf(ang);
  const float den = lr * lr + li * li;
  const float fr = ((abr - 1.f) * lr + abi * li) / den;
  const float fi = (abi * lr - (abr - 1.f) * li) / den;
  for (int h = 0; h < 16; ++h) {
    const float br = p.b_re[(size_t)idx * 16 + h], bi = p.b_im[(size_t)idx * 16 + h];
    bbt[(size_t)ldg * 2048 + (2 * pp) * 16 + h] = f2bf(fr * br - fi * bi);
    bbt[(size_t)ldg * 2048 + (2 * pp + 1) * 16 + h] = f2bf(fr * bi + fi * br);
    const size_t ci = ((size_t)ldg * 16 + h) * 64 + pp;
    cm[(size_t)ldg * 2048 + h * 128 + 2 * pp] = f2bf(p.c_re[ci]);
    cm[(size_t)ldg * 2048 + h * 128 + 2 * pp + 1] = f2bf(-p.c_im[ci]);
  }
  ab[idx * 2] = abr;
  ab[idx * 2 + 1] = abi;
  float tr = abr, ti = abi;
  for (int i = 0; i < 7; ++i) {
    const float nr = tr * tr - ti * ti, ni = 2.f * tr * ti;
    tr = nr;
    ti = ni;
  }
  at[idx * 2] = tr;
  at[idx * 2 + 1] = ti;
  bf16_t* vt = (bf16_t*)(p.ws + OFF_S5V) + (size_t)ldg * 16384;
  const int d = (ldg >> 5) & 1;
  float qr = 1.f, qi = 0.f;
  for (int k = 0; k < 128; ++k) {
    const int tp = d ? k : 127 - k;
    vt[pp * 128 + tp] = f2bf(qr);
    vt[(64 + pp) * 128 + tp] = f2bf(qi);
    const float nr = qr * abr - qi * abi, ni = qr * abi + qi * abr;
    qr = nr;
    qi = ni;
  }
}

__device__ void mod_item(const Params& p, int item, float* smem) {
  const int l = item / 96, cgp = item % 96;
  const int tid = opaque_tid();
  float* sc = smem;
  float* red = smem + 9 * 1024;
  __syncthreads();
  for (int i = tid; i < 9 * 1024; i += 256) {
    const int r = i >> 10, k = i & 1023;
    const float v = (r < 8) ? p.c[r * 1024 + k] : p.c_ctx[k];
    sc[i] = siluf_(v);
  }
  __syncthreads();
  const int col = cgp * 64 + (tid & 63), kq = tid >> 6;
  float acc[9];
#pragma unroll
  for (int r = 0; r < 9; ++r) acc[r] = 0.f;
  const float* wp = p.w_ada + (size_t)l * 1024 * 6144 + col;
#pragma unroll 1
  for (int k0 = kq * 256; k0 < kq * 256 + 256; k0 += 16) {
    float wv[16];
#pragma unroll
    for (int u = 0; u < 16; ++u) wv[u] = wp[(size_t)(k0 + u) * 6144];
#pragma unroll
    for (int u = 0; u < 16; ++u)
#pragma unroll
      for (int r = 0; r < 9; ++r) acc[r] += sc[r * 1024 + k0 + u] * wv[u];
  }
#pragma unroll
  for (int r = 0; r < 9; ++r) red[(kq * 9 + r) * 64 + (tid & 63)] = acc[r];
  __syncthreads();
  float* mod = (float*)(p.ws + OFF_MOD);
  for (int i = tid; i < 9 * 64; i += 256) {
    const int r = i >> 6, cc = i & 63;
    const float s = red[(0 * 9 + r) * 64 + cc] + red[(1 * 9 + r) * 64 + cc] + red[(2 * 9 + r) * 64 + cc] +
                    red[(3 * 9 + r) * 64 + cc];
    mod[(size_t)(l * 9 + r) * 6144 + cgp * 64 + cc] = s + p.b_ada[l * 6144 + cgp * 64 + cc];
  }
}

struct WcDesc { const float* src; int K, N, dst, gu, kt, nt; };
__device__ __forceinline__ WcDesc wc_decode(const Params& p, int l, int it) {
  WcDesc d;
  d.gu = -1;
  if (it < 1664) { d.src = p.w_in + (size_t)l * 1024 * 6656; d.K = 1024; d.N = 6656; d.dst = W_IN; }
  else if (it < 1728) { it -= 1664; d.src = p.w_glu + (size_t)l * 512 * 512; d.K = 512; d.N = 512; d.dst = W_GLU; }
  else if (it < 1856) { it -= 1728; d.src = p.w_bs5 + (size_t)l * 512 * 1024; d.K = 512; d.N = 1024; d.dst = W_BS5; }
  else if (it < 1984) { it -= 1856; d.src = p.w_bret + (size_t)l * 512 * 1024; d.K = 512; d.N = 1024; d.dst = W_BRET; }
  else if (it < 2112) { it -= 1984; d.src = p.w_bna + (size_t)l * 512 * 1024; d.K = 512; d.N = 1024; d.dst = W_BNA; }
  else if (it < 2368) { it -= 2112; d.src = p.w_out + (size_t)l * 1024 * 1024; d.K = 1024; d.N = 1024; d.dst = W_OUT; }
  else if (it < 3072) { it -= 2368; d.src = p.w_fg + (size_t)l * 1024 * 2816; d.K = 1024; d.N = 2816; d.dst = W_FG; d.gu = 0; }
  else if (it < 3776) { it -= 3072; d.src = p.w_fu + (size_t)l * 1024 * 2816; d.K = 1024; d.N = 2816; d.dst = W_FG; d.gu = 1; }
  else { it -= 3776; d.src = p.w_fd + (size_t)l * 2816 * 1024; d.K = 2816; d.N = 1024; d.dst = W_FD; }
  const int ntn = d.N >> 6;
  d.kt = it / ntn;
  d.nt = it % ntn;
  return d;
}
__device__ void wconv_range(const Params& p, int l, int first, int stride, int n, float* tile) {
  const int tid = opaque_tid();
  const int kr0 = tid >> 4, nc = (tid & 15) * 4;
  int it = first;
  if (it >= n) return;
  WcDesc d = wc_decode(p, l, it);
  float4 v0, v1, v2, v3;
#define WC_LOAD(D)                                                                           \
  {                                                                                          \
    const float* s_ = (D).src + (size_t)((D).kt * 64 + kr0) * (D).N + (D).nt * 64 + nc;      \
    v0 = *(const float4*)(s_);                                                               \
    v1 = *(const float4*)(s_ + (size_t)16 * (D).N);                                          \
    v2 = *(const float4*)(s_ + (size_t)32 * (D).N);                                          \
    v3 = *(const float4*)(s_ + (size_t)48 * (D).N);                                          \
  }
  WC_LOAD(d)
  while (true) {
    __syncthreads();
    {
      float* t0 = tile + kr0 * 65 + nc;
      t0[0] = v0.x; t0[1] = v0.y; t0[2] = v0.z; t0[3] = v0.w;
      t0[16 * 65 + 0] = v1.x; t0[16 * 65 + 1] = v1.y; t0[16 * 65 + 2] = v1.z; t0[16 * 65 + 3] = v1.w;
      t0[32 * 65 + 0] = v2.x; t0[32 * 65 + 1] = v2.y; t0[32 * 65 + 2] = v2.z; t0[32 * 65 + 3] = v2.w;
      t0[48 * 65 + 0] = v3.x; t0[48 * 65 + 1] = v3.y; t0[48 * 65 + 2] = v3.z; t0[48 * 65 + 3] = v3.w;
    }
    __syncthreads();
    const int nx = it + stride;
    WcDesc dn = d;
    if (nx < n) {
      dn = wc_decode(p, l, nx);
      WC_LOAD(dn)
    }
    const int nn = tid >> 2, kq = tid & 3;
    unsigned u[8];
#pragma unroll
    for (int i = 0; i < 8; ++i)
      u[i] = pack2(tile[(kq * 16 + 2 * i) * 65 + nn], tile[(kq * 16 + 2 * i + 1) * 65 + nn]);
    bf16_t* Wd = (bf16_t*)(p.ws + OFF_W) + d.dst;
    int drow = d.nt * 64 + nn;
    if (d.gu >= 0) drow = (drow >> 6) * 128 + ((drow >> 5) & 1) * 64 + d.gu * 32 + (drow & 31);
    uint4* dp = (uint4*)(Wd + (size_t)drow * d.K + d.kt * 64 + kq * 16);
    dp[0] = uint4{u[0], u[1], u[2], u[3]};
    dp[1] = uint4{u[4], u[5], u[6], u[7]};
    if (nx >= n) break;
    it = nx;
    d = dn;
  }
#undef WC_LOAD
}

__device__ void norm_rows(const Params& p, int l, int which, int r, const float* src_ctx, const float* src_x) {
  const int lane = opaque_tid() & 63;
  float4 v[2][4];
  const float* mod[2];
#pragma unroll
  for (int q = 0; q < 2; ++q) {
    const int rr = r + q * 4;
    const float* src = (rr < R_CTX) ? src_ctx + (size_t)rr * 1024 : src_x + (size_t)(rr - R_CTX) * 1024;
    const int modrow = (rr < R_CTX) ? 8 : (rr - R_CTX) >> 11;
    mod[q] = (const float*)(p.ws + OFF_MOD) + (size_t)(l * 9 + modrow) * 6144 + which * 3072;
#pragma unroll
    for (int i = 0; i < 4; ++i) v[q][i] = *(const float4*)(src + i * 256 + lane * 4);
  }
#pragma unroll
  for (int q = 0; q < 2; ++q) {
    const int rr = r + q * 4;
    float ss = 0.f;
#pragma unroll
    for (int i = 0; i < 4; ++i) ss += v[q][i].x * v[q][i].x + v[q][i].y * v[q][i].y + v[q][i].z * v[q][i].z + v[q][i].w * v[q][i].w;
    ss = wave_sum(ss);
    const float rstd = rsqrtf(ss * (1.f / 1024.f) + 1e-6f);
    bf16_t* h = (bf16_t*)(p.ws + OFF_H) + (size_t)rr * 1024;
#pragma unroll
    for (int i = 0; i < 4; ++i) {
      const int c0 = i * 256 + lane * 4;
      const float4 sh = *(const float4*)(mod[q] + c0);
      const float4 sc = *(const float4*)(mod[q] + 1024 + c0);
      uint2 o;
      o.x = pack2(v[q][i].x * rstd * (1.f + sc.x) + sh.x, v[q][i].y * rstd * (1.f + sc.y) + sh.y);
      o.y = pack2(v[q][i].z * rstd * (1.f + sc.z) + sh.z, v[q][i].w * rstd * (1.f + sc.w) + sh.w);
      *(uint2*)(h + c0) = o;
    }
  }
}

__device__ __forceinline__ void resid_big_tile(const Params& p, int l, int mt, int nt, const bf16_t* A, int lda,
                                               const bf16_t* Bt, int ldb, int K, int goff, const float* sx, float* dx,
                                               bf16_t* smem) {
  f32x4 acc[8][4];
#pragma unroll
  for (int mi = 0; mi < 8; ++mi)
#pragma unroll
    for (int ni = 0; ni < 4; ++ni) acc[mi][ni] = f32x4{0.f, 0.f, 0.f, 0.f};
  gemm_core_big<true>(acc, A + (size_t)mt * 256 * lda, lda, Bt + (size_t)nt * 128 * ldb, ldb, K, smem);
  TIDVARS
  const int modrow = (mt - 8) >> 3;
  const float* modp_ = (const float*)(p.ws + OFF_MOD);
  float4 gv[4];
#pragma unroll
  for (int ni = 0; ni < 4; ++ni)
    gv[ni] = *(const float4*)(modp_ + (size_t)(l * 9 + modrow) * 6144 + goff + nt * 128 + wn * 64 + ni * 16 + quad * 4);
#pragma unroll
  for (int mi = 0; mi < 8; ++mi) {
    const int r = mt * 256 + wm * 128 + mi * 16 + l15;
    const size_t o = (size_t)(r - R_CTX) * 1024 + nt * 128 + wn * 64 + quad * 4;
    float4 sv[4];
#pragma unroll
    for (int ni = 0; ni < 4; ++ni) sv[ni] = *(const float4*)(sx + o + ni * 16);
#pragma unroll
    for (int ni = 0; ni < 4; ++ni) {
      float4 ov;
      ov.x = sv[ni].x + gv[ni].x * acc[mi][ni][0];
      ov.y = sv[ni].y + gv[ni].y * acc[mi][ni][1];
      ov.z = sv[ni].z + gv[ni].z * acc[mi][ni][2];
      ov.w = sv[ni].w + gv[ni].w * acc[mi][ni][3];
      *(float4*)(dx + o + ni * 16) = ov;
    }
  }
}

__device__ __forceinline__ void inproj_tile(const Params& p, int mt, int nt, bf16_t* smem) {
  const bf16_t* h = (const bf16_t*)(p.ws + OFF_H);
  const bf16_t* W = (const bf16_t*)(p.ws + OFF_W);
  bf16_t* proj = (bf16_t*)(p.ws + OFF_PROJ);
  bf16_t* vT = (bf16_t*)(p.ws + OFF_VT);
  const float* rot = (const float*)(p.ws + OFF_ROT);
  int colbase = 0, vrow = -1;
  float scale = 1.f;
  bool rotary = false;
  if (nt < 4) colbase = PC_U + nt * 128;
  else if (nt < 6) { colbase = PC_RK + (nt - 4) * 128; scale = 0.125f; rotary = true; }
  else if (nt < 10) vrow = (nt - 6) * 128;
  else if (nt < 14) colbase = PC_NK + (nt - 10) * 128;
  else if (nt < 18) vrow = 512 + (nt - 14) * 128;
  else if (nt < 20) { colbase = PC_RQ + (nt - 18) * 128; rotary = true; }
  else if (nt < 24) colbase = PC_RG + (nt - 20) * 128;
  else { colbase = PC_NQ + (nt - 24) * 128; scale = 0.125f; }
  f32x4 acc[8][4];
#pragma unroll
  for (int mi = 0; mi < 8; ++mi)
#pragma unroll
    for (int ni = 0; ni < 4; ++ni) acc[mi][ni] = f32x4{0.f, 0.f, 0.f, 0.f};
  if (vrow >= 0) {
    gemm_core_big<false>(acc, h + (size_t)mt * 256 * 1024, 1024, W + W_IN + (size_t)nt * 128 * 1024, 1024, 1024, smem);
    TIDVARS
    const int m0 = mt * 256 + wm * 128;
#pragma unroll
    for (int mi = 0; mi < 8; ++mi) {
      const int r0 = m0 + mi * 16 + quad * 4;
#pragma unroll
      for (int ni = 0; ni < 4; ++ni) {
        const int vr = vrow + wn * 64 + ni * 16 + l15;
        uint2 o;
        o.x = pack2(acc[mi][ni][0], acc[mi][ni][1]);
        o.y = pack2(acc[mi][ni][2], acc[mi][ni][3]);
        *(uint2*)(vT + (size_t)vr * R_ALL + r0) = o;
      }
    }
    return;
  }
  gemm_core_big<true>(acc, h + (size_t)mt * 256 * 1024, 1024, W + W_IN + (size_t)nt * 128 * 1024, 1024, 1024, smem);
  TIDVARS
  const int m0 = mt * 256 + wm * 128;
  if (rotary && mt >= 8) {
#pragma unroll
    for (int mi = 0; mi < 8; ++mi) {
      const int r = m0 + mi * 16 + l15;
      const int t = (r - R_CTX) & 2047;
      const int cr = t >> 6, cc = t & 63;
      const float4 c1 = *(const float4*)(rot + cr * 16 + quad * 4), s1 = *(const float4*)(rot + 1024 + cr * 16 + quad * 4);
      const float4 c2 = *(const float4*)(rot + cc * 16 + quad * 4), s2 = *(const float4*)(rot + 1024 + cc * 16 + quad * 4);
      const float cs1[4] = {c1.x, c1.y, c1.z, c1.w}, sn1[4] = {s1.x, s1.y, s1.z, s1.w};
      const float cs2[4] = {c2.x, c2.y, c2.z, c2.w}, sn2[4] = {s2.x, s2.y, s2.z, s2.w};
#pragma unroll
      for (int j = 0; j < 4; ++j) {
        const float a = acc[mi][0][j], bb = acc[mi][1][j];
        acc[mi][0][j] = a * cs1[j] - bb * sn1[j];
        acc[mi][1][j] = a * sn1[j] + bb * cs1[j];
        const float a2 = acc[mi][2][j], b2 = acc[mi][3][j];
        acc[mi][2][j] = a2 * cs2[j] - b2 * sn2[j];
        acc[mi][3][j] = a2 * sn2[j] + b2 * cs2[j];
      }
    }
  }
#pragma unroll
  for (int mi = 0; mi < 8; ++mi) {
    const int r = m0 + mi * 16 + l15;
#pragma unroll
    for (int ni = 0; ni < 4; ++ni) {
      uint2 o;
      o.x = pack2(acc[mi][ni][0] * scale, acc[mi][ni][1] * scale);
      o.y = pack2(acc[mi][ni][2] * scale, acc[mi][ni][3] * scale);
      *(uint2*)(proj + (size_t)r * PJ + colbase + wn * 64 + ni * 16 + quad * 4) = o;
    }
  }
  if (nt < 4) {
    bf16_t* uT = (bf16_t*)(p.ws + OFF_UT);
#pragma unroll
    for (int mi = 0; mi < 8; ++mi) {
      const int r = m0 + mi * 16 + l15;
#pragma unroll
      for (int ni = 0; ni < 4; ++ni)
#pragma unroll
        for (int j = 0; j < 4; ++j)
          uT[(size_t)(nt * 128 + wn * 64 + ni * 16 + quad * 4 + j) * R_ALL + r] = f2bf(acc[mi][ni][j]);
    }
  }
}

__device__ __forceinline__ void ret_item(const Params& p, int l, int b, int h, int qt, bool isctx, bool dry, unsigned char* smem) {
  TIDVARS
  bf16_t* proj = (bf16_t*)(p.ws + OFF_PROJ);
  const bf16_t* vT = (const bf16_t*)(p.ws + OFF_VT);
  const float LOG2E = 1.4426950408889634f;
  const float thf = p.theta[l * 8 + h], thb = p.theta[l * 8 + 4 + h];
  const float lgf = -log1pf(expf(-thf)) * LOG2E;
  const float lgb = -log1pf(expf(-thb)) * LOG2E;
  const int seqbase = isctx ? b * 256 : R_CTX + b * 2048;
  const int q0w = qt * 128 + w * 32;
  bf16x8 bq[2][2];
#pragma unroll
  for (int qb = 0; qb < 2; ++qb)
#pragma unroll
    for (int ks = 0; ks < 2; ++ks)
      bq[qb][ks] = *(const bf16x8*)(proj + (size_t)(seqbase + q0w + qb * 16 + l15) * PJ + PC_RQ + h * 64 + ks * 32 + quad * 8);
  float cfF[8], cfB[8];
#pragma unroll
  for (int j = 0; j < 8; ++j) {
    cfF[j] = exp2f(-lgf * (float)(quad * 8 + j));
    cfB[j] = exp2f(lgb * (float)(quad * 8 + j));
  }
  f32x4 O[2][8];
#pragma unroll
  for (int qb = 0; qb < 2; ++qb)
#pragma unroll
    for (int i = 0; i < 8; ++i) O[qb][i] = f32x4{0.f, 0.f, 0.f, 0.f};
  const int ntiles = isctx ? 4 : 36;
  const int lrow = tid >> 3, lcc = tid & 7;
  const bf16_t* kg = proj + PC_RK + h * 64 + lcc * 8 + (size_t)lrow * PJ;
  const bf16_t* vg = vT + (size_t)(h * 128 + lrow) * R_ALL + lcc * 8;
  constexpr int STG = 15360;
  bf16_t* sm = (bf16_t*)smem;
  const int swo = lrow * 80 + lcc * 8;
  uint4 rk0, rk1, rv0, rv1, rv2, rv3;
  {
    const int krow0 = b * 256;
    rk0 = *(const uint4*)(kg + (size_t)krow0 * PJ);
    rk1 = *(const uint4*)(kg + (size_t)(krow0 + 32) * PJ);
    rv0 = *(const uint4*)(vg + krow0);
    rv1 = *(const uint4*)(vg + (size_t)32 * R_ALL + krow0);
    rv2 = *(const uint4*)(vg + (size_t)64 * R_ALL + krow0);
    rv3 = *(const uint4*)(vg + (size_t)96 * R_ALL + krow0);
    *(uint4*)(sm + swo) = rk0;
    *(uint4*)(sm + swo + 32 * 80) = rk1;
    *(uint4*)(sm + 64 * 80 + swo) = rv0;
    *(uint4*)(sm + 64 * 80 + swo + 32 * 80) = rv1;
    *(uint4*)(sm + 64 * 80 + swo + 64 * 80) = rv2;
    *(uint4*)(sm + 64 * 80 + swo + 96 * 80) = rv3;
  }
  __syncthreads();
#pragma unroll 1
  for (int ti = 0; ti < ntiles; ++ti) {
    {
      const int tn = (ti + 1 < ntiles) ? ti + 1 : ti;
      const int krow0 = (tn < 4) ? b * 256 + tn * 64 : R_CTX + b * 2048 + (tn - 4) * 64;
      rk0 = *(const uint4*)(kg + (size_t)krow0 * PJ);
      rk1 = *(const uint4*)(kg + (size_t)(krow0 + 32) * PJ);
      rv0 = *(const uint4*)(vg + krow0);
      rv1 = *(const uint4*)(vg + (size_t)32 * R_ALL + krow0);
      rv2 = *(const uint4*)(vg + (size_t)64 * R_ALL + krow0);
      rv3 = *(const uint4*)(vg + (size_t)96 * R_ALL + krow0);
    }
    const bf16_t* Ks = sm + (ti & 1) * STG;
    const bf16_t* Vs = Ks + 64 * 80;
    const bool kctx = ti < 4;
#pragma unroll
    for (int g2 = 0; g2 < 2; ++g2) {
      const int kpos0 = (kctx ? ti * 64 : (ti - 4) * 64) + g2 * 32;
      const bf16_t* kr = Ks + (g2 * 32 + (l15 >> 2) * 8 + (l15 & 3)) * 80 + quad * 8;
      const bf16x8 kf0 = *(const bf16x8*)(kr), kf1 = *(const bf16x8*)(kr + 32);
      const bf16x8 kf2 = *(const bf16x8*)(kr + 4 * 80), kf3 = *(const bf16x8*)(kr + 4 * 80 + 32);
      bf16x8 pa[2];
#pragma unroll
      for (int qb = 0; qb < 2; ++qb) {
        f32x4 sx = f32x4{0.f, 0.f, 0.f, 0.f}, sy = f32x4{0.f, 0.f, 0.f, 0.f};
        sx = MFMA16(kf0, bq[qb][0], sx);
        sx = MFMA16(kf1, bq[qb][1], sx);
        sy = MFMA16(kf2, bq[qb][0], sy);
        sy = MFMA16(kf3, bq[qb][1], sy);
        const int qlo = q0w + qb * 16;
        const int qpos = qlo + l15;
        float pv[8];
        if (isctx || !kctx) {
          if (kpos0 + 31 <= qlo) {
            const float rf = exp2f(lgf * (float)(qpos - kpos0));
#pragma unroll
            for (int j = 0; j < 8; ++j) pv[j] = ((j < 4) ? sx[j & 3] : sy[j & 3]) * (rf * cfF[j]);
          } else if (kpos0 > qlo + 15) {
            const float rb = exp2f(lgb * (float)(kpos0 - qpos));
#pragma unroll
            for (int j = 0; j < 8; ++j) pv[j] = ((j < 4) ? sx[j & 3] : sy[j & 3]) * (rb * cfB[j]);
          } else {
#pragma unroll
            for (int j = 0; j < 8; ++j) {
              const int d = qpos - (kpos0 + quad * 8 + j);
              const float wgt = (d >= 0) ? exp2f(lgf * (float)d) : exp2f(lgb * (float)(-d));
              pv[j] = ((j < 4) ? sx[j & 3] : sy[j & 3]) * wgt;
            }
          }
        } else {
          const float rf = exp2f(lgf * (float)(qpos + 256 - kpos0));
          const float rb = exp2f(lgb * (float)(2048 - qpos + kpos0));
#pragma unroll
          for (int j = 0; j < 8; ++j) pv[j] = ((j < 4) ? sx[j & 3] : sy[j & 3]) * (rf * cfF[j] + rb * cfB[j]);
        }
        pa[qb] = pack8(pv);
      }
#pragma unroll
      for (int db = 0; db < 8; ++db) {
        const bf16x8 vf = *(const bf16x8*)(Vs + (db * 16 + l15) * 80 + g2 * 32 + quad * 8);
        O[0][db] = MFMA16(vf, pa[0], O[0][db]);
        O[1][db] = MFMA16(vf, pa[1], O[1][db]);
      }
    }
    if (ti + 1 < ntiles) {
      bf16_t* d = sm + ((ti + 1) & 1) * STG;
      *(uint4*)(d + swo) = rk0;
      *(uint4*)(d + swo + 32 * 80) = rk1;
      *(uint4*)(d + 64 * 80 + swo) = rv0;
      *(uint4*)(d + 64 * 80 + swo + 32 * 80) = rv1;
      *(uint4*)(d + 64 * 80 + swo + 64 * 80) = rv2;
      *(uint4*)(d + 64 * 80 + swo + 96 * 80) = rv3;
    }
    __syncthreads();
  }
  bf16_t* obase = dry ? (bf16_t*)(p.ws + WS_END) : proj;
  const size_t omask = dry ? (size_t)0x7FFFFF : ~(size_t)0;
#pragma unroll
  for (int qb = 0; qb < 2; ++qb) {
    float s = 0.f;
#pragma unroll
    for (int db = 0; db < 8; ++db) s += (O[qb][db][0] + O[qb][db][1]) + (O[qb][db][2] + O[qb][db][3]);
    s += __shfl_xor(s, 16);
    s += __shfl_xor(s, 32);
    const float mu = s * (1.f / 128.f);
    float v = 0.f;
#pragma unroll
    for (int db = 0; db < 8; ++db)
#pragma unroll
      for (int j = 0; j < 4; ++j) { const float d = O[qb][db][j] - mu; v += d * d; }
    v += __shfl_xor(v, 16);
    v += __shfl_xor(v, 32);
    const float rs = rsqrtf(v * (1.f / 128.f) + 1e-5f);
    const int orow = seqbase + q0w + qb * 16 + l15;
    uint2 gg[8];
#pragma unroll
    for (int db = 0; db < 8; ++db) gg[db] = *(const uint2*)(proj + (size_t)orow * PJ + PC_RG + h * 128 + db * 16 + quad * 4);
#pragma unroll
    for (int db = 0; db < 8; ++db) {
      const float g0 = __uint_as_float(gg[db].x << 16), g1 = __uint_as_float(gg[db].x & 0xffff0000u);
      const float g2 = __uint_as_float(gg[db].y << 16), g3 = __uint_as_float(gg[db].y & 0xffff0000u);
      uint2 o;
      o.x = pack2(siluf_(g0) * (O[qb][db][0] - mu) * rs, siluf_(g1) * (O[qb][db][1] - mu) * rs);
      o.y = pack2(siluf_(g2) * (O[qb][db][2] - mu) * rs, siluf_(g3) * (O[qb][db][3] - mu) * rs);
      *(uint2*)(obase + (((size_t)orow * PJ + PC_RG + h * 128 + db * 16 + quad * 4) & omask)) = o;
    }
  }
}

__device__ __forceinline__ void na_item(const Params& p, int l, int b, int h, int qidx, bool isctx, bool dry, unsigned char* smem) {
  TIDVARS
  bf16_t* proj = (bf16_t*)(p.ws + OFF_PROJ);
  const bf16_t* vT = (const bf16_t*)(p.ws + OFF_VT);
  const int qrow0 = isctx ? b * 256 + qidx * 64 : R_CTX + b * 2048 + qidx * 64;
  float* rpbs = (float*)smem;
  float* part = (float*)(smem + 2048);
  {
    const float* rp = p.rpb + (size_t)(l * 8 + h) * 465;
    for (int i = tid; i < 465; i += 256) rpbs[i] = rp[i];
  }
  bf16x8 bq[4][2];
#pragma unroll
  for (int qb = 0; qb < 4; ++qb)
#pragma unroll
    for (int ks = 0; ks < 2; ++ks)
      bq[qb][ks] = *(const bf16x8*)(proj + (size_t)(qrow0 + qb * 16 + l15) * PJ + PC_NQ + h * 64 + ks * 32 + quad * 8);
  const int r = qidx;
  const int rs = min(max(r - 4, 0), 24);
  const int winbase = R_CTX + b * 2048 + rs * 64;
  float m_run[4], l_run[4];
  f32x4 O[4][4];
#pragma unroll
  for (int qb = 0; qb < 4; ++qb) {
    m_run[qb] = -1e30f;
    l_run[qb] = 0.f;
#pragma unroll
    for (int i = 0; i < 4; ++i) O[qb][i] = f32x4{0.f, 0.f, 0.f, 0.f};
  }
  const int ngr = isctx ? 2 : 6;
  const bf16_t* kbase = proj + PC_NK + h * 64 + quad * 8 + (size_t)((l15 >> 2) * 8 + (l15 & 3)) * PJ;
  const bf16_t* vbase = vT + (size_t)(512 + h * 64 + l15) * R_ALL + quad * 8;
  bf16x8 kf0, kf1, kf2, kf3, vf0, vf1, vf2, vf3;
  {
    const int krow0 = b * 256 + w * 64;
    const bf16_t* kp = kbase + (size_t)krow0 * PJ;
    kf0 = *(const bf16x8*)(kp);
    kf1 = *(const bf16x8*)(kp + 32);
    kf2 = *(const bf16x8*)(kp + 4 * PJ);
    kf3 = *(const bf16x8*)(kp + 4 * PJ + 32);
    vf0 = *(const bf16x8*)(vbase + krow0);
    vf1 = *(const bf16x8*)(vbase + (size_t)16 * R_ALL + krow0);
    vf2 = *(const bf16x8*)(vbase + (size_t)32 * R_ALL + krow0);
    vf3 = *(const bf16x8*)(vbase + (size_t)48 * R_ALL + krow0);
  }
  __syncthreads();
#pragma unroll 1
  for (int g = 0; g < ngr; ++g) {
    bf16x8 nk0, nk1, nk2, nk3, nv0, nv1, nv2, nv3;
    {
      const int gn = (g + 1 < ngr) ? g + 1 : g;
      const int tn = w + 4 * (gn >> 1);
      const int krow0 = ((tn < 4) ? b * 256 + tn * 64 : winbase + (tn - 4) * 64) + (gn & 1) * 32;
      const bf16_t* kp = kbase + (size_t)krow0 * PJ;
      nk0 = *(const bf16x8*)(kp);
      nk1 = *(const bf16x8*)(kp + 32);
      nk2 = *(const bf16x8*)(kp + 4 * PJ);
      nk3 = *(const bf16x8*)(kp + 4 * PJ + 32);
      nv0 = *(const bf16x8*)(vbase + krow0);
      nv1 = *(const bf16x8*)(vbase + (size_t)16 * R_ALL + krow0);
      nv2 = *(const bf16x8*)(vbase + (size_t)32 * R_ALL + krow0);
      nv3 = *(const bf16x8*)(vbase + (size_t)48 * R_ALL + krow0);
    }
    const int t = w + 4 * (g >> 1);
    const int hb = g & 1;
    const bool win = t >= 4;
    const int a = t - 4;
#pragma unroll
    for (int qb = 0; qb < 4; ++qb) {
      if (win && ((qb == 0 && hb == 1) || (qb == 3 && hb == 0))) continue;
      f32x4 sx = f32x4{0.f, 0.f, 0.f, 0.f}, sy = f32x4{0.f, 0.f, 0.f, 0.f};
      sx = MFMA16(kf0, bq[qb][0], sx);
      sx = MFMA16(kf1, bq[qb][1], sx);
      sy = MFMA16(kf2, bq[qb][0], sy);
      sy = MFMA16(kf3, bq[qb][1], sy);
      float s[8];
#pragma unroll
      for (int j = 0; j < 8; ++j) s[j] = (j < 4) ? sx[j & 3] : sy[j & 3];
      if (win) {
        const int c = qb * 16 + l15;
        const int cs = min(max(c - 8, 0), 48);
#pragma unroll
        for (int j = 0; j < 8; ++j) {
          const int kc = hb * 32 + quad * 8 + j;
          const bool valid = (kc >= cs) && (kc < cs + 16);
          const int bi = min(max((rs + a - r + 7) * 31 + (kc - c + 15), 0), 464);
          const float sb = s[j] + rpbs[bi];
          s[j] = valid ? sb : -1e30f;
        }
      }
      float gmax = s[0];
#pragma unroll
      for (int j = 1; j < 8; ++j) gmax = fmaxf(gmax, s[j]);
      gmax = fmaxf(gmax, __shfl_xor(gmax, 16));
      gmax = fmaxf(gmax, __shfl_xor(gmax, 32));
      const float m_new = fmaxf(m_run[qb], gmax);
      const bool grew = m_new > m_run[qb];
      float ps = 0.f;
      float pv[8];
#pragma unroll
      for (int j = 0; j < 8; ++j) {
        pv[j] = __expf(s[j] - m_new);
        ps += pv[j];
      }
      const bf16x8 pa = pack8(pv);
      if (__any(grew)) {
        const float alpha = __expf(m_run[qb] - m_new);
        l_run[qb] *= alpha;
#pragma unroll
        for (int db = 0; db < 4; ++db)
#pragma unroll
          for (int j = 0; j < 4; ++j) O[qb][db][j] *= alpha;
      }
      m_run[qb] = m_new;
      l_run[qb] += ps;
      O[qb][0] = MFMA16(vf0, pa, O[qb][0]);
      O[qb][1] = MFMA16(vf1, pa, O[qb][1]);
      O[qb][2] = MFMA16(vf2, pa, O[qb][2]);
      O[qb][3] = MFMA16(vf3, pa, O[qb][3]);
    }
    kf0 = nk0; kf1 = nk1; kf2 = nk2; kf3 = nk3;
    vf0 = nv0; vf1 = nv1; vf2 = nv2; vf3 = nv3;
  }
#pragma unroll
  for (int qb = 0; qb < 4; ++qb) {
    float lt = l_run[qb];
    lt += __shfl_xor(lt, 16);
    lt += __shfl_xor(lt, 32);
    l_run[qb] = lt;
    if (qb != w) {
      float* ps_ = part + (w * 3 + (qb > w ? qb - 1 : qb)) * 1152;
#pragma unroll
      for (int db = 0; db < 4; ++db)
#pragma unroll
        for (int j = 0; j < 4; ++j) ps_[(db * 4 + j) * 64 + lane] = O[qb][db][j];
      ps_[1024 + lane] = m_run[qb];
      ps_[1088 + lane] = lt;
    }
  }
  __syncthreads();
  float m_own = 0.f, l_own = 0.f;
  f32x4 Oo[4];
#pragma unroll
  for (int qb = 0; qb < 4; ++qb)
    if (qb == w) {
      m_own = m_run[qb];
      l_own = l_run[qb];
#pragma unroll
      for (int db = 0; db < 4; ++db) Oo[db] = O[qb][db];
    }
  float m_tot = m_own;
#pragma unroll
  for (int v = 0; v < 4; ++v) {
    if (v == w) continue;
    const float* ps_ = part + (v * 3 + (w > v ? w - 1 : w)) * 1152;
    m_tot = fmaxf(m_tot, ps_[1024 + lane]);
  }
  {
    const float f = __expf(m_own - m_tot);
    l_own *= f;
#pragma unroll
    for (int db = 0; db < 4; ++db)
#pragma unroll
      for (int j = 0; j < 4; ++j) Oo[db][j] *= f;
  }
#pragma unroll
  for (int v = 0; v < 4; ++v) {
    if (v == w) continue;
    const float* ps_ = part + (v * 3 + (w > v ? w - 1 : w)) * 1152;
    const float f = __expf(ps_[1024 + lane] - m_tot);
    l_own += ps_[1088 + lane] * f;
#pragma unroll
    for (int db = 0; db < 4; ++db)
#pragma unroll
      for (int j = 0; j < 4; ++j) Oo[db][j] += ps_[(db * 4 + j) * 64 + lane] * f;
  }
  bf16_t* obase = dry ? (bf16_t*)(p.ws + WS_END) : proj;
  const size_t omask = dry ? (size_t)0x7FFFFF : ~(size_t)0;
  const float linv = 1.f / l_own;
  const int orow = qrow0 + w * 16 + l15;
#pragma unroll
  for (int db = 0; db < 4; ++db) {
    uint2 o;
    o.x = pack2(Oo[db][0] * linv, Oo[db][1] * linv);
    o.y = pack2(Oo[db][2] * linv, Oo[db][3] * linv);
    *(uint2*)(obase + (((size_t)orow * PJ + PC_NQ + h * 64 + db * 16 + quad * 4) & omask)) = o;
  }
}

struct S5Frag {
  bf16x8 bf[8];
  bf16x8 cf[4];
  float ar, ai;
};

__device__ __forceinline__ void s5_load_frag(const Params& p, S5Frag& f, int ldg, bool need_c) {
  const int lane = opaque_tid() & 63, l15 = lane & 15, quad = lane >> 4;
  const bf16_t* bbt = (const bf16_t*)(p.ws + OFF_S5BB) + (size_t)ldg * 2048;
  const bf16_t* cm = (const bf16_t*)(p.ws + OFF_S5CM) + (size_t)ldg * 2048;
  const float* ab = (const float*)(p.ws + OFF_S5AB) + (size_t)ldg * 128;
  const bf16x8 z = {0, 0, 0, 0, 0, 0, 0, 0};
#pragma unroll
  for (int pb = 0; pb < 8; ++pb)
    f.bf[pb] = (quad < 2) ? *(const bf16x8*)(bbt + (pb * 16 + l15) * 16 + quad * 8) : z;
  if (need_c) {
#pragma unroll
    for (int ks = 0; ks < 4; ++ks) f.cf[ks] = *(const bf16x8*)(cm + l15 * 128 + ks * 32 + quad * 8);
  }
  f.ar = ab[lane * 2];
  f.ai = ab[lane * 2 + 1];
}

template <int DIR>
__device__ __forceinline__ int s5_row(int b, int s0, int l15) {
  const int s = s0 + l15;
  if (s0 < 256) {
    const int j = DIR ? 255 - s : s;
    return b * 256 + j;
  }
  const int t = s - 256;
  const int tt = DIR ? 2047 - t : t;
  return R_CTX + b * 2048 + tt;
}

template <int DIR, bool WRITE>
__device__ __forceinline__ void s5_chunk(const bf16_t* __restrict__ proj, int b, int g, int cseq,
                                         const S5Frag& f, float& xr, float& xi, float* BUs, bf16_t* Xs,
                                         f32x4 (&yacc)[8]) {
  const int lane = opaque_tid() & 63, l15 = lane & 15, quad = lane >> 4;
  const bf16x8 z = {0, 0, 0, 0, 0, 0, 0, 0};
  const bf16_t* ub = proj + PC_U + g * 16 + (quad & 1) * 8;
  bf16x8 ucur = *(const bf16x8*)(ub + (size_t)s5_row<DIR>(b, cseq * 128, l15) * PJ);
#pragma unroll 1
  for (int sbs = 0; sbs < 8; ++sbs) {
    const int sn = cseq * 128 + ((sbs < 7) ? sbs + 1 : sbs) * 16;
    const bf16x8 unext = *(const bf16x8*)(ub + (size_t)s5_row<DIR>(b, sn, l15) * PJ);
    const bf16x8 uf = (quad < 2) ? ucur : z;
    __builtin_amdgcn_wave_barrier();
#pragma unroll
    for (int pb = 0; pb < 8; ++pb) {
      f32x4 bu = f32x4{0.f, 0.f, 0.f, 0.f};
      bu = MFMA16(uf, f.bf[pb], bu);
#pragma unroll
      for (int j = 0; j < 4; ++j) BUs[(quad * 4 + j) * 132 + pb * 16 + l15] = bu[j];
    }
    __builtin_amdgcn_wave_barrier();
    float2 bbv[16];
#pragma unroll
    for (int t = 0; t < 16; ++t) bbv[t] = *(const float2*)(BUs + t * 132 + 2 * lane);
#pragma unroll
    for (int t = 0; t < 16; ++t) {
      const float2 bb = bbv[t];
      const float nr = f.ar * xr - f.ai * xi + bb.x;
      const float ni = f.ar * xi + f.ai * xr + bb.y;
      xr = nr;
      xi = ni;
      if (WRITE) {
        const int rt = DIR ? 15 - t : t;
        *(unsigned*)(Xs + rt * 144 + 2 * lane) = pack2(xr, xi);
      }
    }
    if (WRITE) {
      __builtin_amdgcn_wave_barrier();
      const int tsb = DIR ? 7 - sbs : sbs;
      f32x4 yt = f32x4{0.f, 0.f, 0.f, 0.f};
#pragma unroll
      for (int ks = 0; ks < 4; ++ks) {
        const bf16x8 xa = *(const bf16x8*)(Xs + l15 * 144 + ks * 32 + quad * 8);
        yt = MFMA16(xa, f.cf[ks], yt);
      }
#pragma unroll
      for (int i = 0; i < 8; ++i)
        if (i == tsb) yacc[i] += yt;
    }
    ucur = unext;
  }
}

__device__ __forceinline__ void s5_item(const Params& p, int l, int b, int g, bool last, unsigned char* smem) {
  TIDVARS
  float* bound = (float*)smem;
  float* BUs = (float*)(smem + 18432 + w * 13056);
  bf16_t* Xs = (bf16_t*)(smem + 18432 + w * 13056 + 8448);
  const bf16_t* proj = (const bf16_t*)(p.ws + OFF_PROJ);
  bf16_t* G = (bf16_t*)(p.ws + OFF_G);
  f32x4 yacc[8];
  {
    const bf16_t* uT = (const bf16_t*)(p.ws + OFF_UT);
    bf16_t* tabs = (bf16_t*)(smem + 18432);
#pragma unroll 1
    for (int dir = 0; dir < 2; ++dir) {
      const int ldg = (l * 2 + dir) * 32 + g;
      __syncthreads();
      {
        const bf16_t* vt = (const bf16_t*)(p.ws + OFF_S5V) + (size_t)ldg * 16384;
#pragma unroll
        for (int i = 0; i < 8; ++i) {
          const int id = tid + i * 256, row = id >> 4, cc = id & 15;
          *(uint4*)(tabs + row * 144 + cc * 8) = *(const uint4*)(vt + row * 128 + cc * 8);
        }
      }
      float bre[4][4], bim[4][4];
      {
        const bf16_t* bbt = (const bf16_t*)(p.ws + OFF_S5BB) + (size_t)ldg * 2048;
#pragma unroll
        for (int nb = 0; nb < 4; ++nb) {
          const int ps = nb * 16 + l15;
          const uint2 r2 = *(const uint2*)(bbt + (2 * ps) * 16 + quad * 4);
          const uint2 i2 = *(const uint2*)(bbt + (2 * ps + 1) * 16 + quad * 4);
          bre[nb][0] = __uint_as_float(r2.x << 16); bre[nb][1] = __uint_as_float(r2.x & 0xffff0000u);
          bre[nb][2] = __uint_as_float(r2.y << 16); bre[nb][3] = __uint_as_float(r2.y & 0xffff0000u);
          bim[nb][0] = __uint_as_float(i2.x << 16); bim[nb][1] = __uint_as_float(i2.x & 0xffff0000u);
          bim[nb][2] = __uint_as_float(i2.y << 16); bim[nb][3] = __uint_as_float(i2.y & 0xffff0000u);
        }
      }
      __syncthreads();
#pragma unroll 1
      for (int c = w; c < 17; c += 4) {
        int rowbase;
        if (dir == 0) rowbase = (c < 2) ? b * 256 + 128 * c : R_CTX + b * 2048 + (c - 2) * 128;
        else rowbase = (c < 2) ? b * 256 + 128 * (1 - c) : R_CTX + b * 2048 + 128 * (17 - c);
        bf16x8 ua[4];
#pragma unroll
        for (int ks = 0; ks < 4; ++ks)
          ua[ks] = *(const bf16x8*)(uT + (size_t)(g * 16 + l15) * R_ALL + rowbase + ks * 32 + quad * 8);
        f32x4 z[8];
#pragma unroll
        for (int nb = 0; nb < 8; ++nb) {
          z[nb] = f32x4{0.f, 0.f, 0.f, 0.f};
#pragma unroll
          for (int ks = 0; ks < 4; ++ks) {
            const bf16x8 wf = *(const bf16x8*)(tabs + (nb * 16 + l15) * 144 + ks * 32 + quad * 8);
            z[nb] = MFMA16(ua[ks], wf, z[nb]);
          }
        }
#pragma unroll
        for (int nb = 0; nb < 4; ++nb) {
          float er = 0.f, ei = 0.f;
#pragma unroll
          for (int j = 0; j < 4; ++j) {
            er += bre[nb][j] * z[nb][j] - bim[nb][j] * z[nb + 4][j];
            ei += bre[nb][j] * z[nb + 4][j] + bim[nb][j] * z[nb][j];
          }
          er += __shfl_xor(er, 16);
          er += __shfl_xor(er, 32);
          ei += __shfl_xor(ei, 16);
          ei += __shfl_xor(ei, 32);
          if (quad == 0) {
            bound[(dir * 18 + c + 1) * 128 + nb * 16 + l15] = er;
            bound[(dir * 18 + c + 1) * 128 + 64 + nb * 16 + l15] = ei;
          }
        }
      }
    }
  }
  __syncthreads();
  if (tid < 128) {
    const int d = tid >> 6, pp = tid & 63;
    const float* at = (const float*)(p.ws + OFF_S5AT) + (size_t)((l * 2 + d) * 32 + g) * 128;
    const float tr = at[pp * 2], ti = at[pp * 2 + 1];
    float xr = 0.f, xi = 0.f;
    bound[(d * 18) * 128 + pp] = 0.f;
    bound[(d * 18) * 128 + 64 + pp] = 0.f;
    for (int c = 1; c < 18; ++c) {
      const float er = bound[(d * 18 + c) * 128 + pp], ei = bound[(d * 18 + c) * 128 + 64 + pp];
      const float nr = tr * xr - ti * xi + er;
      const float ni = tr * xi + ti * xr + ei;
      xr = nr;
      xi = ni;
      bound[(d * 18 + c) * 128 + pp] = xr;
      bound[(d * 18 + c) * 128 + 64 + pp] = xi;
    }
  }
  __syncthreads();
  const float dsk = p.s5_d[l * 512 + g * 16 + l15];
  for (int tc = (last ? 2 : 0) + w; tc < 18; tc += 4) {
#pragma unroll
    for (int i = 0; i < 8; ++i) yacc[i] = f32x4{0.f, 0.f, 0.f, 0.f};
    {
      S5Frag f;
      s5_load_frag(p, f, (l * 2 + 0) * 32 + g, true);
      const int cseq = tc;
      float xr = bound[(0 * 18 + cseq) * 128 + lane], xi = bound[(0 * 18 + cseq) * 128 + 64 + lane];
      s5_chunk<0, true>(proj, b, g, cseq, f, xr, xi, BUs, Xs, yacc);
    }
    {
      S5Frag f;
      s5_load_frag(p, f, (l * 2 + 1) * 32 + g, true);
      const int cseq = (tc < 2) ? 1 - tc : 19 - tc;
      float xr = bound[(1 * 18 + cseq) * 128 + lane], xi = bound[(1 * 18 + cseq) * 128 + 64 + lane];
      s5_chunk<1, true>(proj, b, g, cseq, f, xr, xi, BUs, Xs, yacc);
    }
    const int rowbase = (tc < 2) ? b * 256 + tc * 128 : R_CTX + b * 2048 + (tc - 2) * 128;
#pragma unroll
    for (int tsb = 0; tsb < 8; ++tsb)
#pragma unroll
      for (int j = 0; j < 4; ++j) {
        const int row = rowbase + tsb * 16 + quad * 4 + j;
        const float uu = bf2f(proj[(size_t)row * PJ + PC_U + g * 16 + l15]);
        const float y = yacc[tsb][j] + dsk * uu;
        const float zz = 0.7978845608028654f * (y + 0.044715f * y * y * y);
        const float gl = y / (1.f + __expf(-2.f * zz));
        G[(size_t)row * 512 + g * 16 + l15] = f2bf(gl);
      }
  }
}

#define EPI_LOOP(NI_)                                                        \
  _Pragma("unroll") for (int mi = 0; mi < 4; ++mi)                           \
  _Pragma("unroll") for (int ni = 0; ni < NI_; ++ni)                         \
  _Pragma("unroll") for (int j = 0; j < 4; ++j)

__global__ void __launch_bounds__(256, 2) fwd_megakernel(Params p) {
  cg::grid_group grid = cg::this_grid();
  __shared__ __attribute__((aligned(16))) unsigned char smem[SMEM_BYTES];
  __shared__ int s_item;
  __shared__ uint4 xb_words;
  if (threadIdx.x == 0) xb_words = make_uint4(0u, 0u, 0u, 0u);
  __syncthreads();
  const XcdBarrier xb = xcd_barrier_post((unsigned*)(p.ws + OFF_BAR), (volatile LAS unsigned*)&xb_words);
  const int nblk = gridDim.x, bid = blockIdx.x;
  const int lbid = bid;
#define sA ((bf16_t*)smem)
#define sB (((bf16_t*)smem) + 128 * 72)
#define W ((const bf16_t*)(p.ws + OFF_W))
#define hbuf ((bf16_t*)(p.ws + OFF_H))
#define Gbuf ((bf16_t*)(p.ws + OFF_G))
#define proj ((bf16_t*)(p.ws + OFF_PROJ))
#define mbuf ((bf16_t*)(p.ws + OFF_VT))
#define hid ((bf16_t*)(p.ws + OFF_PROJ))
#define ctxs ((float*)(p.ws + OFF_CTXS))
#define modp ((const float*)(p.ws + OFF_MOD))
#define cnt ((int*)(p.ws + OFF_CNT))

#pragma unroll 1
  for (int rep = 0, nrep = REPS61; rep < nrep; ++rep) {
    TIDVARS
    for (int i = (tid < 2 ? bid * 2 + tid : 1024); i < 1024; i += nblk * 2) {
      const int coord = i >> 4, fi = i & 15;
      const float inv = powf(10000.f, -(float)fi / 16.f);
      const float ang = (float)coord * inv;
      float* rot = (float*)(p.ws + OFF_ROT);
      rot[i] = cosf(ang);
      rot[1024 + i] = sinf(ang);
    }
    for (int i = (tid < 16 ? bid * 16 + tid : 8192); i < 8192; i += nblk * 16) s5_tables(p, i);
    for (int it = bid; it < 192; it += nblk) mod_item(p, it, (float*)smem);
    wconv_range(p, 0, (bid + 320) % nblk, nblk, 4480, (float*)smem);
    if (p.fnorm == nullptr) grid.sync();
    xcd_barrier(xb);
  }

  for (int l = 0; l < 2; ++l) {
    const bool last = (l == 1);
    const float* src_ctx = (l == 0) ? p.ctx : ctxs;
    const float* src_x = (l == 0) ? p.x : p.out;
    const int mt_min = last ? 16 : 0;

#pragma unroll 1
    for (int rep = 0, nrep = REPS62; rep < nrep; ++rep) {
      TIDVARS
      const int nnorm = R_ALL / 8;
      for (int it = bid; it < nnorm; it += nblk) norm_rows(p, l, 0, it * 8 + w, src_ctx, src_x);
      if (last) wconv_range(p, 1, bid, nblk, 4480, (float*)smem);
      xcd_barrier(xb);
    }

#pragma unroll 1
    for (int rep = 0, nrep = REPS(1); rep < nrep; ++rep) {
      for (int tile = lbid; tile < 72 * 28; tile += nblk) {
        const int mt = tile / 28, nt = tile % 28;
        if (last && mt < 8 && nt >= 18) continue;
        inproj_tile(p, mt, nt, (bf16_t*)smem);
      }
      xcd_barrier(xb);
    }

#pragma unroll 1
    for (int rep = 0, nrep = (PROBE >= 21 && PROBE <= 23) ? (1 + (int)(p.fnorm != nullptr)) : REPS(2); rep < nrep; ++rep) {
      TIDVARS
      const bool dry = rep > 0;
      const int n_s5 = 256;
      const int n_ret = 512 + (last ? 0 : 64);
      const int n_na = 2048 + (last ? 0 : 256);
      const int total = n_s5 + n_ret + n_na;
      while (true) {
        __syncthreads();
        if (tid == 0) s_item = atomicAdd(&cnt[l + 2 * rep], 1);
        __syncthreads();
        int it = s_item;
#if PROBE == 21
        if (rep > 0 && it >= n_s5) break;
#elif PROBE == 22
        if (rep > 0) { it += n_s5; if (it >= n_s5 + n_ret) break; }
#elif PROBE == 23
        if (rep > 0) it += n_s5 + n_ret;
#endif
        if (it >= total) break;
        if (it < n_s5) {
          __builtin_amdgcn_s_setprio(3);
          s5_item(p, l, it >> 5, it & 31, last, smem);
          __builtin_amdgcn_s_setprio(0);
        } else if (it < n_s5 + n_ret) {
          it -= n_s5;
          const bool ic = it >= 512;
          const int i2 = it - 512;
          ret_item(p, l, ic ? (i2 >> 3) : (it >> 6), ic ? ((i2 >> 1) & 3) : ((it >> 4) & 3), ic ? (i2 & 1) : (it & 15), ic, dry, smem);
        } else {
          it -= n_s5 + n_ret;
          const bool ic = it >= 2048;
          const int i2 = it - 2048;
          na_item(p, l, ic ? (i2 >> 5) : (it >> 8), ic ? ((i2 >> 2) & 7) : ((it >> 5) & 7), ic ? (i2 & 3) : (it & 31), ic, dry, smem);
        }
      }
      xcd_barrier(xb);
    }

#pragma unroll 1
    for (int rep = 0, nrep = REPS(5); rep < nrep; ++rep) {
      for (int tile = lbid + mt_min * 4; tile < 144 * 4; tile += nblk) {
        const int mt = tile >> 2, nt = tile & 3;
        f32x4 acc[4][4];
        zero_acc<4>(acc);
        gemm_core_v1<4, true>(acc, Gbuf + (size_t)mt * 128 * 512, 512, W + W_GLU + (size_t)nt * 128 * 512, 512, 512, (bf16_t*)smem);
        TIDVARS
        float4 bgl[4];
#pragma unroll
        for (int ni = 0; ni < 4; ++ni) bgl[ni] = *(const float4*)(p.b_glu + l * 512 + nt * 128 + wn * 64 + ni * 16 + quad * 4);
#pragma unroll
        for (int mi = 0; mi < 4; ++mi) {
          const int r = mt * 128 + wm * 64 + mi * 16 + l15;
          uint2 gg[4];
#pragma unroll
          for (int ni = 0; ni < 4; ++ni) gg[ni] = *(const uint2*)(Gbuf + (size_t)r * 512 + nt * 128 + wn * 64 + ni * 16 + quad * 4);
#pragma unroll
          for (int ni = 0; ni < 4; ++ni) {
            const int c = nt * 128 + wn * 64 + ni * 16 + quad * 4;
            const float g0 = __uint_as_float(gg[ni].x << 16), g1 = __uint_as_float(gg[ni].x & 0xffff0000u);
            const float g2 = __uint_as_float(gg[ni].y << 16), g3 = __uint_as_float(gg[ni].y & 0xffff0000u);
            uint2 o;
            o.x = pack2(g0 * sigm(acc[mi][ni][0] + bgl[ni].x), g1 * sigm(acc[mi][ni][1] + bgl[ni].y));
            o.y = pack2(g2 * sigm(acc[mi][ni][2] + bgl[ni].z), g3 * sigm(acc[mi][ni][3] + bgl[ni].w));
            *(uint2*)(proj + (size_t)r * PJ + PC_U + c) = o;
          }
        }
      }
      xcd_barrier(xb);
    }

#pragma unroll 1
    for (int rep = 0, nrep = REPS(3); rep < nrep; ++rep) {
      for (int tile = lbid + mt_min * 16; tile < 144 * 16; tile += nblk) {
        const int mt = tile >> 4, nt = tile & 15;
        f32x4 sg[3][4][2];
#pragma unroll
        for (int g = 0; g < 3; ++g) zero_acc<2>(sg[g]);
        gemm_core_g3(sg, hbuf + (size_t)mt * 128 * 1024, 1024, W + W_IN + (size_t)(3584 + nt * 64) * 1024,
                     (size_t)1024 * 1024, 1024, 1024, (bf16_t*)smem);
        unsigned sgp[3][4][2][2];
#pragma unroll
        for (int g = 0; g < 3; ++g)
#pragma unroll
          for (int mi = 0; mi < 4; ++mi)
#pragma unroll
            for (int ni = 0; ni < 2; ++ni) {
              sgp[g][mi][ni][0] = pack2(sigm(sg[g][mi][ni][0]), sigm(sg[g][mi][ni][1]));
              sgp[g][mi][ni][1] = pack2(sigm(sg[g][mi][ni][2]), sigm(sg[g][mi][ni][3]));
            }
        f32x4 tot[4][2];
        zero_acc<2>(tot);
#pragma unroll 1
        for (int i = 0; i < 3; ++i) {
          f32x4 ab[4][2];
          zero_acc<2>(ab);
          const bf16_t* Ai = proj + (size_t)mt * 128 * PJ + (i == 0 ? PC_U : (i == 1 ? PC_RG : PC_NQ));
          const bf16_t* Wi = W + (i == 0 ? W_BS5 : (i == 1 ? W_BRET : W_BNA)) + (size_t)nt * 64 * 512;
          gemm_core_v1<2, true>(ab, Ai, PJ, Wi, 512, 512, (bf16_t*)smem);
#pragma unroll
          for (int mi = 0; mi < 4; ++mi)
#pragma unroll
            for (int ni = 0; ni < 2; ++ni) {
              const unsigned u0 = sgp[0][mi][ni][0], u1 = sgp[0][mi][ni][1];
              tot[mi][ni][0] += __uint_as_float(u0 << 16) * ab[mi][ni][0];
              tot[mi][ni][1] += __uint_as_float(u0 & 0xffff0000u) * ab[mi][ni][1];
              tot[mi][ni][2] += __uint_as_float(u1 << 16) * ab[mi][ni][2];
              tot[mi][ni][3] += __uint_as_float(u1 & 0xffff0000u) * ab[mi][ni][3];
              sgp[0][mi][ni][0] = sgp[1][mi][ni][0];
              sgp[0][mi][ni][1] = sgp[1][mi][ni][1];
              sgp[1][mi][ni][0] = sgp[2][mi][ni][0];
              sgp[1][mi][ni][1] = sgp[2][mi][ni][1];
            }
        }
        TIDVARS
#pragma unroll
        for (int mi = 0; mi < 4; ++mi)
#pragma unroll
          for (int ni = 0; ni < 2; ++ni) {
            const int r = mt * 128 + wm * 64 + mi * 16 + l15;
            const int c = nt * 64 + wn * 32 + ni * 16 + quad * 4;
            uint2 o;
            o.x = pack2(tot[mi][ni][0], tot[mi][ni][1]);
            o.y = pack2(tot[mi][ni][2], tot[mi][ni][3]);
            *(uint2*)(mbuf + (size_t)r * 1024 + c) = o;
          }
      }
      xcd_barrier(xb);
    }

#pragma unroll 1
    for (int rep = 0, nrep = REPS(5); rep < nrep; ++rep) {
      const bool dry = rep > 0;
      float* dctx = dry ? (float*)(p.ws + WS_END) : ctxs;
      float* dx = dry ? (float*)(p.ws + WS_END) : p.out;
      const size_t omask = dry ? (size_t)0x7FFFFF : ~(size_t)0;
      if (!dry) {
        for (int tile = lbid + 64; tile < 72 * 8; tile += nblk)
          resid_big_tile(p, l, tile >> 3, tile & 7, mbuf, 1024, W + W_OUT, 1024, 1024, 2048, src_x, p.out, (bf16_t*)smem);
      }
      for (int tile = lbid + mt_min * 8; tile < (dry ? 144 : 16) * 8; tile += nblk) {
        const int mt = tile >> 3, nt = tile & 7;
        f32x4 acc[4][4];
        zero_acc<4>(acc);
        gemm_core_v1<4, true>(acc, mbuf + (size_t)mt * 128 * 1024, 1024, W + W_OUT + (size_t)nt * 128 * 1024, 1024, 1024, (bf16_t*)smem);
        TIDVARS
        const bool isc = mt < 16;
        const int modrow = isc ? 8 : (mt - 16) >> 4;
        const float* sbase = isc ? src_ctx : src_x;
        float* dbase = isc ? dctx : dx;
        float4 gv[4];
#pragma unroll
        for (int ni = 0; ni < 4; ++ni)
          gv[ni] = *(const float4*)(modp + (size_t)(l * 9 + modrow) * 6144 + 2048 + nt * 128 + wn * 64 + ni * 16 + quad * 4);
#pragma unroll
        for (int mi = 0; mi < 4; ++mi) {
          const int r = mt * 128 + wm * 64 + mi * 16 + l15;
          const size_t o = (size_t)(isc ? r : r - R_CTX) * 1024 + nt * 128 + wn * 64 + quad * 4;
          float4 sv[4];
#pragma unroll
          for (int ni = 0; ni < 4; ++ni) sv[ni] = *(const float4*)(sbase + o + ni * 16);
#pragma unroll
          for (int ni = 0; ni < 4; ++ni) {
            float4 ov;
            ov.x = sv[ni].x + gv[ni].x * acc[mi][ni][0];
            ov.y = sv[ni].y + gv[ni].y * acc[mi][ni][1];
            ov.z = sv[ni].z + gv[ni].z * acc[mi][ni][2];
            ov.w = sv[ni].w + gv[ni].w * acc[mi][ni][3];
            *(float4*)(dbase + ((o + ni * 16) & omask)) = ov;
          }
        }
      }
      xcd_barrier(xb);
    }

#pragma unroll 1
    for (int rep = 0, nrep = REPS63; rep < nrep; ++rep) {
      for (int it = bid + mt_min * 16; it < R_ALL / 8; it += nblk) {
        TIDVARS
        norm_rows(p, l, 1, it * 8 + w, ctxs, p.out);
      }
      xcd_barrier(xb);
    }

#pragma unroll 1
    for (int rep = 0, nrep = REPS(4); rep < nrep; ++rep) {
      for (int tile = lbid + (mt_min >> 1) * 44; tile < 72 * 44; tile += nblk) {
        const int mt = tile / 44, nt = tile % 44;
        f32x4 acc[8][4];
#pragma unroll
        for (int mi = 0; mi < 8; ++mi)
#pragma unroll
          for (int ni = 0; ni < 4; ++ni) acc[mi][ni] = f32x4{0.f, 0.f, 0.f, 0.f};
        gemm_core_big<true>(acc, hbuf + (size_t)mt * 256 * 1024, 1024, W + W_FG + (size_t)nt * 128 * 1024, 1024, 1024, (bf16_t*)smem);
        TIDVARS
#pragma unroll
        for (int mi = 0; mi < 8; ++mi)
#pragma unroll
          for (int ni = 0; ni < 2; ++ni) {
            const int r = mt * 256 + wm * 128 + mi * 16 + l15;
            const int c = nt * 64 + wn * 32 + ni * 16 + quad * 4;
            uint2 o;
            o.x = pack2(siluf_(acc[mi][ni][0]) * acc[mi][ni + 2][0], siluf_(acc[mi][ni][1]) * acc[mi][ni + 2][1]);
            o.y = pack2(siluf_(acc[mi][ni][2]) * acc[mi][ni + 2][2], siluf_(acc[mi][ni][3]) * acc[mi][ni + 2][3]);
            *(uint2*)(hid + (size_t)r * FFN + c) = o;
          }
      }
      xcd_barrier(xb);
    }

#pragma unroll 1
    for (int rep = 0, nrep = REPS(5); rep < nrep; ++rep) {
      const bool dry = rep > 0;
      float* dctx = dry ? (float*)(p.ws + WS_END) : ctxs;
      float* dx = dry ? (float*)(p.ws + WS_END) : p.out;
      const size_t omask = dry ? (size_t)0x7FFFFF : ~(size_t)0;
      if (!dry) {
        for (int tile = lbid + 64; tile < 72 * 8; tile += nblk)
          resid_big_tile(p, l, tile >> 3, tile & 7, hid, FFN, W + W_FD, FFN, FFN, 5120, p.out, p.out, (bf16_t*)smem);
      }
      for (int tile = lbid + mt_min * 8; tile < (dry ? 144 : 16) * 8; tile += nblk) {
        const int mt = tile >> 3, nt = tile & 7;
        f32x4 acc[4][4];
        zero_acc<4>(acc);
        gemm_core_v1<4, true>(acc, hid + (size_t)mt * 128 * FFN, FFN, W + W_FD + (size_t)nt * 128 * FFN, FFN, FFN, (bf16_t*)smem);
        TIDVARS
        const bool isc = mt < 16;
        const int modrow = isc ? 8 : (mt - 16) >> 4;
        const float* sbase = isc ? (const float*)ctxs : (const float*)p.out;
        float* dbase = isc ? dctx : dx;
        float4 gv[4];
#pragma unroll
        for (int ni = 0; ni < 4; ++ni)
          gv[ni] = *(const float4*)(modp + (size_t)(l * 9 + modrow) * 6144 + 5120 + nt * 128 + wn * 64 + ni * 16 + quad * 4);
#pragma unroll
        for (int mi = 0; mi < 4; ++mi) {
          const int r = mt * 128 + wm * 64 + mi * 16 + l15;
          const size_t o = (size_t)(isc ? r : r - R_CTX) * 1024 + nt * 128 + wn * 64 + quad * 4;
          float4 sv[4];
#pragma unroll
          for (int ni = 0; ni < 4; ++ni) sv[ni] = *(const float4*)(sbase + o + ni * 16);
#pragma unroll
          for (int ni = 0; ni < 4; ++ni) {
            float4 ov;
            ov.x = sv[ni].x + gv[ni].x * acc[mi][ni][0];
            ov.y = sv[ni].y + gv[ni].y * acc[mi][ni][1];
            ov.z = sv[ni].z + gv[ni].z * acc[mi][ni][2];
            ov.w = sv[ni].w + gv[ni].w * acc[mi][ni][3];
            *(float4*)(dbase + ((o + ni * 16) & omask)) = ov;
          }
        }
      }
      xcd_barrier(xb);
    }
#if PROBE == 7
    for (int i = 0; i < 10; ++i) xcd_barrier(xb);
#endif
  }

  for (int it = bid; it < (NB * SEQ) / 4; it += nblk) {
    TIDVARS
    const int r = it * 4 + w;
    float* row = p.out + (size_t)r * 1024;
    float4 v[4];
    float ss = 0.f;
#pragma unroll
    for (int i = 0; i < 4; ++i) {
      v[i] = *(const float4*)(row + i * 256 + lane * 4);
      ss += v[i].x * v[i].x + v[i].y * v[i].y + v[i].z * v[i].z + v[i].w * v[i].w;
    }
    ss = wave_sum(ss);
    const float rstd = rsqrtf(ss * (1.f / 1024.f) + 1e-6f);
#pragma unroll
    for (int i = 0; i < 4; ++i) {
      const float4 fn = *(const float4*)(p.fnorm + i * 256 + lane * 4);
      float4 o;
      o.x = v[i].x * rstd * fn.x;
      o.y = v[i].y * rstd * fn.y;
      o.z = v[i].z * rstd * fn.z;
      o.w = v[i].w * rstd * fn.w;
      *(float4*)(row + i * 256 + lane * 4) = o;
    }
  }
}

extern "C" void kernel_launch(void* const* d_in, const int* in_sizes, int n_in, void* d_out, int out_size,
                              void* d_ws, size_t ws_size, hipStream_t stream) {
  static int grid_blocks = 0;
  if (!grid_blocks) {
    int dev = 0, cus = 0, per_cu = 0;
    hipGetDevice(&dev);
    hipDeviceGetAttribute(&cus, hipDeviceAttributeMultiprocessorCount, dev);
    hipOccupancyMaxActiveBlocksPerMultiprocessor(&per_cu, fwd_megakernel, 256, 0);
    if (per_cu > 2) per_cu = 2;
    if (per_cu < 1) per_cu = 1;
    grid_blocks = cus * per_cu;
  }
  if (ws_size < WS_END) fprintf(stderr, "workspace too small: %zu < %zu\n", ws_size, (size_t)WS_END);
  Params p{};
  const float** pp = (const float**)&p;
  for (int i = 0; i < 27; ++i) pp[i] = (const float*)d_in[i];
  p.out = (float*)d_out;
  p.ws = (unsigned char*)d_ws;
  hipMemsetAsync((unsigned char*)d_ws + OFF_CNT, 0, 256 + 16384, stream);
  void* args[] = {&p};
  hipError_t e = hipLaunchCooperativeKernel((void*)fwd_megakernel, dim3(grid_blocks), dim3(256), args, 0, stream);
  if (e != hipSuccess) fprintf(stderr, "cooperative launch failed: %s (grid %d)\n", hipGetErrorString(e), grid_blocks);
}
```

```cpp
#include <hip/hip_runtime.h>
#include <hip/hip_cooperative_groups.h>
#include <cstdio>
#include <cstdint>
namespace cg = cooperative_groups;

typedef unsigned short bf16_t;
using bf16x8 = __attribute__((ext_vector_type(8))) short;
using f32x4 = __attribute__((ext_vector_type(4))) float;

#ifndef PROBE
#define PROBE 0
#endif
#define REPS(n) ((PROBE == (n)) ? (1 + (int)(p.fnorm != nullptr)) : 1)
#define REPS61 ((PROBE == 6 || PROBE == 61) ? (1 + (int)(p.fnorm != nullptr)) : 1)
#define REPS62 ((PROBE == 6 || PROBE == 62) ? (1 + (int)(p.fnorm != nullptr)) : 1)
#define REPS63 ((PROBE == 6 || PROBE == 63) ? (1 + (int)(p.fnorm != nullptr)) : 1)
#define MFMA16(a, b, c) __builtin_amdgcn_mfma_f32_16x16x32_bf16((a), (b), (c), 0, 0, 0)

constexpr int NB = 8, SEQ = 2048, CTXL = 256;
constexpr int R_CTX = NB * CTXL;
constexpr int R_ALL = R_CTX + NB * SEQ;
constexpr int N_IN = 6656, FFN = 2816;
constexpr int PJ = 2560;
constexpr int PC_U = 0, PC_RK = 512, PC_NK = 768, PC_RQ = 1280, PC_RG = 1536, PC_NQ = 2048;

constexpr size_t OFF_CTXS = 0;
constexpr size_t OFF_MOD = 8388608;
constexpr size_t OFF_ROT = OFF_MOD + 442368;
constexpr size_t OFF_CNT = OFF_ROT + 8192;
constexpr size_t OFF_BAR = OFF_CNT + 256;
constexpr size_t OFF_S5BB = OFF_BAR + 16384;
constexpr size_t OFF_S5CM = OFF_S5BB + 524288;
constexpr size_t OFF_S5AB = OFF_S5CM + 524288;
constexpr size_t OFF_S5AT = OFF_S5AB + 65536;
constexpr size_t OFF_W = OFF_S5AT + 65536;
constexpr size_t OFF_H = OFF_W + 36700160;
constexpr size_t OFF_G = OFF_H + 37748736;
constexpr size_t OFF_PROJ = OFF_G + 18874368;
constexpr size_t OFF_VT = OFF_PROJ + 94371840;
constexpr size_t OFF_UT = OFF_VT + 37748736;
constexpr size_t OFF_S5V = OFF_UT + 18874368;
constexpr size_t WS_END = OFF_S5V + 4194304;

constexpr int W_IN = 0, W_GLU = 6815744, W_BS5 = 7077888, W_BRET = 7602176, W_BNA = 8126464,
              W_OUT = 8650752, W_FG = 9699328, W_FU = 12582912, W_FD = 15466496;

constexpr int SMEM_BYTES = 73728;

struct Params {
  const float *x, *c, *ctx, *c_ctx, *w_ada, *b_ada, *w_in, *lam_re, *lam_im, *log_dt, *b_re, *b_im,
      *c_re, *c_im, *s5_d, *w_glu, *b_glu, *theta, *rpb, *w_bs5, *w_bret, *w_bna, *w_out, *w_fg,
      *w_fu, *w_fd, *fnorm;
  float* out;
  unsigned char* ws;
};

__device__ __forceinline__ bf16_t f2bf(float f) {
  unsigned u = __float_as_uint(f);
  u += 0x7fffu + ((u >> 16) & 1u);
  return (bf16_t)(u >> 16);
}
__device__ __forceinline__ float bf2f(bf16_t h) { return __uint_as_float(((unsigned)h) << 16); }
__device__ __forceinline__ float sigm(float x) { return __builtin_amdgcn_rcpf(1.f + __expf(-x)); }
__device__ __forceinline__ float siluf_(float x) { return x * sigm(x); }
typedef __bf16 bf16x2_t __attribute__((ext_vector_type(2)));
typedef float f32x2_t __attribute__((ext_vector_type(2)));
__device__ __forceinline__ unsigned pack2(float a, float b) {
  f32x2_t v = {a, b};
  bf16x2_t r = __builtin_convertvector(v, bf16x2_t);
  return __builtin_bit_cast(unsigned, r);
}
__device__ __forceinline__ bf16x8 pack8(const float (&v)[8]) {
  union { unsigned u[4]; bf16x8 h; } x;
  x.u[0] = pack2(v[0], v[1]);
  x.u[1] = pack2(v[2], v[3]);
  x.u[2] = pack2(v[4], v[5]);
  x.u[3] = pack2(v[6], v[7]);
  return x.h;
}

__device__ __forceinline__ int opaque_tid() {
  int x = threadIdx.x;
  asm volatile("" : "+v"(x));
  return x;
}
#define TIDVARS                                                                          \
  const int tid = opaque_tid(), lane = tid & 63, w = tid >> 6, wm = w >> 1, wn = w & 1; \
  const int l15 = lane & 15, quad = lane >> 4;                                           \
  (void)wm; (void)wn; (void)l15; (void)quad; (void)lane; (void)w;

#define XB_TMO      128
#define XB_XCNT(j)  (256  + 64 * (j))
#define XB_XSUB(j)  (1280 + 64 * (j))
#define XB_XGEN(j)  (2304 + 64 * (j))
#define XB_TOP      3328
#define XB_TOPGEN   3392
#define XCD_BAR_WORDS 3456
#define XB_SPIN_CAP (1u << 22)
#define LAS __attribute__((address_space(3)))

__device__ __forceinline__ unsigned xb_ld(unsigned* p) { return __hip_atomic_load(p, __ATOMIC_RELAXED, __HIP_MEMORY_SCOPE_AGENT); }
__device__ __forceinline__ unsigned xb_add(unsigned* p, unsigned v) { return __hip_atomic_fetch_add(p, v, __ATOMIC_RELAXED, __HIP_MEMORY_SCOPE_AGENT); }
__device__ __forceinline__ unsigned xb_xcc_id() { return (unsigned)__builtin_amdgcn_s_getreg((3 << 11) | 20) & 0xFu; }
#define XB_SPIN(cond, bar) do { unsigned _sp = 0; while (cond) { __builtin_amdgcn_s_sleep(1); \
    if ((++_sp & 255u) == 0u) { if (xb_ld(&(bar)[XB_TMO])) break; if (_sp > XB_SPIN_CAP) { atomicAdd(&(bar)[XB_TMO], 1u); break; } } } } while (0)

struct XcdBarrier {
  unsigned* bar; unsigned x;
  volatile LAS unsigned* st;
};
__device__ __forceinline__ XcdBarrier xcd_barrier_post(unsigned* bar, volatile LAS unsigned* st) {
  XcdBarrier b; b.bar = bar; b.x = xb_xcc_id(); b.st = st;
  if (threadIdx.x == 0) (void)xb_add(&bar[XB_XCNT(b.x)], 1u);
  return b;
}
__device__ __forceinline__ void xcd_barrier_complete(unsigned* bar, unsigned x, unsigned& nloc, unsigned& nx) {
  const unsigned G = gridDim.x * gridDim.y * gridDim.z;
  unsigned sum, cnt_, mine, sp = 0u;
  for (;;) {
    sum = 0u; cnt_ = 0u; mine = 0u;
#pragma unroll
    for (unsigned j = 0; j < 16; ++j) { const unsigned c = xb_ld(&bar[XB_XCNT(j)]); sum += c; cnt_ += (c > 0u) ? 1u : 0u; mine = (j == x) ? c : mine; }
    if (sum == G) break;
    __builtin_amdgcn_s_sleep(1);
    if ((++sp & 255u) == 0u) { if (xb_ld(&bar[XB_TMO])) break; if (sp > XB_SPIN_CAP) { atomicAdd(&bar[XB_TMO], 1u); break; } }
  }
  nloc = mine > 0u ? mine : 1u; nx = cnt_ > 0u ? cnt_ : 1u;
}
__device__ __forceinline__ void xcd_barrier(const XcdBarrier& b) {
  asm volatile("s_waitcnt vmcnt(0)" ::: "memory");
  __syncthreads();
  if (threadIdx.x == 0) {
    unsigned* bar = b.bar;
    __builtin_amdgcn_s_waitcnt(0);
    unsigned nloc = b.st[0], nx = b.st[1];
    if (nloc == 0u) { xcd_barrier_complete(bar, b.x, nloc, nx); b.st[0] = nloc; b.st[1] = nx; }
    const unsigned old = xb_add(&bar[XB_XSUB(b.x)], 1u);
    const unsigned gen = old / nloc;
    if (old + 1u == (gen + 1u) * nloc) {
      __builtin_amdgcn_fence(__ATOMIC_RELEASE, "agent");
      asm volatile("s_waitcnt vmcnt(0)" ::: "memory");
      const unsigned og = xb_add(&bar[XB_TOP], 1u);
      const unsigned tg = og / nx;
      if (og + 1u == (tg + 1u) * nx) xb_add(&bar[XB_TOPGEN], 1u);
      else XB_SPIN(xb_ld(&bar[XB_TOPGEN]) == tg, bar);
      __builtin_amdgcn_fence(__ATOMIC_ACQUIRE, "agent");
      xb_add(&bar[XB_XGEN(b.x)], 1u);
      asm volatile("s_waitcnt vmcnt(0)" ::: "memory");
    } else {
      XB_SPIN(xb_ld(&bar[XB_XGEN(b.x)]) == gen, bar);
      __builtin_amdgcn_fence(__ATOMIC_ACQUIRE, "agent");
      asm volatile("s_waitcnt vmcnt(0)" ::: "memory");
    }
  }
  __syncthreads();
}

constexpr int GEMM_STG = 18432;
template <int NI, bool SWAP>
__device__ __forceinline__ void gemm_core(f32x4 (&acc)[4][NI], const bf16_t* __restrict__ A, int lda,
                                          const bf16_t* __restrict__ Bt, int ldb, int K, bf16_t* sm) {
  constexpr int LS = 72;
  TIDVARS
  const int lrow = tid >> 3, lcc = tid & 7;
  const bf16_t* ap = A + (size_t)lrow * lda + lcc * 8;
  const bf16_t* bp = Bt + (size_t)lrow * ldb + lcc * 8;
  const size_t as = (size_t)32 * lda, bs = (size_t)32 * ldb;
  const int nk = K >> 6;
  uint4 xa0, xa1, xa2, xa3, xb0, xb1, xb2, xb3, ya0, ya1, ya2, ya3, yb0, yb1, yb2, yb3;
#define G_ISSUE(P, kt)                                              \
  {                                                                 \
    const int k_ = (((kt) < nk) ? (kt) : nk - 1) << 6;              \
    P##a0 = *(const uint4*)(ap + k_);                               \
    P##a1 = *(const uint4*)(ap + as + k_);                          \
    P##a2 = *(const uint4*)(ap + 2 * as + k_);                      \
    P##a3 = *(const uint4*)(ap + 3 * as + k_);                      \
    P##b0 = *(const uint4*)(bp + k_);                               \
    P##b1 = *(const uint4*)(bp + bs + k_);                          \
    if (NI > 2) {                                                   \
      P##b2 = *(const uint4*)(bp + 2 * bs + k_);                    \
      P##b3 = *(const uint4*)(bp + 3 * bs + k_);                    \
    }                                                               \
  }
#define G_WRITE(P, stage)                                           \
  {                                                                 \
    bf16_t* d_ = sm + (stage) * GEMM_STG + lrow * LS + lcc * 8;     \
    *(uint4*)(d_) = P##a0;                                          \
    *(uint4*)(d_ + 32 * LS) = P##a1;                                \
    *(uint4*)(d_ + 64 * LS) = P##a2;                                \
    *(uint4*)(d_ + 96 * LS) = P##a3;                                \
    *(uint4*)(d_ + 128 * LS) = P##b0;                               \
    *(uint4*)(d_ + 160 * LS) = P##b1;                               \
    if (NI > 2) {                                                   \
      *(uint4*)(d_ + 192 * LS) = P##b2;                             \
      *(uint4*)(d_ + 224 * LS) = P##b3;                             \
    }                                                               \
  }
#define G_COMPUTE(stage)                                                                           \
  {                                                                                                \
    const bf16_t* sra_ = sm + (stage) * GEMM_STG + (wm * 64 + l15) * LS + quad * 8;                \
    const bf16_t* srb_ = sm + (stage) * GEMM_STG + (128 + wn * 16 * NI + l15) * LS + quad * 8;     \
    __builtin_amdgcn_s_setprio(1);                                                                 \
    _Pragma("unroll") for (int ks = 0; ks < 2; ++ks) {                                             \
      bf16x8 a_[4], b_[NI];                                                                        \
      _Pragma("unroll") for (int mi = 0; mi < 4; ++mi) a_[mi] = *(const bf16x8*)(sra_ + mi * 16 * LS + ks * 32); \
      _Pragma("unroll") for (int ni = 0; ni < NI; ++ni) b_[ni] = *(const bf16x8*)(srb_ + ni * 16 * LS + ks * 32); \
      _Pragma("unroll") for (int mi = 0; mi < 4; ++mi)                                             \
      _Pragma("unroll") for (int ni = 0; ni < NI; ++ni)                                            \
        acc[mi][ni] = SWAP ? MFMA16(b_[ni], a_[mi], acc[mi][ni]) : MFMA16(a_[mi], b_[ni], acc[mi][ni]); \
    }                                                                                              \
    __builtin_amdgcn_s_setprio(0);                                                                 \
  }
  G_ISSUE(x, 0)
  G_ISSUE(y, 1)
  __syncthreads();
  G_WRITE(x, 0)
  G_ISSUE(x, 2)
  __syncthreads();
#pragma unroll 1
  for (int kt = 0; kt < nk; kt += 2) {
    G_WRITE(y, 1)
    G_ISSUE(y, kt + 3)
    G_COMPUTE(0)
    __syncthreads();
    G_WRITE(x, 0)
    G_ISSUE(x, kt + 4)
    G_COMPUTE(1)
    __syncthreads();
  }
#undef G_ISSUE
#undef G_WRITE
#undef G_COMPUTE
}

template <bool SWAP>
__device__ __forceinline__ void gemm_core_big(f32x4 (&acc)[8][4], const bf16_t* __restrict__ A, int lda,
                                              const bf16_t* __restrict__ Bt, int ldb, int K, bf16_t* sm) {
  constexpr int LS = 80;
  TIDVARS
  const int lrow = tid >> 3, lcc = tid & 7;
  const bf16_t* ap = A + (size_t)lrow * lda + lcc * 8;
  const bf16_t* bp = Bt + (size_t)lrow * ldb + lcc * 8;
  const size_t as = (size_t)32 * lda, bs = (size_t)32 * ldb;
  uint4 ra0, ra1, ra2, ra3, ra4, ra5, ra6, ra7, rb0, rb1, rb2, rb3;
#define GB_ISSUE(k_)                              \
  ra0 = *(const uint4*)(ap + (k_));               \
  ra1 = *(const uint4*)(ap + as + (k_));          \
  ra2 = *(const uint4*)(ap + 2 * as + (k_));      \
  ra3 = *(const uint4*)(ap + 3 * as + (k_));      \
  ra4 = *(const uint4*)(ap + 4 * as + (k_));      \
  ra5 = *(const uint4*)(ap + 5 * as + (k_));      \
  ra6 = *(const uint4*)(ap + 6 * as + (k_));      \
  ra7 = *(const uint4*)(ap + 7 * as + (k_));      \
  rb0 = *(const uint4*)(bp + (k_));               \
  rb1 = *(const uint4*)(bp + bs + (k_));          \
  rb2 = *(const uint4*)(bp + 2 * bs + (k_));      \
  rb3 = *(const uint4*)(bp + 3 * bs + (k_));
  GB_ISSUE(0)
  bf16_t* swa = sm + lrow * LS + lcc * 8;
  const bf16_t* sra = sm + (wm * 128 + l15) * LS + quad * 8;
  const bf16_t* srb = sm + (256 + wn * 64 + l15) * LS + quad * 8;
#pragma unroll 1
  for (int k0 = 0; k0 < K; k0 += 64) {
    __syncthreads();
    *(uint4*)(swa) = ra0;
    *(uint4*)(swa + 32 * LS) = ra1;
    *(uint4*)(swa + 64 * LS) = ra2;
    *(uint4*)(swa + 96 * LS) = ra3;
    *(uint4*)(swa + 128 * LS) = ra4;
    *(uint4*)(swa + 160 * LS) = ra5;
    *(uint4*)(swa + 192 * LS) = ra6;
    *(uint4*)(swa + 224 * LS) = ra7;
    *(uint4*)(swa + 256 * LS) = rb0;
    *(uint4*)(swa + 288 * LS) = rb1;
    *(uint4*)(swa + 320 * LS) = rb2;
    *(uint4*)(swa + 352 * LS) = rb3;
    __syncthreads();
    const int kn = (k0 + 64 < K) ? k0 + 64 : k0;
    GB_ISSUE(kn)
    __builtin_amdgcn_s_setprio(1);
#pragma unroll
    for (int ks = 0; ks < 2; ++ks) {
      bf16x8 b_[4];
#pragma unroll
      for (int ni = 0; ni < 4; ++ni) b_[ni] = *(const bf16x8*)(srb + ni * 16 * LS + ks * 32);
#pragma unroll
      for (int mh = 0; mh < 2; ++mh) {
        bf16x8 a_[4];
#pragma unroll
        for (int mi = 0; mi < 4; ++mi) a_[mi] = *(const bf16x8*)(sra + (mh * 4 + mi) * 16 * LS + ks * 32);
#pragma unroll
        for (int mi = 0; mi < 4; ++mi)
#pragma unroll
          for (int ni = 0; ni < 4; ++ni)
            acc[mh * 4 + mi][ni] = SWAP ? MFMA16(b_[ni], a_[mi], acc[mh * 4 + mi][ni]) : MFMA16(a_[mi], b_[ni], acc[mh * 4 + mi][ni]);
      }
    }
    __builtin_amdgcn_s_setprio(0);
  }
#undef GB_ISSUE
}

template <int NI, bool SWAP>
__device__ __forceinline__ void gemm_core_v1(f32x4 (&acc)[4][NI], const bf16_t* __restrict__ A, int lda,
                                             const bf16_t* __restrict__ Bt, int ldb, int K, bf16_t* sm) {
  constexpr int LS = 80;
  TIDVARS
  bf16_t* sA_ = sm;
  bf16_t* sB_ = sm + 128 * LS;
  const int lrow = tid >> 3, lcc = tid & 7;
  const bf16_t* ap = A + (size_t)lrow * lda + lcc * 8;
  const bf16_t* bp = Bt + (size_t)lrow * ldb + lcc * 8;
  const size_t as = (size_t)32 * lda, bs = (size_t)32 * ldb;
  uint4 ra0, ra1, ra2, ra3, rb0, rb1, rb2, rb3;
  ra0 = *(const uint4*)(ap);
  ra1 = *(const uint4*)(ap + as);
  ra2 = *(const uint4*)(ap + 2 * as);
  ra3 = *(const uint4*)(ap + 3 * as);
  rb0 = *(const uint4*)(bp);
  rb1 = *(const uint4*)(bp + bs);
  if (NI > 2) {
    rb2 = *(const uint4*)(bp + 2 * bs);
    rb3 = *(const uint4*)(bp + 3 * bs);
  } else {
    rb2 = rb0;
    rb3 = rb0;
  }
  bf16_t* swa = sA_ + lrow * LS + lcc * 8;
  bf16_t* swb = sB_ + lrow * LS + lcc * 8;
  const bf16_t* sra = sA_ + (wm * 64 + l15) * LS + quad * 8;
  const bf16_t* srb = sB_ + (wn * 16 * NI + l15) * LS + quad * 8;
  for (int k0 = 0; k0 < K; k0 += 64) {
    __syncthreads();
    *(uint4*)(swa) = ra0;
    *(uint4*)(swa + 32 * LS) = ra1;
    *(uint4*)(swa + 64 * LS) = ra2;
    *(uint4*)(swa + 96 * LS) = ra3;
    *(uint4*)(swb) = rb0;
    *(uint4*)(swb + 32 * LS) = rb1;
    if (NI > 2) {
      *(uint4*)(swb + 64 * LS) = rb2;
      *(uint4*)(swb + 96 * LS) = rb3;
    }
    __syncthreads();
    const int kn = (k0 + 64 < K) ? k0 + 64 : k0;
    ra0 = *(const uint4*)(ap + kn);
    ra1 = *(const uint4*)(ap + as + kn);
    ra2 = *(const uint4*)(ap + 2 * as + kn);
    ra3 = *(const uint4*)(ap + 3 * as + kn);
    rb0 = *(const uint4*)(bp + kn);
    rb1 = *(const uint4*)(bp + bs + kn);
    if (NI > 2) {
      rb2 = *(const uint4*)(bp + 2 * bs + kn);
      rb3 = *(const uint4*)(bp + 3 * bs + kn);
    }
    __builtin_amdgcn_s_setprio(1);
#pragma unroll
    for (int ks = 0; ks < 2; ++ks) {
      bf16x8 a[4], b[NI];
#pragma unroll
      for (int mi = 0; mi < 4; ++mi) a[mi] = *(const bf16x8*)(sra + mi * 16 * LS + ks * 32);
#pragma unroll
      for (int ni = 0; ni < NI; ++ni) b[ni] = *(const bf16x8*)(srb + ni * 16 * LS + ks * 32);
#pragma unroll
      for (int mi = 0; mi < 4; ++mi)
#pragma unroll
        for (int ni = 0; ni < NI; ++ni)
          acc[mi][ni] = SWAP ? MFMA16(b[ni], a[mi], acc[mi][ni]) : MFMA16(a[mi], b[ni], acc[mi][ni]);
    }
    __builtin_amdgcn_s_setprio(0);
  }
}

__device__ __forceinline__ void gemm_core_g3(f32x4 (&acc)[3][4][2], const bf16_t* __restrict__ A, int lda,
                                             const bf16_t* __restrict__ Bt, size_t gstride, int ldb, int K, bf16_t* sm) {
  constexpr int LS = 80;
  TIDVARS
  const int lrow = tid >> 3, lcc = tid & 7;
  const bf16_t* ap = A + (size_t)lrow * lda + lcc * 8;
  const bf16_t* bp = Bt + (size_t)lrow * ldb + lcc * 8;
  const size_t as = (size_t)32 * lda, bs = (size_t)32 * ldb;
  uint4 ra0, ra1, ra2, ra3, rb0, rb1, rb2, rb3, rb4, rb5;
#define G3_ISSUE(k_)                                    \
  ra0 = *(const uint4*)(ap + (k_));                     \
  ra1 = *(const uint4*)(ap + as + (k_));                \
  ra2 = *(const uint4*)(ap + 2 * as + (k_));            \
  ra3 = *(const uint4*)(ap + 3 * as + (k_));            \
  rb0 = *(const uint4*)(bp + (k_));                     \
  rb1 = *(const uint4*)(bp + bs + (k_));                \
  rb2 = *(const uint4*)(bp + gstride + (k_));           \
  rb3 = *(const uint4*)(bp + gstride + bs + (k_));      \
  rb4 = *(const uint4*)(bp + 2 * gstride + (k_));       \
  rb5 = *(const uint4*)(bp + 2 * gstride + bs + (k_));
  G3_ISSUE(0)
  bf16_t* swa = sm + lrow * LS + lcc * 8;
  const bf16_t* sra = sm + (wm * 64 + l15) * LS + quad * 8;
  const bf16_t* srb = sm + (128 + wn * 32 + l15) * LS + quad * 8;
#pragma unroll 1
  for (int k0 = 0; k0 < K; k0 += 64) {
    __syncthreads();
    *(uint4*)(swa) = ra0;
    *(uint4*)(swa + 32 * LS) = ra1;
    *(uint4*)(swa + 64 * LS) = ra2;
    *(uint4*)(swa + 96 * LS) = ra3;
    *(uint4*)(swa + 128 * LS) = rb0;
    *(uint4*)(swa + 160 * LS) = rb1;
    *(uint4*)(swa + 192 * LS) = rb2;
    *(uint4*)(swa + 224 * LS) = rb3;
    *(uint4*)(swa + 256 * LS) = rb4;
    *(uint4*)(swa + 288 * LS) = rb5;
    __syncthreads();
    const int kn = (k0 + 64 < K) ? k0 + 64 : k0;
    G3_ISSUE(kn)
    __builtin_amdgcn_s_setprio(1);
#pragma unroll
    for (int ks = 0; ks < 2; ++ks) {
      bf16x8 a_[4];
#pragma unroll
      for (int mi = 0; mi < 4; ++mi) a_[mi] = *(const bf16x8*)(sra + mi * 16 * LS + ks * 32);
#pragma unroll
      for (int g = 0; g < 3; ++g) {
        bf16x8 b_[2];
#pragma unroll
        for (int ni = 0; ni < 2; ++ni) b_[ni] = *(const bf16x8*)(srb + (g * 64 + ni * 16) * LS + ks * 32);
#pragma unroll
        for (int mi = 0; mi < 4; ++mi)
#pragma unroll
          for (int ni = 0; ni < 2; ++ni) acc[g][mi][ni] = MFMA16(b_[ni], a_[mi], acc[g][mi][ni]);
        __builtin_amdgcn_sched_barrier(0);
      }
    }
    __builtin_amdgcn_s_setprio(0);
  }
#undef G3_ISSUE
}

template <int NI>
__device__ __forceinline__ void zero_acc(f32x4 (&acc)[4][NI]) {
#pragma unroll
  for (int mi = 0; mi < 4; ++mi)
#pragma unroll
    for (int ni = 0; ni < NI; ++ni) acc[mi][ni] = f32x4{0.f, 0.f, 0.f, 0.f};
}

__device__ __forceinline__ float wave_sum(float v) {
#pragma unroll
  for (int off = 32; off >= 1; off >>= 1) v += __shfl_xor(v, off);
  return v;
}

__device__ void s5_tables(const Params& p, int idx) {
  bf16_t* bbt = (bf16_t*)(p.ws + OFF_S5BB);
  bf16_t* cm = (bf16_t*)(p.ws + OFF_S5CM);
  float* ab = (float*)(p.ws + OFF_S5AB);
  float* at = (float*)(p.ws + OFF_S5AT);
  const int pp = idx & 63, ldg = idx >> 6;
  const float lr = p.lam_re[idx], li = p.lam_im[idx];
  const float dt = expf(p.log_dt[ldg]);
  const float mag = expf(lr * dt), ang = li * dt;
  const float abr = mag * cosf(ang), abi = mag * sinf(ang);
  const float den = lr * lr + li * li;
  const float fr = ((abr - 1.f) * lr + abi * li) / den;
  const float fi = (abi * lr - (abr - 1.f) * li) / den;
  for (int h = 0; h < 16; ++h) {
    const float br = p.b_re[(size_t)idx * 16 + h], bi = p.b_im[(size_t)idx * 16 + h];
    bbt[(size_t)ldg * 2048 + (2 * pp) * 16 + h] = f2bf(fr * br - fi * bi);
    bbt[(size_t)ldg * 2048 + (2 * pp + 1) * 16 + h] = f2bf(fr * bi + fi * br);
    const size_t ci = ((size_t)ldg * 16 + h) * 64 + pp;
    cm[(size_t)ldg * 2048 + h * 128 + 2 * pp] = f2bf(p.c_re[ci]);
    cm[(size_t)ldg * 2048 + h * 128 + 2 * pp + 1] = f2bf(-p.c_im[ci]);
  }
  ab[idx * 2] = abr;
  ab[idx * 2 + 1] = abi;
  float tr = abr, ti = abi;
  for (int i = 0; i < 7; ++i) {
    const float nr = tr * tr - ti * ti, ni = 2.f * tr * ti;
    tr = nr;
    ti = ni;
  }
  at[idx * 2] = tr;
  at[idx * 2 + 1] = ti;
  bf16_t* vt = (bf16_t*)(p.ws + OFF_S5V) + (size_t)ldg * 16384;
  const int d = (ldg >> 5) & 1;
  float qr = 1.f, qi = 0.f;
  for (int k = 0; k < 128; ++k) {
    const int tp = d ? k : 127 - k;
    vt[pp * 128 + tp] = f2bf(qr);
    vt[(64 + pp) * 128 + tp] = f2bf(qi);
    const float nr = qr * abr - qi * abi, ni = qr * abi + qi * abr;
    qr = nr;
    qi = ni;
  }
}

__device__ void mod_item(const Params& p, int item, float* smem) {
  const int l = item / 96, cgp = item % 96;
  const int tid = opaque_tid();
  float* sc = smem;
  float* red = smem + 9 * 1024;
  __syncthreads();
  for (int i = tid; i < 9 * 1024; i += 256) {
    const int r = i >> 10, k = i & 1023;
    const float v = (r < 8) ? p.c[r * 1024 + k] : p.c_ctx[k];
    sc[i] = siluf_(v);
  }
  __syncthreads();
  const int col = cgp * 64 + (tid & 63), kq = tid >> 6;
  float acc[9];
#pragma unroll
  for (int r = 0; r < 9; ++r) acc[r] = 0.f;
  const float* wp = p.w_ada + (size_t)l * 1024 * 6144 + col;
#pragma unroll 1
  for (int k0 = kq * 256; k0 < kq * 256 + 256; k0 += 16) {
    float wv[16];
#pragma unroll
    for (int u = 0; u < 16; ++u) wv[u] = __builtin_nontemporal_load(wp + (size_t)(k0 + u) * 6144);
#pragma unroll
    for (int u = 0; u < 16; ++u)
#pragma unroll
      for (int r = 0; r < 9; ++r) acc[r] += sc[r * 1024 + k0 + u] * wv[u];
  }
#pragma unroll
  for (int r = 0; r < 9; ++r) red[(kq * 9 + r) * 64 + (tid & 63)] = acc[r];
  __syncthreads();
  float* mod = (float*)(p.ws + OFF_MOD);
  for (int i = tid; i < 9 * 64; i += 256) {
    const int r = i >> 6, cc = i & 63;
    const float s = red[(0 * 9 + r) * 64 + cc] + red[(1 * 9 + r) * 64 + cc] + red[(2 * 9 + r) * 64 + cc] +
                    red[(3 * 9 + r) * 64 + cc];
    mod[(size_t)(l * 9 + r) * 6144 + cgp * 64 + cc] = s + p.b_ada[l * 6144 + cgp * 64 + cc];
  }
}

__device__ __forceinline__ float4 nt_ld4(const float* p_) {
  const f32x4 v = __builtin_nontemporal_load((const f32x4*)p_);
  return float4{v[0], v[1], v[2], v[3]};
}
struct WcDesc { const float* src; int K, N, dst, gu, kt, nt; };
__device__ __forceinline__ WcDesc wc_decode(const Params& p, int l, int it) {
  WcDesc d;
  d.gu = -1;
  if (it < 1664) { d.src = p.w_in + (size_t)l * 1024 * 6656; d.K = 1024; d.N = 6656; d.dst = W_IN; }
  else if (it < 1728) { it -= 1664; d.src = p.w_glu + (size_t)l * 512 * 512; d.K = 512; d.N = 512; d.dst = W_GLU; }
  else if (it < 1856) { it -= 1728; d.src = p.w_bs5 + (size_t)l * 512 * 1024; d.K = 512; d.N = 1024; d.dst = W_BS5; }
  else if (it < 1984) { it -= 1856; d.src = p.w_bret + (size_t)l * 512 * 1024; d.K = 512; d.N = 1024; d.dst = W_BRET; }
  else if (it < 2112) { it -= 1984; d.src = p.w_bna + (size_t)l * 512 * 1024; d.K = 512; d.N = 1024; d.dst = W_BNA; }
  else if (it < 2368) { it -= 2112; d.src = p.w_out + (size_t)l * 1024 * 1024; d.K = 1024; d.N = 1024; d.dst = W_OUT; }
  else if (it < 3072) { it -= 2368; d.src = p.w_fg + (size_t)l * 1024 * 2816; d.K = 1024; d.N = 2816; d.dst = W_FG; d.gu = 0; }
  else if (it < 3776) { it -= 3072; d.src = p.w_fu + (size_t)l * 1024 * 2816; d.K = 1024; d.N = 2816; d.dst = W_FG; d.gu = 1; }
  else { it -= 3776; d.src = p.w_fd + (size_t)l * 2816 * 1024; d.K = 2816; d.N = 1024; d.dst = W_FD; }
  const int ntn = d.N >> 6;
  d.kt = it / ntn;
  d.nt = it % ntn;
  return d;
}
__device__ void wconv_range(const Params& p, int l, int first, int stride, int n, float* tile) {
  const int tid = opaque_tid();
  const int kr0 = tid >> 4, nc = (tid & 15) * 4;
  int it = first;
  if (it >= n) return;
  WcDesc d = wc_decode(p, l, it);
  float4 v0, v1, v2, v3;
#define WC_LOAD(D)                                                                           \
  {                                                                                          \
    const float* s_ = (D).src + (size_t)((D).kt * 64 + kr0) * (D).N + (D).nt * 64 + nc;      \
    v0 = nt_ld4((s_));                                    \
    v1 = nt_ld4((s_ + (size_t)16 * (D).N));               \
    v2 = nt_ld4((s_ + (size_t)32 * (D).N));               \
    v3 = nt_ld4((s_ + (size_t)48 * (D).N));               \
  }
  WC_LOAD(d)
  while (true) {
    __syncthreads();
    {
      float* t0 = tile + kr0 * 65 + nc;
      t0[0] = v0.x; t0[1] = v0.y; t0[2] = v0.z; t0[3] = v0.w;
      t0[16 * 65 + 0] = v1.x; t0[16 * 65 + 1] = v1.y; t0[16 * 65 + 2] = v1.z; t0[16 * 65 + 3] = v1.w;
      t0[32 * 65 + 0] = v2.x; t0[32 * 65 + 1] = v2.y; t0[32 * 65 + 2] = v2.z; t0[32 * 65 + 3] = v2.w;
      t0[48 * 65 + 0] = v3.x; t0[48 * 65 + 1] = v3.y; t0[48 * 65 + 2] = v3.z; t0[48 * 65 + 3] = v3.w;
    }
    __syncthreads();
    const int nx = it + stride;
    WcDesc dn = d;
    if (nx < n) {
      dn = wc_decode(p, l, nx);
      WC_LOAD(dn)
    }
    const int nn = tid >> 2, kq = tid & 3;
    unsigned u[8];
#pragma unroll
    for (int i = 0; i < 8; ++i)
      u[i] = pack2(tile[(kq * 16 + 2 * i) * 65 + nn], tile[(kq * 16 + 2 * i + 1) * 65 + nn]);
    bf16_t* Wd = (bf16_t*)(p.ws + OFF_W) + d.dst;
    int drow = d.nt * 64 + nn;
    if (d.gu >= 0) drow = (drow >> 6) * 128 + ((drow >> 5) & 1) * 64 + d.gu * 32 + (drow & 31);
    uint4* dp = (uint4*)(Wd + (size_t)drow * d.K + d.kt * 64 + kq * 16);
    dp[0] = uint4{u[0], u[1], u[2], u[3]};
    dp[1] = uint4{u[4], u[5], u[6], u[7]};
    if (nx >= n) break;
    it = nx;
    d = dn;
  }
#undef WC_LOAD
}

__device__ void norm_rows(const Params& p, int l, int which, int r, const float* src_ctx, const float* src_x) {
  const int lane = opaque_tid() & 63;
  float4 v[2][4];
  const float* mod[2];
#pragma unroll
  for (int q = 0; q < 2; ++q) {
    const int rr = r + q * 4;
    const float* src = (rr < R_CTX) ? src_ctx + (size_t)rr * 1024 : src_x + (size_t)(rr - R_CTX) * 1024;
    const int modrow = (rr < R_CTX) ? 8 : (rr - R_CTX) >> 11;
    mod[q] = (const float*)(p.ws + OFF_MOD) + (size_t)(l * 9 + modrow) * 6144 + which * 3072;
#pragma unroll
    for (int i = 0; i < 4; ++i) v[q][i] = *(const float4*)(src + i * 256 + lane * 4);
  }
#pragma unroll
  for (int q = 0; q < 2; ++q) {
    const int rr = r + q * 4;
    float ss = 0.f;
#pragma unroll
    for (int i = 0; i < 4; ++i) ss += v[q][i].x * v[q][i].x + v[q][i].y * v[q][i].y + v[q][i].z * v[q][i].z + v[q][i].w * v[q][i].w;
    ss = wave_sum(ss);
    const float rstd = rsqrtf(ss * (1.f / 1024.f) + 1e-6f);
    bf16_t* h = (bf16_t*)(p.ws + OFF_H) + (size_t)rr * 1024;
#pragma unroll
    for (int i = 0; i < 4; ++i) {
      const int c0 = i * 256 + lane * 4;
      const float4 sh = *(const float4*)(mod[q] + c0);
      const float4 sc = *(const float4*)(mod[q] + 1024 + c0);
      uint2 o;
      o.x = pack2(v[q][i].x * rstd * (1.f + sc.x) + sh.x, v[q][i].y * rstd * (1.f + sc.y) + sh.y);
      o.y = pack2(v[q][i].z * rstd * (1.f + sc.z) + sh.z, v[q][i].w * rstd * (1.f + sc.w) + sh.w);
      *(uint2*)(h + c0) = o;
    }
  }
}

__device__ __forceinline__ void resid_big_tile(const Params& p, int l, int mt, int nt, const bf16_t* A, int lda,
                                               const bf16_t* Bt, int ldb, int K, int goff, const float* sx, float* dx,
                                               bf16_t* smem) {
  f32x4 acc[8][4];
#pragma unroll
  for (int mi = 0; mi < 8; ++mi)
#pragma unroll
    for (int ni = 0; ni < 4; ++ni) acc[mi][ni] = f32x4{0.f, 0.f, 0.f, 0.f};
  gemm_core_big<true>(acc, A + (size_t)mt * 256 * lda, lda, Bt + (size_t)nt * 128 * ldb, ldb, K, smem);
  TIDVARS
  const int modrow = (mt - 8) >> 3;
  const float* modp_ = (const float*)(p.ws + OFF_MOD);
  float4 gv[4];
#pragma unroll
  for (int ni = 0; ni < 4; ++ni)
    gv[ni] = *(const float4*)(modp_ + (size_t)(l * 9 + modrow) * 6144 + goff + nt * 128 + wn * 64 + ni * 16 + quad * 4);
#pragma unroll
  for (int mi = 0; mi < 8; ++mi) {
    const int r = mt * 256 + wm * 128 + mi * 16 + l15;
    const size_t o = (size_t)(r - R_CTX) * 1024 + nt * 128 + wn * 64 + quad * 4;
    float4 sv[4];
#pragma unroll
    for (int ni = 0; ni < 4; ++ni) sv[ni] = *(const float4*)(sx + o + ni * 16);
#pragma unroll
    for (int ni = 0; ni < 4; ++ni) {
      float4 ov;
      ov.x = sv[ni].x + gv[ni].x * acc[mi][ni][0];
      ov.y = sv[ni].y + gv[ni].y * acc[mi][ni][1];
      ov.z = sv[ni].z + gv[ni].z * acc[mi][ni][2];
      ov.w = sv[ni].w + gv[ni].w * acc[mi][ni][3];
      *(float4*)(dx + o + ni * 16) = ov;
    }
  }
}

__device__ __forceinline__ void inproj_tile(const Params& p, int mt, int nt, bf16_t* smem) {
  const bf16_t* h = (const bf16_t*)(p.ws + OFF_H);
  const bf16_t* W = (const bf16_t*)(p.ws + OFF_W);
  bf16_t* proj = (bf16_t*)(p.ws + OFF_PROJ);
  bf16_t* vT = (bf16_t*)(p.ws + OFF_VT);
  const float* rot = (const float*)(p.ws + OFF_ROT);
  int colbase = 0, vrow = -1;
  float scale = 1.f;
  bool rotary = false;
  if (nt < 4) colbase = PC_U + nt * 128;
  else if (nt < 6) { colbase = PC_RK + (nt - 4) * 128; scale = 0.125f; rotary = true; }
  else if (nt < 10) vrow = (nt - 6) * 128;
  else if (nt < 14) colbase = PC_NK + (nt - 10) * 128;
  else if (nt < 18) vrow = 512 + (nt - 14) * 128;
  else if (nt < 20) { colbase = PC_RQ + (nt - 18) * 128; rotary = true; }
  else if (nt < 24) colbase = PC_RG + (nt - 20) * 128;
  else { colbase = PC_NQ + (nt - 24) * 128; scale = 0.125f; }
  f32x4 acc[8][4];
#pragma unroll
  for (int mi = 0; mi < 8; ++mi)
#pragma unroll
    for (int ni = 0; ni < 4; ++ni) acc[mi][ni] = f32x4{0.f, 0.f, 0.f, 0.f};
  if (vrow >= 0) {
    gemm_core_big<false>(acc, h + (size_t)mt * 256 * 1024, 1024, W + W_IN + (size_t)nt * 128 * 1024, 1024, 1024, smem);
    TIDVARS
    const int m0 = mt * 256 + wm * 128;
#pragma unroll
    for (int mi = 0; mi < 8; ++mi) {
      const int r0 = m0 + mi * 16 + quad * 4;
#pragma unroll
      for (int ni = 0; ni < 4; ++ni) {
        const int vr = vrow + wn * 64 + ni * 16 + l15;
        uint2 o;
        o.x = pack2(acc[mi][ni][0], acc[mi][ni][1]);
        o.y = pack2(acc[mi][ni][2], acc[mi][ni][3]);
        *(uint2*)(vT + (size_t)vr * R_ALL + r0) = o;
      }
    }
    return;
  }
  gemm_core_big<true>(acc, h + (size_t)mt * 256 * 1024, 1024, W + W_IN + (size_t)nt * 128 * 1024, 1024, 1024, smem);
  TIDVARS
  const int m0 = mt * 256 + wm * 128;
  if (rotary && mt >= 8) {
#pragma unroll
    for (int mi = 0; mi < 8; ++mi) {
      const int r = m0 + mi * 16 + l15;
      const int t = (r - R_CTX) & 2047;
      const int cr = t >> 6, cc = t & 63;
      const float4 c1 = *(const float4*)(rot + cr * 16 + quad * 4), s1 = *(const float4*)(rot + 1024 + cr * 16 + quad * 4);
      const float4 c2 = *(const float4*)(rot + cc * 16 + quad * 4), s2 = *(const float4*)(rot + 1024 + cc * 16 + quad * 4);
      const float cs1[4] = {c1.x, c1.y, c1.z, c1.w}, sn1[4] = {s1.x, s1.y, s1.z, s1.w};
      const float cs2[4] = {c2.x, c2.y, c2.z, c2.w}, sn2[4] = {s2.x, s2.y, s2.z, s2.w};
#pragma unroll
      for (int j = 0; j < 4; ++j) {
        const float a = acc[mi][0][j], bb = acc[mi][1][j];
        acc[mi][0][j] = a * cs1[j] - bb * sn1[j];
        acc[mi][1][j] = a * sn1[j] + bb * cs1[j];
        const float a2 = acc[mi][2][j], b2 = acc[mi][3][j];
        acc[mi][2][j] = a2 * cs2[j] - b2 * sn2[j];
        acc[mi][3][j] = a2 * sn2[j] + b2 * cs2[j];
      }
    }
  }
#pragma unroll
  for (int mi = 0; mi < 8; ++mi) {
    const int r = m0 + mi * 16 + l15;
#pragma unroll
    for (int ni = 0; ni < 4; ++ni) {
      uint2 o;
      o.x = pack2(acc[mi][ni][0] * scale, acc[mi][ni][1] * scale);
      o.y = pack2(acc[mi][ni][2] * scale, acc[mi][ni][3] * scale);
      *(uint2*)(proj + (size_t)r * PJ + colbase + wn * 64 + ni * 16 + quad * 4) = o;
    }
  }
  if (nt < 4) {
    bf16_t* uT = (bf16_t*)(p.ws + OFF_UT);
#pragma unroll
    for (int mi = 0; mi < 8; ++mi) {
      const int r = m0 + mi * 16 + l15;
#pragma unroll
      for (int ni = 0; ni < 4; ++ni)
#pragma unroll
        for (int j = 0; j < 4; ++j)
          uT[(size_t)(nt * 128 + wn * 64 + ni * 16 + quad * 4 + j) * R_ALL + r] = f2bf(acc[mi][ni][j]);
    }
  }
}

__device__ __forceinline__ void ret_item(const Params& p, int l, int b, int h, int qt, bool isctx, bool dry, unsigned char* smem) {
  TIDVARS
  bf16_t* proj = (bf16_t*)(p.ws + OFF_PROJ);
  const bf16_t* vT = (const bf16_t*)(p.ws + OFF_VT);
  const float LOG2E = 1.4426950408889634f;
  const float thf = p.theta[l * 8 + h], thb = p.theta[l * 8 + 4 + h];
  const float lgf = -log1pf(expf(-thf)) * LOG2E;
  const float lgb = -log1pf(expf(-thb)) * LOG2E;
  const int seqbase = isctx ? b * 256 : R_CTX + b * 2048;
  const int q0w = qt * 128 + w * 32;
  bf16x8 bq[2][2];
#pragma unroll
  for (int qb = 0; qb < 2; ++qb)
#pragma unroll
    for (int ks = 0; ks < 2; ++ks)
      bq[qb][ks] = *(const bf16x8*)(proj + (size_t)(seqbase + q0w + qb * 16 + l15) * PJ + PC_RQ + h * 64 + ks * 32 + quad * 8);
  float cfF[8], cfB[8];
#pragma unroll
  for (int j = 0; j < 8; ++j) {
    cfF[j] = exp2f(-lgf * (float)(quad * 8 + j));
    cfB[j] = exp2f(lgb * (float)(quad * 8 + j));
  }
  f32x4 O[2][8];
#pragma unroll
  for (int qb = 0; qb < 2; ++qb)
#pragma unroll
    for (int i = 0; i < 8; ++i) O[qb][i] = f32x4{0.f, 0.f, 0.f, 0.f};
  const int ntiles = isctx ? 4 : 36;
  const int lrow = tid >> 3, lcc = tid & 7;
  const bf16_t* kg = proj + PC_RK + h * 64 + lcc * 8 + (size_t)lrow * PJ;
  const bf16_t* vg = vT + (size_t)(h * 128 + lrow) * R_ALL + lcc * 8;
  constexpr int STG = 15360;
  bf16_t* sm = (bf16_t*)smem;
  const int swo = lrow * 80 + lcc * 8;
  uint4 rk0, rk1, rv0, rv1, rv2, rv3;
  {
    const int krow0 = b * 256;
    rk0 = *(const uint4*)(kg + (size_t)krow0 * PJ);
    rk1 = *(const uint4*)(kg + (size_t)(krow0 + 32) * PJ);
    rv0 = *(const uint4*)(vg + krow0);
    rv1 = *(const uint4*)(vg + (size_t)32 * R_ALL + krow0);
    rv2 = *(const uint4*)(vg + (size_t)64 * R_ALL + krow0);
    rv3 = *(const uint4*)(vg + (size_t)96 * R_ALL + krow0);
    *(uint4*)(sm + swo) = rk0;
    *(uint4*)(sm + swo + 32 * 80) = rk1;
    *(uint4*)(sm + 64 * 80 + swo) = rv0;
    *(uint4*)(sm + 64 * 80 + swo + 32 * 80) = rv1;
    *(uint4*)(sm + 64 * 80 + swo + 64 * 80) = rv2;
    *(uint4*)(sm + 64 * 80 + swo + 96 * 80) = rv3;
  }
  __syncthreads();
#pragma unroll 1
  for (int ti = 0; ti < ntiles; ++ti) {
    {
      const int tn = (ti + 1 < ntiles) ? ti + 1 : ti;
      const int krow0 = (tn < 4) ? b * 256 + tn * 64 : R_CTX + b * 2048 + (tn - 4) * 64;
      rk0 = *(const uint4*)(kg + (size_t)krow0 * PJ);
      rk1 = *(const uint4*)(kg + (size_t)(krow0 + 32) * PJ);
      rv0 = *(const uint4*)(vg + krow0);
      rv1 = *(const uint4*)(vg + (size_t)32 * R_ALL + krow0);
      rv2 = *(const uint4*)(vg + (size_t)64 * R_ALL + krow0);
      rv3 = *(const uint4*)(vg + (size_t)96 * R_ALL + krow0);
    }
    const bf16_t* Ks = sm + (ti & 1) * STG;
    const bf16_t* Vs = Ks + 64 * 80;
    const bool kctx = ti < 4;
#pragma unroll
    for (int g2 = 0; g2 < 2; ++g2) {
      const int kpos0 = (kctx ? ti * 64 : (ti - 4) * 64) + g2 * 32;
      const bf16_t* kr = Ks + (g2 * 32 + (l15 >> 2) * 8 + (l15 & 3)) * 80 + quad * 8;
      const bf16x8 kf0 = *(const bf16x8*)(kr), kf1 = *(const bf16x8*)(kr + 32);
      const bf16x8 kf2 = *(const bf16x8*)(kr + 4 * 80), kf3 = *(const bf16x8*)(kr + 4 * 80 + 32);
      bf16x8 pa[2];
#pragma unroll
      for (int qb = 0; qb < 2; ++qb) {
        f32x4 sx = f32x4{0.f, 0.f, 0.f, 0.f}, sy = f32x4{0.f, 0.f, 0.f, 0.f};
        sx = MFMA16(kf0, bq[qb][0], sx);
        sx = MFMA16(kf1, bq[qb][1], sx);
        sy = MFMA16(kf2, bq[qb][0], sy);
        sy = MFMA16(kf3, bq[qb][1], sy);
        const int qlo = q0w + qb * 16;
        const int qpos = qlo + l15;
        float pv[8];
        if (isctx || !kctx) {
          if (kpos0 + 31 <= qlo) {
            const float rf = exp2f(lgf * (float)(qpos - kpos0));
#pragma unroll
            for (int j = 0; j < 8; ++j) pv[j] = ((j < 4) ? sx[j & 3] : sy[j & 3]) * (rf * cfF[j]);
          } else if (kpos0 > qlo + 15) {
            const float rb = exp2f(lgb * (float)(kpos0 - qpos));
#pragma unroll
            for (int j = 0; j < 8; ++j) pv[j] = ((j < 4) ? sx[j & 3] : sy[j & 3]) * (rb * cfB[j]);
          } else {
#pragma unroll
            for (int j = 0; j < 8; ++j) {
              const int d = qpos - (kpos0 + quad * 8 + j);
              const float wgt = (d >= 0) ? exp2f(lgf * (float)d) : exp2f(lgb * (float)(-d));
              pv[j] = ((j < 4) ? sx[j & 3] : sy[j & 3]) * wgt;
            }
          }
        } else {
          const float rf = exp2f(lgf * (float)(qpos + 256 - kpos0));
          const float rb = exp2f(lgb * (float)(2048 - qpos + kpos0));
#pragma unroll
          for (int j = 0; j < 8; ++j) pv[j] = ((j < 4) ? sx[j & 3] : sy[j & 3]) * (rf * cfF[j] + rb * cfB[j]);
        }
        pa[qb] = pack8(pv);
      }
#pragma unroll
      for (int db = 0; db < 8; ++db) {
        const bf16x8 vf = *(const bf16x8*)(Vs + (db * 16 + l15) * 80 + g2 * 32 + quad * 8);
        O[0][db] = MFMA16(vf, pa[0], O[0][db]);
        O[1][db] = MFMA16(vf, pa[1], O[1][db]);
      }
    }
    if (ti + 1 < ntiles) {
      bf16_t* d = sm + ((ti + 1) & 1) * STG;
      *(uint4*)(d + swo) = rk0;
      *(uint4*)(d + swo + 32 * 80) = rk1;
      *(uint4*)(d + 64 * 80 + swo) = rv0;
      *(uint4*)(d + 64 * 80 + swo + 32 * 80) = rv1;
      *(uint4*)(d + 64 * 80 + swo + 64 * 80) = rv2;
      *(uint4*)(d + 64 * 80 + swo + 96 * 80) = rv3;
    }
    __syncthreads();
  }
  bf16_t* obase = dry ? (bf16_t*)(p.ws + WS_END) : proj;
  const size_t omask = dry ? (size_t)0x7FFFFF : ~(size_t)0;
#pragma unroll
  for (int qb = 0; qb < 2; ++qb) {
    float s = 0.f;
#pragma unroll
    for (int db = 0; db < 8; ++db) s += (O[qb][db][0] + O[qb][db][1]) + (O[qb][db][2] + O[qb][db][3]);
    s += __shfl_xor(s, 16);
    s += __shfl_xor(s, 32);
    const float mu = s * (1.f / 128.f);
    float v = 0.f;
#pragma unroll
    for (int db = 0; db < 8; ++db)
#pragma unroll
      for (int j = 0; j < 4; ++j) { const float d = O[qb][db][j] - mu; v += d * d; }
    v += __shfl_xor(v, 16);
    v += __shfl_xor(v, 32);
    const float rs = rsqrtf(v * (1.f / 128.f) + 1e-5f);
    const int orow = seqbase + q0w + qb * 16 + l15;
    uint2 gg[8];
#pragma unroll
    for (int db = 0; db < 8; ++db) gg[db] = *(const uint2*)(proj + (size_t)orow * PJ + PC_RG + h * 128 + db * 16 + quad * 4);
#pragma unroll
    for (int db = 0; db < 8; ++db) {
      const float g0 = __uint_as_float(gg[db].x << 16), g1 = __uint_as_float(gg[db].x & 0xffff0000u);
      const float g2 = __uint_as_float(gg[db].y << 16), g3 = __uint_as_float(gg[db].y & 0xffff0000u);
      uint2 o;
      o.x = pack2(siluf_(g0) * (O[qb][db][0] - mu) * rs, siluf_(g1) * (O[qb][db][1] - mu) * rs);
      o.y = pack2(siluf_(g2) * (O[qb][db][2] - mu) * rs, siluf_(g3) * (O[qb][db][3] - mu) * rs);
      *(uint2*)(obase + (((size_t)orow * PJ + PC_RG + h * 128 + db * 16 + quad * 4) & omask)) = o;
    }
  }
}

__device__ __forceinline__ void na_item(const Params& p, int l, int b, int h, int qidx, bool isctx, bool dry, unsigned char* smem) {
  TIDVARS
  bf16_t* proj = (bf16_t*)(p.ws + OFF_PROJ);
  const bf16_t* vT = (const bf16_t*)(p.ws + OFF_VT);
  const int qrow0 = isctx ? b * 256 + qidx * 64 : R_CTX + b * 2048 + qidx * 64;
  float* rpbs = (float*)smem;
  float* part = (float*)(smem + 2048);
  {
    const float* rp = p.rpb + (size_t)(l * 8 + h) * 465;
    for (int i = tid; i < 465; i += 256) rpbs[i] = rp[i];
  }
  bf16x8 bq[4][2];
#pragma unroll
  for (int qb = 0; qb < 4; ++qb)
#pragma unroll
    for (int ks = 0; ks < 2; ++ks)
      bq[qb][ks] = *(const bf16x8*)(proj + (size_t)(qrow0 + qb * 16 + l15) * PJ + PC_NQ + h * 64 + ks * 32 + quad * 8);
  const int r = qidx;
  const int rs = min(max(r - 4, 0), 24);
  const int winbase = R_CTX + b * 2048 + rs * 64;
  float m_run[4], l_run[4];
  f32x4 O[4][4];
#pragma unroll
  for (int qb = 0; qb < 4; ++qb) {
    m_run[qb] = -1e30f;
    l_run[qb] = 0.f;
#pragma unroll
    for (int i = 0; i < 4; ++i) O[qb][i] = f32x4{0.f, 0.f, 0.f, 0.f};
  }
  const int ngr = isctx ? 2 : 6;
  const bf16_t* kbase = proj + PC_NK + h * 64 + quad * 8 + (size_t)((l15 >> 2) * 8 + (l15 & 3)) * PJ;
  const bf16_t* vbase = vT + (size_t)(512 + h * 64 + l15) * R_ALL + quad * 8;
  bf16x8 kf0, kf1, kf2, kf3, vf0, vf1, vf2, vf3;
  {
    const int krow0 = b * 256 + w * 64;
    const bf16_t* kp = kbase + (size_t)krow0 * PJ;
    kf0 = *(const bf16x8*)(kp);
    kf1 = *(const bf16x8*)(kp + 32);
    kf2 = *(const bf16x8*)(kp + 4 * PJ);
    kf3 = *(const bf16x8*)(kp + 4 * PJ + 32);
    vf0 = *(const bf16x8*)(vbase + krow0);
    vf1 = *(const bf16x8*)(vbase + (size_t)16 * R_ALL + krow0);
    vf2 = *(const bf16x8*)(vbase + (size_t)32 * R_ALL + krow0);
    vf3 = *(const bf16x8*)(vbase + (size_t)48 * R_ALL + krow0);
  }
  __syncthreads();
#pragma unroll 1
  for (int g = 0; g < ngr; ++g) {
    bf16x8 nk0, nk1, nk2, nk3, nv0, nv1, nv2, nv3;
    {
      const int gn = (g + 1 < ngr) ? g + 1 : g;
      const int tn = w + 4 * (gn >> 1);
      const int krow0 = ((tn < 4) ? b * 256 + tn * 64 : winbase + (tn - 4) * 64) + (gn & 1) * 32;
      const bf16_t* kp = kbase + (size_t)krow0 * PJ;
      nk0 = *(const bf16x8*)(kp);
      nk1 = *(const bf16x8*)(kp + 32);
      nk2 = *(const bf16x8*)(kp + 4 * PJ);
      nk3 = *(const bf16x8*)(kp + 4 * PJ + 32);
      nv0 = *(const bf16x8*)(vbase + krow0);
      nv1 = *(const bf16x8*)(vbase + (size_t)16 * R_ALL + krow0);
      nv2 = *(const bf16x8*)(vbase + (size_t)32 * R_ALL + krow0);
      nv3 = *(const bf16x8*)(vbase + (size_t)48 * R_ALL + krow0);
    }
    const int t = w + 4 * (g >> 1);
    const int hb = g & 1;
    const bool win = t >= 4;
    const int a = t - 4;
#pragma unroll
    for (int qb = 0; qb < 4; ++qb) {
      if (win && ((qb == 0 && hb == 1) || (qb == 3 && hb == 0))) continue;
      f32x4 sx = f32x4{0.f, 0.f, 0.f, 0.f}, sy = f32x4{0.f, 0.f, 0.f, 0.f};
      sx = MFMA16(kf0, bq[qb][0], sx);
      sx = MFMA16(kf1, bq[qb][1], sx);
      sy = MFMA16(kf2, bq[qb][0], sy);
      sy = MFMA16(kf3, bq[qb][1], sy);
      float s[8];
#pragma unroll
      for (int j = 0; j < 8; ++j) s[j] = (j < 4) ? sx[j & 3] : sy[j & 3];
      if (win) {
        const int c = qb * 16 + l15;
        const int cs = min(max(c - 8, 0), 48);
#pragma unroll
        for (int j = 0; j < 8; ++j) {
          const int kc = hb * 32 + quad * 8 + j;
          const bool valid = (kc >= cs) && (kc < cs + 16);
          const int bi = min(max((rs + a - r + 7) * 31 + (kc - c + 15), 0), 464);
          const float sb = s[j] + rpbs[bi];
          s[j] = valid ? sb : -1e30f;
        }
      }
      float gmax = s[0];
#pragma unroll
      for (int j = 1; j < 8; ++j) gmax = fmaxf(gmax, s[j]);
      gmax = fmaxf(gmax, __shfl_xor(gmax, 16));
      gmax = fmaxf(gmax, __shfl_xor(gmax, 32));
      const float m_new = fmaxf(m_run[qb], gmax);
      const bool grew = m_new > m_run[qb];
      float ps = 0.f;
      float pv[8];
#pragma unroll
      for (int j = 0; j < 8; ++j) {
        pv[j] = __expf(s[j] - m_new);
        ps += pv[j];
      }
      const bf16x8 pa = pack8(pv);
      if (__any(grew)) {
        const float alpha = __expf(m_run[qb] - m_new);
        l_run[qb] *= alpha;
#pragma unroll
        for (int db = 0; db < 4; ++db)
#pragma unroll
          for (int j = 0; j < 4; ++j) O[qb][db][j] *= alpha;
      }
      m_run[qb] = m_new;
      l_run[qb] += ps;
      O[qb][0] = MFMA16(vf0, pa, O[qb][0]);
      O[qb][1] = MFMA16(vf1, pa, O[qb][1]);
      O[qb][2] = MFMA16(vf2, pa, O[qb][2]);
      O[qb][3] = MFMA16(vf3, pa, O[qb][3]);
    }
    kf0 = nk0; kf1 = nk1; kf2 = nk2; kf3 = nk3;
    vf0 = nv0; vf1 = nv1; vf2 = nv2; vf3 = nv3;
  }
#pragma unroll
  for (int qb = 0; qb < 4; ++qb) {
    float lt = l_run[qb];
    lt += __shfl_xor(lt, 16);
    lt += __shfl_xor(lt, 32);
    l_run[qb] = lt;
    if (qb != w) {
      float* ps_ = part + (w * 3 + (qb > w ? qb - 1 : qb)) * 1152;
#pragma unroll
      for (int db = 0; db < 4; ++db)
#pragma unroll
        for (int j = 0; j < 4; ++j) ps_[(db * 4 + j) * 64 + lane] = O[qb][db][j];
      ps_[1024 + lane] = m_run[qb];
      ps_[1088 + lane] = lt;
    }
  }
  __syncthreads();
  float m_own = 0.f, l_own = 0.f;
  f32x4 Oo[4];
#pragma unroll
  for (int qb = 0; qb < 4; ++qb)
    if (qb == w) {
      m_own = m_run[qb];
      l_own = l_run[qb];
#pragma unroll
      for (int db = 0; db < 4; ++db) Oo[db] = O[qb][db];
    }
  float m_tot = m_own;
#pragma unroll
  for (int v = 0; v < 4; ++v) {
    if (v == w) continue;
    const float* ps_ = part + (v * 3 + (w > v ? w - 1 : w)) * 1152;
    m_tot = fmaxf(m_tot, ps_[1024 + lane]);
  }
  {
    const float f = __expf(m_own - m_tot);
    l_own *= f;
#pragma unroll
    for (int db = 0; db < 4; ++db)
#pragma unroll
      for (int j = 0; j < 4; ++j) Oo[db][j] *= f;
  }
#pragma unroll
  for (int v = 0; v < 4; ++v) {
    if (v == w) continue;
    const float* ps_ = part + (v * 3 + (w > v ? w - 1 : w)) * 1152;
    const float f = __expf(ps_[1024 + lane] - m_tot);
    l_own += ps_[1088 + lane] * f;
#pragma unroll
    for (int db = 0; db < 4; ++db)
#pragma unroll
      for (int j = 0; j < 4; ++j) Oo[db][j] += ps_[(db * 4 + j) * 64 + lane] * f;
  }
  bf16_t* obase = dry ? (bf16_t*)(p.ws + WS_END) : proj;
  const size_t omask = dry ? (size_t)0x7FFFFF : ~(size_t)0;
  const float linv = 1.f / l_own;
  const int orow = qrow0 + w * 16 + l15;
#pragma unroll
  for (int db = 0; db < 4; ++db) {
    uint2 o;
    o.x = pack2(Oo[db][0] * linv, Oo[db][1] * linv);
    o.y = pack2(Oo[db][2] * linv, Oo[db][3] * linv);
    *(uint2*)(obase + (((size_t)orow * PJ + PC_NQ + h * 64 + db * 16 + quad * 4) & omask)) = o;
  }
}

struct S5Frag {
  bf16x8 bf[8];
  bf16x8 cf[4];
  float ar, ai;
};

__device__ __forceinline__ void s5_load_frag(const Params& p, S5Frag& f, int ldg, bool need_c) {
  const int lane = opaque_tid() & 63, l15 = lane & 15, quad = lane >> 4;
  const bf16_t* bbt = (const bf16_t*)(p.ws + OFF_S5BB) + (size_t)ldg * 2048;
  const bf16_t* cm = (const bf16_t*)(p.ws + OFF_S5CM) + (size_t)ldg * 2048;
  const float* ab = (const float*)(p.ws + OFF_S5AB) + (size_t)ldg * 128;
  const bf16x8 z = {0, 0, 0, 0, 0, 0, 0, 0};
#pragma unroll
  for (int pb = 0; pb < 8; ++pb)
    f.bf[pb] = (quad < 2) ? *(const bf16x8*)(bbt + (pb * 16 + l15) * 16 + quad * 8) : z;
  if (need_c) {
#pragma unroll
    for (int ks = 0; ks < 4; ++ks) f.cf[ks] = *(const bf16x8*)(cm + l15 * 128 + ks * 32 + quad * 8);
  }
  f.ar = ab[lane * 2];
  f.ai = ab[lane * 2 + 1];
}

template <int DIR>
__device__ __forceinline__ int s5_row(int b, int s0, int l15) {
  const int s = s0 + l15;
  if (s0 < 256) {
    const int j = DIR ? 255 - s : s;
    return b * 256 + j;
  }
  const int t = s - 256;
  const int tt = DIR ? 2047 - t : t;
  return R_CTX + b * 2048 + tt;
}

template <int DIR, bool WRITE>
__device__ __forceinline__ void s5_chunk(const bf16_t* __restrict__ proj, int b, int g, int cseq,
                                         const S5Frag& f, float& xr, float& xi, float* BUs, bf16_t* Xs,
                                         f32x4 (&yacc)[8]) {
  const int lane = opaque_tid() & 63, l15 = lane & 15, quad = lane >> 4;
  const bf16x8 z = {0, 0, 0, 0, 0, 0, 0, 0};
  const bf16_t* ub = proj + PC_U + g * 16 + (quad & 1) * 8;
  bf16x8 ucur = *(const bf16x8*)(ub + (size_t)s5_row<DIR>(b, cseq * 128, l15) * PJ);
#pragma unroll 1
  for (int sbs = 0; sbs < 8; ++sbs) {
    const int sn = cseq * 128 + ((sbs < 7) ? sbs + 1 : sbs) * 16;
    const bf16x8 unext = *(const bf16x8*)(ub + (size_t)s5_row<DIR>(b, sn, l15) * PJ);
    const bf16x8 uf = (quad < 2) ? ucur : z;
    __builtin_amdgcn_wave_barrier();
#pragma unroll
    for (int pb = 0; pb < 8; ++pb) {
      f32x4 bu = f32x4{0.f, 0.f, 0.f, 0.f};
      bu = MFMA16(uf, f.bf[pb], bu);
#pragma unroll
      for (int j = 0; j < 4; ++j) BUs[(quad * 4 + j) * 132 + pb * 16 + l15] = bu[j];
    }
    __builtin_amdgcn_wave_barrier();
    float2 bbv[16];
#pragma unroll
    for (int t = 0; t < 16; ++t) bbv[t] = *(const float2*)(BUs + t * 132 + 2 * lane);
#pragma unroll
    for (int t = 0; t < 16; ++t) {
      const float2 bb = bbv[t];
      const float nr = f.ar * xr - f.ai * xi + bb.x;
      const float ni = f.ar * xi + f.ai * xr + bb.y;
      xr = nr;
      xi = ni;
      if (WRITE) {
        const int rt = DIR ? 15 - t : t;
        *(unsigned*)(Xs + rt * 144 + 2 * lane) = pack2(xr, xi);
      }
    }
    if (WRITE) {
      __builtin_amdgcn_wave_barrier();
      const int tsb = DIR ? 7 - sbs : sbs;
      f32x4 yt = f32x4{0.f, 0.f, 0.f, 0.f};
#pragma unroll
      for (int ks = 0; ks < 4; ++ks) {
        const bf16x8 xa = *(const bf16x8*)(Xs + l15 * 144 + ks * 32 + quad * 8);
        yt = MFMA16(xa, f.cf[ks], yt);
      }
#pragma unroll
      for (int i = 0; i < 8; ++i)
        if (i == tsb) yacc[i] += yt;
    }
    ucur = unext;
  }
}

__device__ __forceinline__ void s5_item(const Params& p, int l, int b, int g, bool last, unsigned char* smem) {
  TIDVARS
  float* bound = (float*)smem;
  float* BUs = (float*)(smem + 18432 + w * 13056);
  bf16_t* Xs = (bf16_t*)(smem + 18432 + w * 13056 + 8448);
  const bf16_t* proj = (const bf16_t*)(p.ws + OFF_PROJ);
  bf16_t* G = (bf16_t*)(p.ws + OFF_G);
  f32x4 yacc[8];
  {
    const bf16_t* uT = (const bf16_t*)(p.ws + OFF_UT);
    bf16_t* tabs = (bf16_t*)(smem + 18432);
#pragma unroll 1
    for (int dir = 0; dir < 2; ++dir) {
      const int ldg = (l * 2 + dir) * 32 + g;
      __syncthreads();
      {
        const bf16_t* vt = (const bf16_t*)(p.ws + OFF_S5V) + (size_t)ldg * 16384;
#pragma unroll
        for (int i = 0; i < 8; ++i) {
          const int id = tid + i * 256, row = id >> 4, cc = id & 15;
          *(uint4*)(tabs + row * 144 + cc * 8) = *(const uint4*)(vt + row * 128 + cc * 8);
        }
      }
      float bre[4][4], bim[4][4];
      {
        const bf16_t* bbt = (const bf16_t*)(p.ws + OFF_S5BB) + (size_t)ldg * 2048;
#pragma unroll
        for (int nb = 0; nb < 4; ++nb) {
          const int ps = nb * 16 + l15;
          const uint2 r2 = *(const uint2*)(bbt + (2 * ps) * 16 + quad * 4);
          const uint2 i2 = *(const uint2*)(bbt + (2 * ps + 1) * 16 + quad * 4);
          bre[nb][0] = __uint_as_float(r2.x << 16); bre[nb][1] = __uint_as_float(r2.x & 0xffff0000u);
          bre[nb][2] = __uint_as_float(r2.y << 16); bre[nb][3] = __uint_as_float(r2.y & 0xffff0000u);
          bim[nb][0] = __uint_as_float(i2.x << 16); bim[nb][1] = __uint_as_float(i2.x & 0xffff0000u);
          bim[nb][2] = __uint_as_float(i2.y << 16); bim[nb][3] = __uint_as_float(i2.y & 0xffff0000u);
        }
      }
      __syncthreads();
#pragma unroll 1
      for (int c = w; c < 17; c += 4) {
        int rowbase;
        if (dir == 0) rowbase = (c < 2) ? b * 256 + 128 * c : R_CTX + b * 2048 + (c - 2) * 128;
        else rowbase = (c < 2) ? b * 256 + 128 * (1 - c) : R_CTX + b * 2048 + 128 * (17 - c);
        bf16x8 ua[4];
#pragma unroll
        for (int ks = 0; ks < 4; ++ks)
          ua[ks] = *(const bf16x8*)(uT + (size_t)(g * 16 + l15) * R_ALL + rowbase + ks * 32 + quad * 8);
        f32x4 z[8];
#pragma unroll
        for (int nb = 0; nb < 8; ++nb) {
          z[nb] = f32x4{0.f, 0.f, 0.f, 0.f};
#pragma unroll
          for (int ks = 0; ks < 4; ++ks) {
            const bf16x8 wf = *(const bf16x8*)(tabs + (nb * 16 + l15) * 144 + ks * 32 + quad * 8);
            z[nb] = MFMA16(ua[ks], wf, z[nb]);
          }
        }
#pragma unroll
        for (int nb = 0; nb < 4; ++nb) {
          float er = 0.f, ei = 0.f;
#pragma unroll
          for (int j = 0; j < 4; ++j) {
            er += bre[nb][j] * z[nb][j] - bim[nb][j] * z[nb + 4][j];
            ei += bre[nb][j] * z[nb + 4][j] + bim[nb][j] * z[nb][j];
          }
          er += __shfl_xor(er, 16);
          er += __shfl_xor(er, 32);
          ei += __shfl_xor(ei, 16);
          ei += __shfl_xor(ei, 32);
          if (quad == 0) {
            bound[(dir * 18 + c + 1) * 128 + nb * 16 + l15] = er;
            bound[(dir * 18 + c + 1) * 128 + 64 + nb * 16 + l15] = ei;
          }
        }
      }
    }
  }
  __syncthreads();
  if (tid < 128) {
    const int d = tid >> 6, pp = tid & 63;
    const float* at = (const float*)(p.ws + OFF_S5AT) + (size_t)((l * 2 + d) * 32 + g) * 128;
    const float tr = at[pp * 2], ti = at[pp * 2 + 1];
    float xr = 0.f, xi = 0.f;
    bound[(d * 18) * 128 + pp] = 0.f;
    bound[(d * 18) * 128 + 64 + pp] = 0.f;
    for (int c = 1; c < 18; ++c) {
      const float er = bound[(d * 18 + c) * 128 + pp], ei = bound[(d * 18 + c) * 128 + 64 + pp];
      const float nr = tr * xr - ti * xi + er;
      const float ni = tr * xi + ti * xr + ei;
      xr = nr;
      xi = ni;
      bound[(d * 18 + c) * 128 + pp] = xr;
      bound[(d * 18 + c) * 128 + 64 + pp] = xi;
    }
  }
  __syncthreads();
  const float dsk = p.s5_d[l * 512 + g * 16 + l15];
  for (int tc = (last ? 2 : 0) + w; tc < 18; tc += 4) {
#pragma unroll
    for (int i = 0; i < 8; ++i) yacc[i] = f32x4{0.f, 0.f, 0.f, 0.f};
    {
      S5Frag f;
      s5_load_frag(p, f, (l * 2 + 0) * 32 + g, true);
      const int cseq = tc;
      float xr = bound[(0 * 18 + cseq) * 128 + lane], xi = bound[(0 * 18 + cseq) * 128 + 64 + lane];
      s5_chunk<0, true>(proj, b, g, cseq, f, xr, xi, BUs, Xs, yacc);
    }
    {
      S5Frag f;
      s5_load_frag(p, f, (l * 2 + 1) * 32 + g, true);
      const int cseq = (tc < 2) ? 1 - tc : 19 - tc;
      float xr = bound[(1 * 18 + cseq) * 128 + lane], xi = bound[(1 * 18 + cseq) * 128 + 64 + lane];
      s5_chunk<1, true>(proj, b, g, cseq, f, xr, xi, BUs, Xs, yacc);
    }
    const int rowbase = (tc < 2) ? b * 256 + tc * 128 : R_CTX + b * 2048 + (tc - 2) * 128;
#pragma unroll
    for (int tsb = 0; tsb < 8; ++tsb)
#pragma unroll
      for (int j = 0; j < 4; ++j) {
        const int row = rowbase + tsb * 16 + quad * 4 + j;
        const float uu = bf2f(proj[(size_t)row * PJ + PC_U + g * 16 + l15]);
        const float y = yacc[tsb][j] + dsk * uu;
        const float zz = 0.7978845608028654f * (y + 0.044715f * y * y * y);
        const float gl = y / (1.f + __expf(-2.f * zz));
        G[(size_t)row * 512 + g * 16 + l15] = f2bf(gl);
      }
  }
}

#define EPI_LOOP(NI_)                                                        \
  _Pragma("unroll") for (int mi = 0; mi < 4; ++mi)                           \
  _Pragma("unroll") for (int ni = 0; ni < NI_; ++ni)                         \
  _Pragma("unroll") for (int j = 0; j < 4; ++j)

__global__ void __launch_bounds__(256, 2) fwd_megakernel(Params p) {
  cg::grid_group grid = cg::this_grid();
  __shared__ __attribute__((aligned(16))) unsigned char smem[SMEM_BYTES];
  __shared__ int s_item;
  __shared__ uint4 xb_words;
  if (threadIdx.x == 0) xb_words = make_uint4(0u, 0u, 0u, 0u);
  __syncthreads();
  const XcdBarrier xb = xcd_barrier_post((unsigned*)(p.ws + OFF_BAR), (volatile LAS unsigned*)&xb_words);
  const int nblk = gridDim.x, bid = blockIdx.x;
  const int lbid = bid;
#define sA ((bf16_t*)smem)
#define sB (((bf16_t*)smem) + 128 * 72)
#define W ((const bf16_t*)(p.ws + OFF_W))
#define hbuf ((bf16_t*)(p.ws + OFF_H))
#define Gbuf ((bf16_t*)(p.ws + OFF_G))
#define proj ((bf16_t*)(p.ws + OFF_PROJ))
#define mbuf ((bf16_t*)(p.ws + OFF_VT))
#define hid ((bf16_t*)(p.ws + OFF_PROJ))
#define ctxs ((float*)(p.ws + OFF_CTXS))
#define modp ((const float*)(p.ws + OFF_MOD))
#define cnt ((int*)(p.ws + OFF_CNT))

#pragma unroll 1
  for (int rep = 0, nrep = REPS61; rep < nrep; ++rep) {
    TIDVARS
    for (int i = (tid < 2 ? bid * 2 + tid : 1024); i < 1024; i += nblk * 2) {
      const int coord = i >> 4, fi = i & 15;
      const float inv = powf(10000.f, -(float)fi / 16.f);
      const float ang = (float)coord * inv;
      float* rot = (float*)(p.ws + OFF_ROT);
      rot[i] = cosf(ang);
      rot[1024 + i] = sinf(ang);
    }
    for (int i = (tid < 16 ? bid * 16 + tid : 8192); i < 8192; i += nblk * 16) s5_tables(p, i);
    for (int it = bid; it < 192; it += nblk) mod_item(p, it, (float*)smem);
    wconv_range(p, 0, (bid + 320) % nblk, nblk, 4480, (float*)smem);
    if (p.fnorm == nullptr) grid.sync();
    xcd_barrier(xb);
  }

  for (int l = 0; l < 2; ++l) {
    const bool last = (l == 1);
    const float* src_ctx = (l == 0) ? p.ctx : ctxs;
    const float* src_x = (l == 0) ? p.x : p.out;
    const int mt_min = last ? 16 : 0;

#pragma unroll 1
    for (int rep = 0, nrep = REPS62; rep < nrep; ++rep) {
      TIDVARS
      const int nnorm = R_ALL / 8;
      for (int it = bid; it < nnorm; it += nblk) norm_rows(p, l, 0, it * 8 + w, src_ctx, src_x);
      if (last) wconv_range(p, 1, bid, nblk, 4480, (float*)smem);
      xcd_barrier(xb);
    }

#pragma unroll 1
    for (int rep = 0, nrep = REPS(1); rep < nrep; ++rep) {
      for (int tile = lbid; tile < 72 * 28; tile += nblk) {
        const int mt = tile / 28, nt = tile % 28;
        if (last && mt < 8 && nt >= 18) continue;
        inproj_tile(p, mt, nt, (bf16_t*)smem);
      }
      xcd_barrier(xb);
    }

#pragma unroll 1
    for (int rep = 0, nrep = (PROBE >= 21 && PROBE <= 23) ? (1 + (int)(p.fnorm != nullptr)) : REPS(2); rep < nrep; ++rep) {
      TIDVARS
      const bool dry = rep > 0;
      const int n_s5 = 256;
      const int n_ret = 512 + (last ? 0 : 64);
      const int n_na = 2048 + (last ? 0 : 256);
      const int total = n_s5 + n_ret + n_na;
      while (true) {
        __syncthreads();
        if (tid == 0) s_item = atomicAdd(&cnt[l + 2 * rep], 1);
        __syncthreads();
        int it = s_item;
#if PROBE == 21
        if (rep > 0 && it >= n_s5) break;
#elif PROBE == 22
        if (rep > 0) { it += n_s5; if (it >= n_s5 + n_ret) break; }
#elif PROBE == 23
        if (rep > 0) it += n_s5 + n_ret;
#endif
        if (it >= total) break;
        if (it < n_s5) {
          __builtin_amdgcn_s_setprio(3);
          s5_item(p, l, it >> 5, it & 31, last, smem);
          __builtin_amdgcn_s_setprio(0);
        } else if (it < n_s5 + n_ret) {
          it -= n_s5;
          const bool ic = it >= 512;
          const int i2 = it - 512;
          ret_item(p, l, ic ? (i2 >> 3) : (it >> 6), ic ? ((i2 >> 1) & 3) : ((it >> 4) & 3), ic ? (i2 & 1) : (it & 15), ic, dry, smem);
        } else {
          it -= n_s5 + n_ret;
          const bool ic = it >= 2048;
          const int i2 = it - 2048;
          na_item(p, l, ic ? (i2 >> 5) : (it >> 8), ic ? ((i2 >> 2) & 7) : ((it >> 5) & 7), ic ? (i2 & 3) : (it & 31), ic, dry, smem);
        }
      }
      xcd_barrier(xb);
    }

#pragma unroll 1
    for (int rep = 0, nrep = REPS(5); rep < nrep; ++rep) {
      for (int tile = lbid + mt_min * 4; tile < 144 * 4; tile += nblk) {
        const int mt = tile >> 2, nt = tile & 3;
        f32x4 acc[4][4];
        zero_acc<4>(acc);
        gemm_core_v1<4, true>(acc, Gbuf + (size_t)mt * 128 * 512, 512, W + W_GLU + (size_t)nt * 128 * 512, 512, 512, (bf16_t*)smem);
        TIDVARS
        float4 bgl[4];
#pragma unroll
        for (int ni = 0; ni < 4; ++ni) bgl[ni] = *(const float4*)(p.b_glu + l * 512 + nt * 128 + wn * 64 + ni * 16 + quad * 4);
#pragma unroll
        for (int mi = 0; mi < 4; ++mi) {
          const int r = mt * 128 + wm * 64 + mi * 16 + l15;
          uint2 gg[4];
#pragma unroll
          for (int ni = 0; ni < 4; ++ni) gg[ni] = *(const uint2*)(Gbuf + (size_t)r * 512 + nt * 128 + wn * 64 + ni * 16 + quad * 4);
#pragma unroll
          for (int ni = 0; ni < 4; ++ni) {
            const int c = nt * 128 + wn * 64 + ni * 16 + quad * 4;
            const float g0 = __uint_as_float(gg[ni].x << 16), g1 = __uint_as_float(gg[ni].x & 0xffff0000u);
            const float g2 = __uint_as_float(gg[ni].y << 16), g3 = __uint_as_float(gg[ni].y & 0xffff0000u);
            uint2 o;
            o.x = pack2(g0 * sigm(acc[mi][ni][0] + bgl[ni].x), g1 * sigm(acc[mi][ni][1] + bgl[ni].y));
            o.y = pack2(g2 * sigm(acc[mi][ni][2] + bgl[ni].z), g3 * sigm(acc[mi][ni][3] + bgl[ni].w));
            *(uint2*)(proj + (size_t)r * PJ + PC_U + c) = o;
          }
        }
      }
      xcd_barrier(xb);
    }

#pragma unroll 1
    for (int rep = 0, nrep = REPS(3); rep < nrep; ++rep) {
      for (int tile = lbid + mt_min * 16; tile < 144 * 16; tile += nblk) {
        const int mt = tile >> 4, nt = tile & 15;
        f32x4 sg[3][4][2];
#pragma unroll
        for (int g = 0; g < 3; ++g) zero_acc<2>(sg[g]);
        gemm_core_g3(sg, hbuf + (size_t)mt * 128 * 1024, 1024, W + W_IN + (size_t)(3584 + nt * 64) * 1024,
                     (size_t)1024 * 1024, 1024, 1024, (bf16_t*)smem);
        unsigned sgp[3][4][2][2];
#pragma unroll
        for (int g = 0; g < 3; ++g)
#pragma unroll
          for (int mi = 0; mi < 4; ++mi)
#pragma unroll
            for (int ni = 0; ni < 2; ++ni) {
              sgp[g][mi][ni][0] = pack2(sigm(sg[g][mi][ni][0]), sigm(sg[g][mi][ni][1]));
              sgp[g][mi][ni][1] = pack2(sigm(sg[g][mi][ni][2]), sigm(sg[g][mi][ni][3]));
            }
        f32x4 tot[4][2];
        zero_acc<2>(tot);
#pragma unroll 1
        for (int i = 0; i < 3; ++i) {
          f32x4 ab[4][2];
          zero_acc<2>(ab);
          const bf16_t* Ai = proj + (size_t)mt * 128 * PJ + (i == 0 ? PC_U : (i == 1 ? PC_RG : PC_NQ));
          const bf16_t* Wi = W + (i == 0 ? W_BS5 : (i == 1 ? W_BRET : W_BNA)) + (size_t)nt * 64 * 512;
          gemm_core_v1<2, true>(ab, Ai, PJ, Wi, 512, 512, (bf16_t*)smem);
#pragma unroll
          for (int mi = 0; mi < 4; ++mi)
#pragma unroll
            for (int ni = 0; ni < 2; ++ni) {
              const unsigned u0 = sgp[0][mi][ni][0], u1 = sgp[0][mi][ni][1];
              tot[mi][ni][0] += __uint_as_float(u0 << 16) * ab[mi][ni][0];
              tot[mi][ni][1] += __uint_as_float(u0 & 0xffff0000u) * ab[mi][ni][1];
              tot[mi][ni][2] += __uint_as_float(u1 << 16) * ab[mi][ni][2];
              tot[mi][ni][3] += __uint_as_float(u1 & 0xffff0000u) * ab[mi][ni][3];
              sgp[0][mi][ni][0] = sgp[1][mi][ni][0];
              sgp[0][mi][ni][1] = sgp[1][mi][ni][1];
              sgp[1][mi][ni][0] = sgp[2][mi][ni][0];
              sgp[1][mi][ni][1] = sgp[2][mi][ni][1];
            }
        }
        TIDVARS
#pragma unroll
        for (int mi = 0; mi < 4; ++mi)
#pragma unroll
          for (int ni = 0; ni < 2; ++ni) {
            const int r = mt * 128 + wm * 64 + mi * 16 + l15;
            const int c = nt * 64 + wn * 32 + ni * 16 + quad * 4;
            uint2 o;
            o.x = pack2(tot[mi][ni][0], tot[mi][ni][1]);
            o.y = pack2(tot[mi][ni][2], tot[mi][ni][3]);
            *(uint2*)(mbuf + (size_t)r * 1024 + c) = o;
          }
      }
      xcd_barrier(xb);
    }

#pragma unroll 1
    for (int rep = 0, nrep = REPS(5); rep < nrep; ++rep) {
      const bool dry = rep > 0;
      float* dctx = dry ? (float*)(p.ws + WS_END) : ctxs;
      float* dx = dry ? (float*)(p.ws + WS_END) : p.out;
      const size_t omask = dry ? (size_t)0x7FFFFF : ~(size_t)0;
      if (last && !dry) {
        for (int tile = lbid + 64; tile < 72 * 8; tile += nblk)
          resid_big_tile(p, l, tile >> 3, tile & 7, mbuf, 1024, W + W_OUT, 1024, 1024, 2048, src_x, p.out, (bf16_t*)smem);
      } else
      for (int tile = lbid + mt_min * 8; tile < 144 * 8; tile += nblk) {
        const int mt = tile >> 3, nt = tile & 7;
        f32x4 acc[4][4];
        zero_acc<4>(acc);
        gemm_core_v1<4, true>(acc, mbuf + (size_t)mt * 128 * 1024, 1024, W + W_OUT + (size_t)nt * 128 * 1024, 1024, 1024, (bf16_t*)smem);
        TIDVARS
        const bool isc = mt < 16;
        const int modrow = isc ? 8 : (mt - 16) >> 4;
        const float* sbase = isc ? src_ctx : src_x;
        float* dbase = isc ? dctx : dx;
        float4 gv[4];
#pragma unroll
        for (int ni = 0; ni < 4; ++ni)
          gv[ni] = *(const float4*)(modp + (size_t)(l * 9 + modrow) * 6144 + 2048 + nt * 128 + wn * 64 + ni * 16 + quad * 4);
#pragma unroll
        for (int mi = 0; mi < 4; ++mi) {
          const int r = mt * 128 + wm * 64 + mi * 16 + l15;
          const size_t o = (size_t)(isc ? r : r - R_CTX) * 1024 + nt * 128 + wn * 64 + quad * 4;
          float4 sv[4];
#pragma unroll
          for (int ni = 0; ni < 4; ++ni) sv[ni] = *(const float4*)(sbase + o + ni * 16);
#pragma unroll
          for (int ni = 0; ni < 4; ++ni) {
            float4 ov;
            ov.x = sv[ni].x + gv[ni].x * acc[mi][ni][0];
            ov.y = sv[ni].y + gv[ni].y * acc[mi][ni][1];
            ov.z = sv[ni].z + gv[ni].z * acc[mi][ni][2];
            ov.w = sv[ni].w + gv[ni].w * acc[mi][ni][3];
            *(float4*)(dbase + ((o + ni * 16) & omask)) = ov;
          }
        }
      }
      xcd_barrier(xb);
    }

#pragma unroll 1
    for (int rep = 0, nrep = REPS63; rep < nrep; ++rep) {
      for (int it = bid + mt_min * 16; it < R_ALL / 8; it += nblk) {
        TIDVARS
        norm_rows(p, l, 1, it * 8 + w, ctxs, p.out);
      }
      xcd_barrier(xb);
    }

#pragma unroll 1
    for (int rep = 0, nrep = REPS(4); rep < nrep; ++rep) {
      for (int tile = lbid + (mt_min >> 1) * 44; tile < 72 * 44; tile += nblk) {
        const int mt = tile / 44, nt = tile % 44;
        f32x4 acc[8][4];
#pragma unroll
        for (int mi = 0; mi < 8; ++mi)
#pragma unroll
          for (int ni = 0; ni < 4; ++ni) acc[mi][ni] = f32x4{0.f, 0.f, 0.f, 0.f};
        gemm_core_big<true>(acc, hbuf + (size_t)mt * 256 * 1024, 1024, W + W_FG + (size_t)nt * 128 * 1024, 1024, 1024, (bf16_t*)smem);
        TIDVARS
#pragma unroll
        for (int mi = 0; mi < 8; ++mi)
#pragma unroll
          for (int ni = 0; ni < 2; ++ni) {
            const int r = mt * 256 + wm * 128 + mi * 16 + l15;
            const int c = nt * 64 + wn * 32 + ni * 16 + quad * 4;
            uint2 o;
            o.x = pack2(siluf_(acc[mi][ni][0]) * acc[mi][ni + 2][0], siluf_(acc[mi][ni][1]) * acc[mi][ni + 2][1]);
            o.y = pack2(siluf_(acc[mi][ni][2]) * acc[mi][ni + 2][2], siluf_(acc[mi][ni][3]) * acc[mi][ni + 2][3]);
            *(uint2*)(hid + (size_t)r * FFN + c) = o;
          }
      }
      xcd_barrier(xb);
    }

#pragma unroll 1
    for (int rep = 0, nrep = REPS(5); rep < nrep; ++rep) {
      const bool dry = rep > 0;
      float* dctx = dry ? (float*)(p.ws + WS_END) : ctxs;
      float* dx = dry ? (float*)(p.ws + WS_END) : p.out;
      const size_t omask = dry ? (size_t)0x7FFFFF : ~(size_t)0;
      if (last && !dry) {
        for (int tile = lbid + 64; tile < 72 * 8; tile += nblk)
          resid_big_tile(p, l, tile >> 3, tile & 7, hid, FFN, W + W_FD, FFN, FFN, 5120, p.out, p.out, (bf16_t*)smem);
      } else
      for (int tile = lbid + mt_min * 8; tile < 144 * 8; tile += nblk) {
        const int mt = tile >> 3, nt = tile & 7;
        f32x4 acc[4][4];
        zero_acc<4>(acc);
        gemm_core_v1<4, true>(acc, hid + (size_t)mt * 128 * FFN, FFN, W + W_FD + (size_t)nt * 128 * FFN, FFN, FFN, (bf16_t*)smem);
        TIDVARS
        const bool isc = mt < 16;
        const int modrow = isc ? 8 : (mt - 16) >> 4;
        const float* sbase = isc ? (const float*)ctxs : (const float*)p.out;
        float* dbase = isc ? dctx : dx;
        float4 gv[4];
#pragma unroll
        for (int ni = 0; ni < 4; ++ni)
          gv[ni] = *(const float4*)(modp + (size_t)(l * 9 + modrow) * 6144 + 5120 + nt * 128 + wn * 64 + ni * 16 + quad * 4);
#pragma unroll
        for (int mi = 0; mi < 4; ++mi) {
          const int r = mt * 128 + wm * 64 + mi * 16 + l15;
          const size_t o = (size_t)(isc ? r : r - R_CTX) * 1024 + nt * 128 + wn * 64 + quad * 4;
          float4 sv[4];
#pragma unroll
          for (int ni = 0; ni < 4; ++ni) sv[ni] = *(const float4*)(sbase + o + ni * 16);
#pragma unroll
          for (int ni = 0; ni < 4; ++ni) {
            float4 ov;
            ov.x = sv[ni].x + gv[ni].x * acc[mi][ni][0];
            ov.y = sv[ni].y + gv[ni].y * acc[mi][ni][1];
            ov.z = sv[ni].z + gv[ni].z * acc[mi][ni][2];
            ov.w = sv[ni].w + gv[ni].w * acc[mi][ni][3];
            *(float4*)(dbase + ((o + ni * 16) & omask)) = ov;
          }
        }
      }
      xcd_barrier(xb);
    }
#if PROBE == 7
    for (int i = 0; i < 10; ++i) xcd_barrier(xb);
#endif
  }

  for (int it = bid; it < (NB * SEQ) / 4; it += nblk) {
    TIDVARS
    const int r = it * 4 + w;
    float* row = p.out + (size_t)r * 1024;
    float4 v[4];
    float ss = 0.f;
#pragma unroll
    for (int i = 0; i < 4; ++i) {
      v[i] = *(const float4*)(row + i * 256 + lane * 4);
      ss += v[i].x * v[i].x + v[i].y * v[i].y + v[i].z * v[i].z + v[i].w * v[i].w;
    }
    ss = wave_sum(ss);
    const float rstd = rsqrtf(ss * (1.f / 1024.f) + 1e-6f);
#pragma unroll
    for (int i = 0; i < 4; ++i) {
      const float4 fn = *(const float4*)(p.fnorm + i * 256 + lane * 4);
      float4 o;
      o.x = v[i].x * rstd * fn.x;
      o.y = v[i].y * rstd * fn.y;
      o.z = v[i].z * rstd * fn.z;
      o.w = v[i].w * rstd * fn.w;
      *(float4*)(row + i * 256 + lane * 4) = o;
    }
  }
}

extern "C" void kernel_launch(void* const* d_in, const int* in_sizes, int n_in, void* d_out, int out_size,
                              void* d_ws, size_t ws_size, hipStream_t stream) {
  static int grid_blocks = 0;
  if (!grid_blocks) {
    int dev = 0, cus = 0, per_cu = 0;
    hipGetDevice(&dev);
    hipDeviceGetAttribute(&cus, hipDeviceAttributeMultiprocessorCount, dev);
    hipOccupancyMaxActiveBlocksPerMultiprocessor(&per_cu, fwd_megakernel, 256, 0);
    if (per_cu > 2) per_cu = 2;
    if (per_cu < 1) per_cu = 1;
    grid_blocks = cus * per_cu;
  }
  if (ws_size < WS_END) fprintf(stderr, "workspace too small: %zu < %zu\n", ws_size, (size_t)WS_END);
  Params p{};
  const float** pp = (const float**)&p;
  for (int i = 0; i < 27; ++i) pp[i] = (const float*)d_in[i];
  p.out = (float*)d_out;
  p.ws = (unsigned char*)d_ws;
  hipMemsetAsync((unsigned char*)d_ws + OFF_CNT, 0, 256 + 16384, stream);
  void* args[] = {&p};
  hipError_t e = hipLaunchCooperativeKernel((void*)fwd_megakernel, dim3(grid_blocks), dim3(256), args, 0, stream);
  if (e != hipSuccess) fprintf(stderr, "cooperative launch failed: %s (grid %d)\n", hipGetErrorString(e), grid_blocks);
}
```

```cpp
#include <hip/hip_runtime.h>
#include <hip/hip_cooperative_groups.h>
#include <cstdio>
#include <cstdint>
namespace cg = cooperative_groups;

typedef unsigned short bf16_t;
using bf16x8 = __attribute__((ext_vector_type(8))) short;
using f32x4 = __attribute__((ext_vector_type(4))) float;

#ifndef PROBE
#define PROBE 0
#endif
#define REPS(n) ((PROBE == (n)) ? (1 + (int)(p.fnorm != nullptr)) : 1)
#define REPS61 ((PROBE == 6 || PROBE == 61) ? (1 + (int)(p.fnorm != nullptr)) : 1)
#define REPS62 ((PROBE == 6 || PROBE == 62) ? (1 + (int)(p.fnorm != nullptr)) : 1)
#define REPS63 ((PROBE == 6 || PROBE == 63) ? (1 + (int)(p.fnorm != nullptr)) : 1)
#define MFMA16(a, b, c) __builtin_amdgcn_mfma_f32_16x16x32_bf16((a), (b), (c), 0, 0, 0)

constexpr int NB = 8, SEQ = 2048, CTXL = 256;
constexpr int R_CTX = NB * CTXL;
constexpr int R_ALL = R_CTX + NB * SEQ;
constexpr int N_IN = 6656, FFN = 2816;
constexpr int PJ = 2560;
constexpr int PC_U = 0, PC_RK = 512, PC_NK = 768, PC_RQ = 1280, PC_RG = 1536, PC_NQ = 2048;

constexpr size_t OFF_CTXS = 0;
constexpr size_t OFF_MOD = 8388608;
constexpr size_t OFF_ROT = OFF_MOD + 442368;
constexpr size_t OFF_CNT = OFF_ROT + 8192;
constexpr size_t OFF_BAR = OFF_CNT + 256;
constexpr size_t OFF_S5BB = OFF_BAR + 16384;
constexpr size_t OFF_S5CM = OFF_S5BB + 524288;
constexpr size_t OFF_S5AB = OFF_S5CM + 524288;
constexpr size_t OFF_S5AT = OFF_S5AB + 65536;
constexpr size_t OFF_W = OFF_S5AT + 65536;
constexpr size_t OFF_H = OFF_W + 36700160;
constexpr size_t OFF_G = OFF_H + 37748736;
constexpr size_t OFF_PROJ = OFF_G + 18874368;
constexpr size_t OFF_VT = OFF_PROJ + 94371840;
constexpr size_t OFF_UT = OFF_VT + 37748736;
constexpr size_t OFF_S5V = OFF_UT + 18874368;
constexpr size_t WS_END = OFF_S5V + 4194304;

constexpr int W_IN = 0, W_GLU = 6815744, W_BS5 = 7077888, W_BRET = 7602176, W_BNA = 8126464,
              W_OUT = 8650752, W_FG = 9699328, W_FU = 12582912, W_FD = 15466496;

constexpr int SMEM_BYTES = 73728;

struct Params {
  const float *x, *c, *ctx, *c_ctx, *w_ada, *b_ada, *w_in, *lam_re, *lam_im, *log_dt, *b_re, *b_im,
      *c_re, *c_im, *s5_d, *w_glu, *b_glu, *theta, *rpb, *w_bs5, *w_bret, *w_bna, *w_out, *w_fg,
      *w_fu, *w_fd, *fnorm;
  float* out;
  unsigned char* ws;
};

__device__ __forceinline__ bf16_t f2bf(float f) {
  unsigned u = __float_as_uint(f);
  u += 0x7fffu + ((u >> 16) & 1u);
  return (bf16_t)(u >> 16);
}
__device__ __forceinline__ float bf2f(bf16_t h) { return __uint_as_float(((unsigned)h) << 16); }
__device__ __forceinline__ float sigm(float x) { return __builtin_amdgcn_rcpf(1.f + __expf(-x)); }
__device__ __forceinline__ float siluf_(float x) { return x * sigm(x); }
typedef __bf16 bf16x2_t __attribute__((ext_vector_type(2)));
typedef float f32x2_t __attribute__((ext_vector_type(2)));
__device__ __forceinline__ unsigned pack2(float a, float b) {
  f32x2_t v = {a, b};
  bf16x2_t r = __builtin_convertvector(v, bf16x2_t);
  return __builtin_bit_cast(unsigned, r);
}
__device__ __forceinline__ bf16x8 pack8(const float (&v)[8]) {
  union { unsigned u[4]; bf16x8 h; } x;
  x.u[0] = pack2(v[0], v[1]);
  x.u[1] = pack2(v[2], v[3]);
  x.u[2] = pack2(v[4], v[5]);
  x.u[3] = pack2(v[6], v[7]);
  return x.h;
}

__device__ __forceinline__ int opaque_tid() {
  int x = threadIdx.x;
  asm volatile("" : "+v"(x));
  return x;
}
#define TIDVARS                                                                          \
  const int tid = opaque_tid(), lane = tid & 63, w = tid >> 6, wm = w >> 1, wn = w & 1; \
  const int l15 = lane & 15, quad = lane >> 4;                                           \
  (void)wm; (void)wn; (void)l15; (void)quad; (void)lane; (void)w;

#define XB_TMO      128
#define XB_XCNT(j)  (256  + 64 * (j))
#define XB_XSUB(j)  (1280 + 64 * (j))
#define XB_XGEN(j)  (2304 + 64 * (j))
#define XB_TOP      3328
#define XB_TOPGEN   3392
#define XCD_BAR_WORDS 3456
#define XB_SPIN_CAP (1u << 22)
#define LAS __attribute__((address_space(3)))

__device__ __forceinline__ unsigned xb_ld(unsigned* p) { return __hip_atomic_load(p, __ATOMIC_RELAXED, __HIP_MEMORY_SCOPE_AGENT); }
__device__ __forceinline__ unsigned xb_add(unsigned* p, unsigned v) { return __hip_atomic_fetch_add(p, v, __ATOMIC_RELAXED, __HIP_MEMORY_SCOPE_AGENT); }
__device__ __forceinline__ unsigned xb_xcc_id() { return (unsigned)__builtin_amdgcn_s_getreg((3 << 11) | 20) & 0xFu; }
#define XB_SPIN(cond, bar) do { unsigned _sp = 0; while (cond) { __builtin_amdgcn_s_sleep(1); \
    if ((++_sp & 255u) == 0u) { if (xb_ld(&(bar)[XB_TMO])) break; if (_sp > XB_SPIN_CAP) { atomicAdd(&(bar)[XB_TMO], 1u); break; } } } } while (0)

struct XcdBarrier {
  unsigned* bar; unsigned x;
  volatile LAS unsigned* st;
};
__device__ __forceinline__ XcdBarrier xcd_barrier_post(unsigned* bar, volatile LAS unsigned* st) {
  XcdBarrier b; b.bar = bar; b.x = xb_xcc_id(); b.st = st;
  if (threadIdx.x == 0) (void)xb_add(&bar[XB_XCNT(b.x)], 1u);
  return b;
}
__device__ __forceinline__ void xcd_barrier_complete(unsigned* bar, unsigned x, unsigned& nloc, unsigned& nx) {
  const unsigned G = gridDim.x * gridDim.y * gridDim.z;
  unsigned sum, cnt_, mine, sp = 0u;
  for (;;) {
    sum = 0u; cnt_ = 0u; mine = 0u;
#pragma unroll
    for (unsigned j = 0; j < 16; ++j) { const unsigned c = xb_ld(&bar[XB_XCNT(j)]); sum += c; cnt_ += (c > 0u) ? 1u : 0u; mine = (j == x) ? c : mine; }
    if (sum == G) break;
    __builtin_amdgcn_s_sleep(1);
    if ((++sp & 255u) == 0u) { if (xb_ld(&bar[XB_TMO])) break; if (sp > XB_SPIN_CAP) { atomicAdd(&bar[XB_TMO], 1u); break; } }
  }
  nloc = mine > 0u ? mine : 1u; nx = cnt_ > 0u ? cnt_ : 1u;
}
__device__ __forceinline__ void xcd_barrier(const XcdBarrier& b) {
  asm volatile("s_waitcnt vmcnt(0)" ::: "memory");
  __syncthreads();
  if (threadIdx.x == 0) {
    unsigned* bar = b.bar;
    __builtin_amdgcn_s_waitcnt(0);
    unsigned nloc = b.st[0], nx = b.st[1];
    if (nloc == 0u) { xcd_barrier_complete(bar, b.x, nloc, nx); b.st[0] = nloc; b.st[1] = nx; }
    const unsigned old = xb_add(&bar[XB_XSUB(b.x)], 1u);
    const unsigned gen = old / nloc;
    if (old + 1u == (gen + 1u) * nloc) {
      __builtin_amdgcn_fence(__ATOMIC_RELEASE, "agent");
      asm volatile("s_waitcnt vmcnt(0)" ::: "memory");
      const unsigned og = xb_add(&bar[XB_TOP], 1u);
      const unsigned tg = og / nx;
      if (og + 1u == (tg + 1u) * nx) xb_add(&bar[XB_TOPGEN], 1u);
      else XB_SPIN(xb_ld(&bar[XB_TOPGEN]) == tg, bar);
      __builtin_amdgcn_fence(__ATOMIC_ACQUIRE, "agent");
      xb_add(&bar[XB_XGEN(b.x)], 1u);
      asm volatile("s_waitcnt vmcnt(0)" ::: "memory");
    } else {
      XB_SPIN(xb_ld(&bar[XB_XGEN(b.x)]) == gen, bar);
      __builtin_amdgcn_fence(__ATOMIC_ACQUIRE, "agent");
      asm volatile("s_waitcnt vmcnt(0)" ::: "memory");
    }
  }
  __syncthreads();
}

constexpr int GEMM_STG = 18432;
template <int NI, bool SWAP>
__device__ __forceinline__ void gemm_core(f32x4 (&acc)[4][NI], const bf16_t* __restrict__ A, int lda,
                                          const bf16_t* __restrict__ Bt, int ldb, int K, bf16_t* sm) {
  constexpr int LS = 72;
  TIDVARS
  const int lrow = tid >> 3, lcc = tid & 7;
  const bf16_t* ap = A + (size_t)lrow * lda + lcc * 8;
  const bf16_t* bp = Bt + (size_t)lrow * ldb + lcc * 8;
  const size_t as = (size_t)32 * lda, bs = (size_t)32 * ldb;
  const int nk = K >> 6;
  uint4 xa0, xa1, xa2, xa3, xb0, xb1, xb2, xb3, ya0, ya1, ya2, ya3, yb0, yb1, yb2, yb3;
#define G_ISSUE(P, kt)                                              \
  {                                                                 \
    const int k_ = (((kt) < nk) ? (kt) : nk - 1) << 6;              \
    P##a0 = *(const uint4*)(ap + k_);                               \
    P##a1 = *(const uint4*)(ap + as + k_);                          \
    P##a2 = *(const uint4*)(ap + 2 * as + k_);                      \
    P##a3 = *(const uint4*)(ap + 3 * as + k_);                      \
    P##b0 = *(const uint4*)(bp + k_);                               \
    P##b1 = *(const uint4*)(bp + bs + k_);                          \
    if (NI > 2) {                                                   \
      P##b2 = *(const uint4*)(bp + 2 * bs + k_);                    \
      P##b3 = *(const uint4*)(bp + 3 * bs + k_);                    \
    }                                                               \
  }
#define G_WRITE(P, stage)                                           \
  {                                                                 \
    bf16_t* d_ = sm + (stage) * GEMM_STG + lrow * LS + lcc * 8;     \
    *(uint4*)(d_) = P##a0;                                          \
    *(uint4*)(d_ + 32 * LS) = P##a1;                                \
    *(uint4*)(d_ + 64 * LS) = P##a2;                                \
    *(uint4*)(d_ + 96 * LS) = P##a3;                                \
    *(uint4*)(d_ + 128 * LS) = P##b0;                               \
    *(uint4*)(d_ + 160 * LS) = P##b1;                               \
    if (NI > 2) {                                                   \
      *(uint4*)(d_ + 192 * LS) = P##b2;                             \
      *(uint4*)(d_ + 224 * LS) = P##b3;                             \
    }                                                               \
  }
#define G_COMPUTE(stage)                                                                           \
  {                                                                                                \
    const bf16_t* sra_ = sm + (stage) * GEMM_STG + (wm * 64 + l15) * LS + quad * 8;                \
    const bf16_t* srb_ = sm + (stage) * GEMM_STG + (128 + wn * 16 * NI + l15) * LS + quad * 8;     \
    __builtin_amdgcn_s_setprio(1);                                                                 \
    _Pragma("unroll") for (int ks = 0; ks < 2; ++ks) {                                             \
      bf16x8 a_[4], b_[NI];                                                                        \
      _Pragma("unroll") for (int mi = 0; mi < 4; ++mi) a_[mi] = *(const bf16x8*)(sra_ + mi * 16 * LS + ks * 32); \
      _Pragma("unroll") for (int ni = 0; ni < NI; ++ni) b_[ni] = *(const bf16x8*)(srb_ + ni * 16 * LS + ks * 32); \
      _Pragma("unroll") for (int mi = 0; mi < 4; ++mi)                                             \
      _Pragma("unroll") for (int ni = 0; ni < NI; ++ni)                                            \
        acc[mi][ni] = SWAP ? MFMA16(b_[ni], a_[mi], acc[mi][ni]) : MFMA16(a_[mi], b_[ni], acc[mi][ni]); \
    }                                                                                              \
    __builtin_amdgcn_s_setprio(0);                                                                 \
  }
  G_ISSUE(x, 0)
  G_ISSUE(y, 1)
  __syncthreads();
  G_WRITE(x, 0)
  G_ISSUE(x, 2)
  __syncthreads();
#pragma unroll 1
  for (int kt = 0; kt < nk; kt += 2) {
    G_WRITE(y, 1)
    G_ISSUE(y, kt + 3)
    G_COMPUTE(0)
    __syncthreads();
    G_WRITE(x, 0)
    G_ISSUE(x, kt + 4)
    G_COMPUTE(1)
    __syncthreads();
  }
#undef G_ISSUE
#undef G_WRITE
#undef G_COMPUTE
}

template <bool SWAP>
__device__ __forceinline__ void gemm_core_big(f32x4 (&acc)[8][4], const bf16_t* __restrict__ A, int lda,
                                              const bf16_t* __restrict__ Bt, int ldb, int K, bf16_t* sm) {
  constexpr int LS = 80;
  TIDVARS
  const int lrow = tid >> 3, lcc = tid & 7;
  const bf16_t* ap = A + (size_t)lrow * lda + lcc * 8;
  const bf16_t* bp = Bt + (size_t)lrow * ldb + lcc * 8;
  const size_t as = (size_t)32 * lda, bs = (size_t)32 * ldb;
  uint4 ra0, ra1, ra2, ra3, ra4, ra5, ra6, ra7, rb0, rb1, rb2, rb3;
#define GB_ISSUE(k_)                              \
  ra0 = *(const uint4*)(ap + (k_));               \
  ra1 = *(const uint4*)(ap + as + (k_));          \
  ra2 = *(const uint4*)(ap + 2 * as + (k_));      \
  ra3 = *(const uint4*)(ap + 3 * as + (k_));      \
  ra4 = *(const uint4*)(ap + 4 * as + (k_));      \
  ra5 = *(const uint4*)(ap + 5 * as + (k_));      \
  ra6 = *(const uint4*)(ap + 6 * as + (k_));      \
  ra7 = *(const uint4*)(ap + 7 * as + (k_));      \
  rb0 = *(const uint4*)(bp + (k_));               \
  rb1 = *(const uint4*)(bp + bs + (k_));          \
  rb2 = *(const uint4*)(bp + 2 * bs + (k_));      \
  rb3 = *(const uint4*)(bp + 3 * bs + (k_));
  GB_ISSUE(0)
  bf16_t* swa = sm + lrow * LS + lcc * 8;
  const bf16_t* sra = sm + (wm * 128 + l15) * LS + quad * 8;
  const bf16_t* srb = sm + (256 + wn * 64 + l15) * LS + quad * 8;
#pragma unroll 1
  for (int k0 = 0; k0 < K; k0 += 64) {
    __syncthreads();
    *(uint4*)(swa) = ra0;
    *(uint4*)(swa + 32 * LS) = ra1;
    *(uint4*)(swa + 64 * LS) = ra2;
    *(uint4*)(swa + 96 * LS) = ra3;
    *(uint4*)(swa + 128 * LS) = ra4;
    *(uint4*)(swa + 160 * LS) = ra5;
    *(uint4*)(swa + 192 * LS) = ra6;
    *(uint4*)(swa + 224 * LS) = ra7;
    *(uint4*)(swa + 256 * LS) = rb0;
    *(uint4*)(swa + 288 * LS) = rb1;
    *(uint4*)(swa + 320 * LS) = rb2;
    *(uint4*)(swa + 352 * LS) = rb3;
    __syncthreads();
    const int kn = (k0 + 64 < K) ? k0 + 64 : k0;
    GB_ISSUE(kn)
    __builtin_amdgcn_s_setprio(1);
#pragma unroll
    for (int ks = 0; ks < 2; ++ks) {
      bf16x8 b_[4];
#pragma unroll
      for (int ni = 0; ni < 4; ++ni) b_[ni] = *(const bf16x8*)(srb + ni * 16 * LS + ks * 32);
#pragma unroll
      for (int mh = 0; mh < 2; ++mh) {
        bf16x8 a_[4];
#pragma unroll
        for (int mi = 0; mi < 4; ++mi) a_[mi] = *(const bf16x8*)(sra + (mh * 4 + mi) * 16 * LS + ks * 32);
#pragma unroll
        for (int mi = 0; mi < 4; ++mi)
#pragma unroll
          for (int ni = 0; ni < 4; ++ni)
            acc[mh * 4 + mi][ni] = SWAP ? MFMA16(b_[ni], a_[mi], acc[mh * 4 + mi][ni]) : MFMA16(a_[mi], b_[ni], acc[mh * 4 + mi][ni]);
      }
    }
    __builtin_amdgcn_s_setprio(0);
  }
#undef GB_ISSUE
}

template <int NI, bool SWAP>
__device__ __forceinline__ void gemm_core_v1(f32x4 (&acc)[4][NI], const bf16_t* __restrict__ A, int lda,
                                             const bf16_t* __restrict__ Bt, int ldb, int K, bf16_t* sm) {
  constexpr int LS = 80;
  TIDVARS
  bf16_t* sA_ = sm;
  bf16_t* sB_ = sm + 128 * LS;
  const int lrow = tid >> 3, lcc = tid & 7;
  const bf16_t* ap = A + (size_t)lrow * lda + lcc * 8;
  const bf16_t* bp = Bt + (size_t)lrow * ldb + lcc * 8;
  const size_t as = (size_t)32 * lda, bs = (size_t)32 * ldb;
  uint4 ra0, ra1, ra2, ra3, rb0, rb1, rb2, rb3;
  ra0 = *(const uint4*)(ap);
  ra1 = *(const uint4*)(ap + as);
  ra2 = *(const uint4*)(ap + 2 * as);
  ra3 = *(const uint4*)(ap + 3 * as);
  rb0 = *(const uint4*)(bp);
  rb1 = *(const uint4*)(bp + bs);
  if (NI > 2) {
    rb2 = *(const uint4*)(bp + 2 * bs);
    rb3 = *(const uint4*)(bp + 3 * bs);
  } else {
    rb2 = rb0;
    rb3 = rb0;
  }
  bf16_t* swa = sA_ + lrow * LS + lcc * 8;
  bf16_t* swb = sB_ + lrow * LS + lcc * 8;
  const bf16_t* sra = sA_ + (wm * 64 + l15) * LS + quad * 8;
  const bf16_t* srb = sB_ + (wn * 16 * NI + l15) * LS + quad * 8;
  for (int k0 = 0; k0 < K; k0 += 64) {
    __syncthreads();
    *(uint4*)(swa) = ra0;
    *(uint4*)(swa + 32 * LS) = ra1;
    *(uint4*)(swa + 64 * LS) = ra2;
    *(uint4*)(swa + 96 * LS) = ra3;
    *(uint4*)(swb) = rb0;
    *(uint4*)(swb + 32 * LS) = rb1;
    if (NI > 2) {
      *(uint4*)(swb + 64 * LS) = rb2;
      *(uint4*)(swb + 96 * LS) = rb3;
    }
    __syncthreads();
    const int kn = (k0 + 64 < K) ? k0 + 64 : k0;
    ra0 = *(const uint4*)(ap + kn);
    ra1 = *(const uint4*)(ap + as + kn);
    ra2 = *(const uint4*)(ap + 2 * as + kn);
    ra3 = *(const uint4*)(ap + 3 * as + kn);
    rb0 = *(const uint4*)(bp + kn);
    rb1 = *(const uint4*)(bp + bs + kn);
    if (NI > 2) {
      rb2 = *(const uint4*)(bp + 2 * bs + kn);
      rb3 = *(const uint4*)(bp + 3 * bs + kn);
    }
    __builtin_amdgcn_s_setprio(1);
#pragma unroll
    for (int ks = 0; ks < 2; ++ks) {
      bf16x8 a[4], b[NI];
#pragma unroll
      for (int mi = 0; mi < 4; ++mi) a[mi] = *(const bf16x8*)(sra + mi * 16 * LS + ks * 32);
#pragma unroll
      for (int ni = 0; ni < NI; ++ni) b[ni] = *(const bf16x8*)(srb + ni * 16 * LS + ks * 32);
#pragma unroll
      for (int mi = 0; mi < 4; ++mi)
#pragma unroll
        for (int ni = 0; ni < NI; ++ni)
          acc[mi][ni] = SWAP ? MFMA16(b[ni], a[mi], acc[mi][ni]) : MFMA16(a[mi], b[ni], acc[mi][ni]);
    }
    __builtin_amdgcn_s_setprio(0);
  }
}

__device__ __forceinline__ void gemm_core_g3(f32x4 (&acc)[3][4][2], const bf16_t* __restrict__ A, int lda,
                                             const bf16_t* __restrict__ Bt, size_t gstride, int ldb, int K, bf16_t* sm) {
  constexpr int LS = 80;
  TIDVARS
  const int lrow = tid >> 3, lcc = tid & 7;
  const bf16_t* ap = A + (size_t)lrow * lda + lcc * 8;
  const bf16_t* bp = Bt + (size_t)lrow * ldb + lcc * 8;
  const size_t as = (size_t)32 * lda, bs = (size_t)32 * ldb;
  uint4 ra0, ra1, ra2, ra3, rb0, rb1, rb2, rb3, rb4, rb5;
#define G3_ISSUE(k_)                                    \
  ra0 = *(const uint4*)(ap + (k_));                     \
  ra1 = *(const uint4*)(ap + as + (k_));                \
  ra2 = *(const uint4*)(ap + 2 * as + (k_));            \
  ra3 = *(const uint4*)(ap + 3 * as + (k_));            \
  rb0 = *(const uint4*)(bp + (k_));                     \
  rb1 = *(const uint4*)(bp + bs + (k_));                \
  rb2 = *(const uint4*)(bp + gstride + (k_));           \
  rb3 = *(const uint4*)(bp + gstride + bs + (k_));      \
  rb4 = *(const uint4*)(bp + 2 * gstride + (k_));       \
  rb5 = *(const uint4*)(bp + 2 * gstride + bs + (k_));
  G3_ISSUE(0)
  bf16_t* swa = sm + lrow * LS + lcc * 8;
  const bf16_t* sra = sm + (wm * 64 + l15) * LS + quad * 8;
  const bf16_t* srb = sm + (128 + wn * 32 + l15) * LS + quad * 8;
#pragma unroll 1
  for (int k0 = 0; k0 < K; k0 += 64) {
    __syncthreads();
    *(uint4*)(swa) = ra0;
    *(uint4*)(swa + 32 * LS) = ra1;
    *(uint4*)(swa + 64 * LS) = ra2;
    *(uint4*)(swa + 96 * LS) = ra3;
    *(uint4*)(swa + 128 * LS) = rb0;
    *(uint4*)(swa + 160 * LS) = rb1;
    *(uint4*)(swa + 192 * LS) = rb2;
    *(uint4*)(swa + 224 * LS) = rb3;
    *(uint4*)(swa + 256 * LS) = rb4;
    *(uint4*)(swa + 288 * LS) = rb5;
    __syncthreads();
    const int kn = (k0 + 64 < K) ? k0 + 64 : k0;
    G3_ISSUE(kn)
    __builtin_amdgcn_s_setprio(1);
#pragma unroll
    for (int ks = 0; ks < 2; ++ks) {
      bf16x8 a_[4];
#pragma unroll
      for (int mi = 0; mi < 4; ++mi) a_[mi] = *(const bf16x8*)(sra + mi * 16 * LS + ks * 32);
#pragma unroll
      for (int g = 0; g < 3; ++g) {
        bf16x8 b_[2];
#pragma unroll
        for (int ni = 0; ni < 2; ++ni) b_[ni] = *(const bf16x8*)(srb + (g * 64 + ni * 16) * LS + ks * 32);
#pragma unroll
        for (int mi = 0; mi < 4; ++mi)
#pragma unroll
          for (int ni = 0; ni < 2; ++ni) acc[g][mi][ni] = MFMA16(b_[ni], a_[mi], acc[g][mi][ni]);
        __builtin_amdgcn_sched_barrier(0);
      }
    }
    __builtin_amdgcn_s_setprio(0);
  }
#undef G3_ISSUE
}

template <int NI>
__device__ __forceinline__ void zero_acc(f32x4 (&acc)[4][NI]) {
#pragma unroll
  for (int mi = 0; mi < 4; ++mi)
#pragma unroll
    for (int ni = 0; ni < NI; ++ni) acc[mi][ni] = f32x4{0.f, 0.f, 0.f, 0.f};
}

__device__ __forceinline__ float wave_sum(float v) {
#pragma unroll
  for (int off = 32; off >= 1; off >>= 1) v += __shfl_xor(v, off);
  return v;
}

__device__ void s5_tables(const Params& p, int idx) {
  bf16_t* bbt = (bf16_t*)(p.ws + OFF_S5BB);
  bf16_t* cm = (bf16_t*)(p.ws + OFF_S5CM);
  float* ab = (float*)(p.ws + OFF_S5AB);
  float* at = (float*)(p.ws + OFF_S5AT);
  const int pp = idx & 63, ldg = idx >> 6;
  const float lr = p.lam_re[idx], li = p.lam_im[idx];
  const float dt = expf(p.log_dt[ldg]);
  const float mag = expf(lr * dt), ang = li * dt;
  const float abr = mag * cosf(ang), abi = mag * sinf(ang);
  const float den = lr * lr + li * li;
  const float fr = ((abr - 1.f) * lr + abi * li) / den;
  const float fi = (abi * lr - (abr - 1.f) * li) / den;
  for (int h = 0; h < 16; ++h) {
    const float br = p.b_re[(size_t)idx * 16 + h], bi = p.b_im[(size_t)idx * 16 + h];
    bbt[(size_t)ldg * 2048 + (2 * pp) * 16 + h] = f2bf(fr * br - fi * bi);
    bbt[(size_t)ldg * 2048 + (2 * pp + 1) * 16 + h] = f2bf(fr * bi + fi * br);
    const size_t ci = ((size_t)ldg * 16 + h) * 64 + pp;
    cm[(size_t)ldg * 2048 + h * 128 + 2 * pp] = f2bf(p.c_re[ci]);
    cm[(size_t)ldg * 2048 + h * 128 + 2 * pp + 1] = f2bf(-p.c_im[ci]);
  }
  ab[idx * 2] = abr;
  ab[idx * 2 + 1] = abi;
  float tr = abr, ti = abi;
  for (int i = 0; i < 7; ++i) {
    const float nr = tr * tr - ti * ti, ni = 2.f * tr * ti;
    tr = nr;
    ti = ni;
  }
  at[idx * 2] = tr;
  at[idx * 2 + 1] = ti;
  bf16_t* vt = (bf16_t*)(p.ws + OFF_S5V) + (size_t)ldg * 16384;
  const int d = (ldg >> 5) & 1;
  float qr = 1.f, qi = 0.f;
  for (int k = 0; k < 128; ++k) {
    const int tp = d ? k : 127 - k;
    vt[pp * 128 + tp] = f2bf(qr);
    vt[(64 + pp) * 128 + tp] = f2bf(qi);
    const float nr = qr * abr - qi * abi, ni = qr * abi + qi * abr;
    qr = nr;
    qi = ni;
  }
}

__device__ void mod_item(const Params& p, int item, float* smem) {
  const int l = item / 96, cgp = item % 96;
  const int tid = opaque_tid();
  float* sc = smem;
  float* red = smem + 9 * 1024;
  __syncthreads();
  for (int i = tid; i < 9 * 1024; i += 256) {
    const int r = i >> 10, k = i & 1023;
    const float v = (r < 8) ? p.c[r * 1024 + k] : p.c_ctx[k];
    sc[i] = siluf_(v);
  }
  __syncthreads();
  const int col = cgp * 64 + (tid & 63), kq = tid >> 6;
  float acc[9];
#pragma unroll
  for (int r = 0; r < 9; ++r) acc[r] = 0.f;
  const float* wp = p.w_ada + (size_t)l * 1024 * 6144 + col;
#pragma unroll 1
  for (int k0 = kq * 256; k0 < kq * 256 + 256; k0 += 16) {
    float wv[16];
#pragma unroll
    for (int u = 0; u < 16; ++u) wv[u] = __builtin_nontemporal_load(wp + (size_t)(k0 + u) * 6144);
#pragma unroll
    for (int u = 0; u < 16; ++u)
#pragma unroll
      for (int r = 0; r < 9; ++r) acc[r] += sc[r * 1024 + k0 + u] * wv[u];
  }
#pragma unroll
  for (int r = 0; r < 9; ++r) red[(kq * 9 + r) * 64 + (tid & 63)] = acc[r];
  __syncthreads();
  float* mod = (float*)(p.ws + OFF_MOD);
  for (int i = tid; i < 9 * 64; i += 256) {
    const int r = i >> 6, cc = i & 63;
    const float s = red[(0 * 9 + r) * 64 + cc] + red[(1 * 9 + r) * 64 + cc] + red[(2 * 9 + r) * 64 + cc] +
                    red[(3 * 9 + r) * 64 + cc];
    mod[(size_t)(l * 9 + r) * 6144 + cgp * 64 + cc] = s + p.b_ada[l * 6144 + cgp * 64 + cc];
  }
}

__device__ __forceinline__ float4 nt_ld4(const float* p_) {
  const f32x4 v = __builtin_nontemporal_load((const f32x4*)p_);
  return float4{v[0], v[1], v[2], v[3]};
}
struct WcDesc { const float* src; int K, N, dst, gu, kt, nt; };
__device__ __forceinline__ WcDesc wc_decode(const Params& p, int l, int it) {
  WcDesc d;
  d.gu = -1;
  if (it < 1664) { d.src = p.w_in + (size_t)l * 1024 * 6656; d.K = 1024; d.N = 6656; d.dst = W_IN; }
  else if (it < 1728) { it -= 1664; d.src = p.w_glu + (size_t)l * 512 * 512; d.K = 512; d.N = 512; d.dst = W_GLU; }
  else if (it < 1856) { it -= 1728; d.src = p.w_bs5 + (size_t)l * 512 * 1024; d.K = 512; d.N = 1024; d.dst = W_BS5; }
  else if (it < 1984) { it -= 1856; d.src = p.w_bret + (size_t)l * 512 * 1024; d.K = 512; d.N = 1024; d.dst = W_BRET; }
  else if (it < 2112) { it -= 1984; d.src = p.w_bna + (size_t)l * 512 * 1024; d.K = 512; d.N = 1024; d.dst = W_BNA; }
  else if (it < 2368) { it -= 2112; d.src = p.w_out + (size_t)l * 1024 * 1024; d.K = 1024; d.N = 1024; d.dst = W_OUT; }
  else if (it < 3072) { it -= 2368; d.src = p.w_fg + (size_t)l * 1024 * 2816; d.K = 1024; d.N = 2816; d.dst = W_FG; d.gu = 0; }
  else if (it < 3776) { it -= 3072; d.src = p.w_fu + (size_t)l * 1024 * 2816; d.K = 1024; d.N = 2816; d.dst = W_FG; d.gu = 1; }
  else { it -= 3776; d.src = p.w_fd + (size_t)l * 2816 * 1024; d.K = 2816; d.N = 1024; d.dst = W_FD; }
  const int ntn = d.N >> 6;
  d.kt = it / ntn;
  d.nt = it % ntn;
  return d;
}
__device__ void wconv_range(const Params& p, int l, int first, int stride, int n, float* tile) {
  const int tid = opaque_tid();
  const int kr0 = tid >> 4, nc = (tid & 15) * 4;
  int it = first;
  if (it >= n) return;
  WcDesc d = wc_decode(p, l, it);
  float4 v0, v1, v2, v3;
#define WC_LOAD(D)                                                                           \
  {                                                                                          \
    const float* s_ = (D).src + (size_t)((D).kt * 64 + kr0) * (D).N + (D).nt * 64 + nc;      \
    v0 = nt_ld4((s_));                                    \
    v1 = nt_ld4((s_ + (size_t)16 * (D).N));               \
    v2 = nt_ld4((s_ + (size_t)32 * (D).N));               \
    v3 = nt_ld4((s_ + (size_t)48 * (D).N));               \
  }
  WC_LOAD(d)
  while (true) {
    __syncthreads();
    {
      float* t0 = tile + kr0 * 65 + nc;
      t0[0] = v0.x; t0[1] = v0.y; t0[2] = v0.z; t0[3] = v0.w;
      t0[16 * 65 + 0] = v1.x; t0[16 * 65 + 1] = v1.y; t0[16 * 65 + 2] = v1.z; t0[16 * 65 + 3] = v1.w;
      t0[32 * 65 + 0] = v2.x; t0[32 * 65 + 1] = v2.y; t0[32 * 65 + 2] = v2.z; t0[32 * 65 + 3] = v2.w;
      t0[48 * 65 + 0] = v3.x; t0[48 * 65 + 1] = v3.y; t0[48 * 65 + 2] = v3.z; t0[48 * 65 + 3] = v3.w;
    }
    __syncthreads();
    const int nx = it + stride;
    WcDesc dn = d;
    if (nx < n) {
      dn = wc_decode(p, l, nx);
      WC_LOAD(dn)
    }
    const int nn = tid >> 2, kq = tid & 3;
    unsigned u[8];
#pragma unroll
    for (int i = 0; i < 8; ++i)
      u[i] = pack2(tile[(kq * 16 + 2 * i) * 65 + nn], tile[(kq * 16 + 2 * i + 1) * 65 + nn]);
    bf16_t* Wd = (bf16_t*)(p.ws + OFF_W) + d.dst;
    int drow = d.nt * 64 + nn;
    if (d.gu >= 0) drow = (drow >> 6) * 128 + ((drow >> 5) & 1) * 64 + d.gu * 32 + (drow & 31);
    uint4* dp = (uint4*)(Wd + (size_t)drow * d.K + d.kt * 64 + kq * 16);
    dp[0] = uint4{u[0], u[1], u[2], u[3]};
    dp[1] = uint4{u[4], u[5], u[6], u[7]};
    if (nx >= n) break;
    it = nx;
    d = dn;
  }
#undef WC_LOAD
}

__device__ void norm_rows(const Params& p, int l, int which, int r, const float* src_ctx, const float* src_x) {
  const int lane = opaque_tid() & 63;
  float4 v[2][4];
  const float* mod[2];
#pragma unroll
  for (int q = 0; q < 2; ++q) {
    const int rr = r + q * 4;
    const float* src = (rr < R_CTX) ? src_ctx + (size_t)rr * 1024 : src_x + (size_t)(rr - R_CTX) * 1024;
    const int modrow = (rr < R_CTX) ? 8 : (rr - R_CTX) >> 11;
    mod[q] = (const float*)(p.ws + OFF_MOD) + (size_t)(l * 9 + modrow) * 6144 + which * 3072;
#pragma unroll
    for (int i = 0; i < 4; ++i)
      v[q][i] = (l == 0 && which == 0) ? nt_ld4(src + i * 256 + lane * 4)
                                       : *(const float4*)(src + i * 256 + lane * 4);
  }
#pragma unroll
  for (int q = 0; q < 2; ++q) {
    const int rr = r + q * 4;
    float ss = 0.f;
#pragma unroll
    for (int i = 0; i < 4; ++i) ss += v[q][i].x * v[q][i].x + v[q][i].y * v[q][i].y + v[q][i].z * v[q][i].z + v[q][i].w * v[q][i].w;
    ss = wave_sum(ss);
    const float rstd = rsqrtf(ss * (1.f / 1024.f) + 1e-6f);
    bf16_t* h = (bf16_t*)(p.ws + OFF_H) + (size_t)rr * 1024;
#pragma unroll
    for (int i = 0; i < 4; ++i) {
      const int c0 = i * 256 + lane * 4;
      const float4 sh = *(const float4*)(mod[q] + c0);
      const float4 sc = *(const float4*)(mod[q] + 1024 + c0);
      uint2 o;
      o.x = pack2(v[q][i].x * rstd * (1.f + sc.x) + sh.x, v[q][i].y * rstd * (1.f + sc.y) + sh.y);
      o.y = pack2(v[q][i].z * rstd * (1.f + sc.z) + sh.z, v[q][i].w * rstd * (1.f + sc.w) + sh.w);
      *(uint2*)(h + c0) = o;
    }
  }
}

__device__ __forceinline__ void resid_big_tile(const Params& p, int l, int mt, int nt, const bf16_t* A, int lda,
                                               const bf16_t* Bt, int ldb, int K, int goff, const float* sx, float* dx,
                                               bf16_t* smem) {
  f32x4 acc[8][4];
#pragma unroll
  for (int mi = 0; mi < 8; ++mi)
#pragma unroll
    for (int ni = 0; ni < 4; ++ni) acc[mi][ni] = f32x4{0.f, 0.f, 0.f, 0.f};
  gemm_core_big<true>(acc, A + (size_t)mt * 256 * lda, lda, Bt + (size_t)nt * 128 * ldb, ldb, K, smem);
  TIDVARS
  const int modrow = (mt - 8) >> 3;
  const float* modp_ = (const float*)(p.ws + OFF_MOD);
  float4 gv[4];
#pragma unroll
  for (int ni = 0; ni < 4; ++ni)
    gv[ni] = *(const float4*)(modp_ + (size_t)(l * 9 + modrow) * 6144 + goff + nt * 128 + wn * 64 + ni * 16 + quad * 4);
#pragma unroll
  for (int mi = 0; mi < 8; ++mi) {
    const int r = mt * 256 + wm * 128 + mi * 16 + l15;
    const size_t o = (size_t)(r - R_CTX) * 1024 + nt * 128 + wn * 64 + quad * 4;
    float4 sv[4];
#pragma unroll
    for (int ni = 0; ni < 4; ++ni) sv[ni] = *(const float4*)(sx + o + ni * 16);
#pragma unroll
    for (int ni = 0; ni < 4; ++ni) {
      float4 ov;
      ov.x = sv[ni].x + gv[ni].x * acc[mi][ni][0];
      ov.y = sv[ni].y + gv[ni].y * acc[mi][ni][1];
      ov.z = sv[ni].z + gv[ni].z * acc[mi][ni][2];
      ov.w = sv[ni].w + gv[ni].w * acc[mi][ni][3];
      *(float4*)(dx + o + ni * 16) = ov;
    }
  }
}

__device__ __forceinline__ void inproj_tile(const Params& p, int mt, int nt, bf16_t* smem) {
  const bf16_t* h = (const bf16_t*)(p.ws + OFF_H);
  const bf16_t* W = (const bf16_t*)(p.ws + OFF_W);
  bf16_t* proj = (bf16_t*)(p.ws + OFF_PROJ);
  bf16_t* vT = (bf16_t*)(p.ws + OFF_VT);
  const float* rot = (const float*)(p.ws + OFF_ROT);
  int colbase = 0, vrow = -1;
  float scale = 1.f;
  bool rotary = false;
  if (nt < 4) colbase = PC_U + nt * 128;
  else if (nt < 6) { colbase = PC_RK + (nt - 4) * 128; scale = 0.125f; rotary = true; }
  else if (nt < 10) vrow = (nt - 6) * 128;
  else if (nt < 14) colbase = PC_NK + (nt - 10) * 128;
  else if (nt < 18) vrow = 512 + (nt - 14) * 128;
  else if (nt < 20) { colbase = PC_RQ + (nt - 18) * 128; rotary = true; }
  else if (nt < 24) colbase = PC_RG + (nt - 20) * 128;
  else { colbase = PC_NQ + (nt - 24) * 128; scale = 0.125f; }
  f32x4 acc[8][4];
#pragma unroll
  for (int mi = 0; mi < 8; ++mi)
#pragma unroll
    for (int ni = 0; ni < 4; ++ni) acc[mi][ni] = f32x4{0.f, 0.f, 0.f, 0.f};
  if (vrow >= 0) {
    gemm_core_big<false>(acc, h + (size_t)mt * 256 * 1024, 1024, W + W_IN + (size_t)nt * 128 * 1024, 1024, 1024, smem);
    TIDVARS
    const int m0 = mt * 256 + wm * 128;
#pragma unroll
    for (int mi = 0; mi < 8; ++mi) {
      const int r0 = m0 + mi * 16 + quad * 4;
#pragma unroll
      for (int ni = 0; ni < 4; ++ni) {
        const int vr = vrow + wn * 64 + ni * 16 + l15;
        uint2 o;
        o.x = pack2(acc[mi][ni][0], acc[mi][ni][1]);
        o.y = pack2(acc[mi][ni][2], acc[mi][ni][3]);
        *(uint2*)(vT + (size_t)vr * R_ALL + r0) = o;
      }
    }
    return;
  }
  gemm_core_big<true>(acc, h + (size_t)mt * 256 * 1024, 1024, W + W_IN + (size_t)nt * 128 * 1024, 1024, 1024, smem);
  TIDVARS
  const int m0 = mt * 256 + wm * 128;
  if (rotary && mt >= 8) {
#pragma unroll
    for (int mi = 0; mi < 8; ++mi) {
      const int r = m0 + mi * 16 + l15;
      const int t = (r - R_CTX) & 2047;
      const int cr = t >> 6, cc = t & 63;
      const float4 c1 = *(const float4*)(rot + cr * 16 + quad * 4), s1 = *(const float4*)(rot + 1024 + cr * 16 + quad * 4);
      const float4 c2 = *(const float4*)(rot + cc * 16 + quad * 4), s2 = *(const float4*)(rot + 1024 + cc * 16 + quad * 4);
      const float cs1[4] = {c1.x, c1.y, c1.z, c1.w}, sn1[4] = {s1.x, s1.y, s1.z, s1.w};
      const float cs2[4] = {c2.x, c2.y, c2.z, c2.w}, sn2[4] = {s2.x, s2.y, s2.z, s2.w};
#pragma unroll
      for (int j = 0; j < 4; ++j) {
        const float a = acc[mi][0][j], bb = acc[mi][1][j];
        acc[mi][0][j] = a * cs1[j] - bb * sn1[j];
        acc[mi][1][j] = a * sn1[j] + bb * cs1[j];
        const float a2 = acc[mi][2][j], b2 = acc[mi][3][j];
        acc[mi][2][j] = a2 * cs2[j] - b2 * sn2[j];
        acc[mi][3][j] = a2 * sn2[j] + b2 * cs2[j];
      }
    }
  }
#pragma unroll
  for (int mi = 0; mi < 8; ++mi) {
    const int r = m0 + mi * 16 + l15;
#pragma unroll
    for (int ni = 0; ni < 4; ++ni) {
      uint2 o;
      o.x = pack2(acc[mi][ni][0] * scale, acc[mi][ni][1] * scale);
      o.y = pack2(acc[mi][ni][2] * scale, acc[mi][ni][3] * scale);
      *(uint2*)(proj + (size_t)r * PJ + colbase + wn * 64 + ni * 16 + quad * 4) = o;
    }
  }
  if (nt < 4) {
    bf16_t* uT = (bf16_t*)(p.ws + OFF_UT);
#pragma unroll
    for (int mi = 0; mi < 8; ++mi) {
      const int r = m0 + mi * 16 + l15;
#pragma unroll
      for (int ni = 0; ni < 4; ++ni)
#pragma unroll
        for (int j = 0; j < 4; ++j)
          uT[(size_t)(nt * 128 + wn * 64 + ni * 16 + quad * 4 + j) * R_ALL + r] = f2bf(acc[mi][ni][j]);
    }
  }
}

__device__ __forceinline__ void ret_item(const Params& p, int l, int b, int h, int qt, bool isctx, bool dry, unsigned char* smem) {
  TIDVARS
  bf16_t* proj = (bf16_t*)(p.ws + OFF_PROJ);
  const bf16_t* vT = (const bf16_t*)(p.ws + OFF_VT);
  const float LOG2E = 1.4426950408889634f;
  const float thf = p.theta[l * 8 + h], thb = p.theta[l * 8 + 4 + h];
  const float lgf = -log1pf(expf(-thf)) * LOG2E;
  const float lgb = -log1pf(expf(-thb)) * LOG2E;
  const int seqbase = isctx ? b * 256 : R_CTX + b * 2048;
  const int q0w = qt * 128 + w * 32;
  bf16x8 bq[2][2];
#pragma unroll
  for (int qb = 0; qb < 2; ++qb)
#pragma unroll
    for (int ks = 0; ks < 2; ++ks)
      bq[qb][ks] = *(const bf16x8*)(proj + (size_t)(seqbase + q0w + qb * 16 + l15) * PJ + PC_RQ + h * 64 + ks * 32 + quad * 8);
  float cfF[8], cfB[8];
#pragma unroll
  for (int j = 0; j < 8; ++j) {
    cfF[j] = exp2f(-lgf * (float)(quad * 8 + j));
    cfB[j] = exp2f(lgb * (float)(quad * 8 + j));
  }
  f32x4 O[2][8];
#pragma unroll
  for (int qb = 0; qb < 2; ++qb)
#pragma unroll
    for (int i = 0; i < 8; ++i) O[qb][i] = f32x4{0.f, 0.f, 0.f, 0.f};
  const int ntiles = isctx ? 4 : 36;
  const int lrow = tid >> 3, lcc = tid & 7;
  const bf16_t* kg = proj + PC_RK + h * 64 + lcc * 8 + (size_t)lrow * PJ;
  const bf16_t* vg = vT + (size_t)(h * 128 + lrow) * R_ALL + lcc * 8;
  constexpr int STG = 15360;
  bf16_t* sm = (bf16_t*)smem;
  const int swo = lrow * 80 + lcc * 8;
  uint4 rk0, rk1, rv0, rv1, rv2, rv3;
  {
    const int krow0 = b * 256;
    rk0 = *(const uint4*)(kg + (size_t)krow0 * PJ);
    rk1 = *(const uint4*)(kg + (size_t)(krow0 + 32) * PJ);
    rv0 = *(const uint4*)(vg + krow0);
    rv1 = *(const uint4*)(vg + (size_t)32 * R_ALL + krow0);
    rv2 = *(const uint4*)(vg + (size_t)64 * R_ALL + krow0);
    rv3 = *(const uint4*)(vg + (size_t)96 * R_ALL + krow0);
    *(uint4*)(sm + swo) = rk0;
    *(uint4*)(sm + swo + 32 * 80) = rk1;
    *(uint4*)(sm + 64 * 80 + swo) = rv0;
    *(uint4*)(sm + 64 * 80 + swo + 32 * 80) = rv1;
    *(uint4*)(sm + 64 * 80 + swo + 64 * 80) = rv2;
    *(uint4*)(sm + 64 * 80 + swo + 96 * 80) = rv3;
  }
  __syncthreads();
#pragma unroll 1
  for (int ti = 0; ti < ntiles; ++ti) {
    {
      const int tn = (ti + 1 < ntiles) ? ti + 1 : ti;
      const int krow0 = (tn < 4) ? b * 256 + tn * 64 : R_CTX + b * 2048 + (tn - 4) * 64;
      rk0 = *(const uint4*)(kg + (size_t)krow0 * PJ);
      rk1 = *(const uint4*)(kg + (size_t)(krow0 + 32) * PJ);
      rv0 = *(const uint4*)(vg + krow0);
      rv1 = *(const uint4*)(vg + (size_t)32 * R_ALL + krow0);
      rv2 = *(const uint4*)(vg + (size_t)64 * R_ALL + krow0);
      rv3 = *(const uint4*)(vg + (size_t)96 * R_ALL + krow0);
    }
    const bf16_t* Ks = sm + (ti & 1) * STG;
    const bf16_t* Vs = Ks + 64 * 80;
    const bool kctx = ti < 4;
#pragma unroll
    for (int g2 = 0; g2 < 2; ++g2) {
      const int kpos0 = (kctx ? ti * 64 : (ti - 4) * 64) + g2 * 32;
      const bf16_t* kr = Ks + (g2 * 32 + (l15 >> 2) * 8 + (l15 & 3)) * 80 + quad * 8;
      const bf16x8 kf0 = *(const bf16x8*)(kr), kf1 = *(const bf16x8*)(kr + 32);
      const bf16x8 kf2 = *(const bf16x8*)(kr + 4 * 80), kf3 = *(const bf16x8*)(kr + 4 * 80 + 32);
      bf16x8 pa[2];
#pragma unroll
      for (int qb = 0; qb < 2; ++qb) {
        f32x4 sx = f32x4{0.f, 0.f, 0.f, 0.f}, sy = f32x4{0.f, 0.f, 0.f, 0.f};
        sx = MFMA16(kf0, bq[qb][0], sx);
        sx = MFMA16(kf1, bq[qb][1], sx);
        sy = MFMA16(kf2, bq[qb][0], sy);
        sy = MFMA16(kf3, bq[qb][1], sy);
        const int qlo = q0w + qb * 16;
        const int qpos = qlo + l15;
        float pv[8];
        if (isctx || !kctx) {
          if (kpos0 + 31 <= qlo) {
            const float rf = exp2f(lgf * (float)(qpos - kpos0));
#pragma unroll
            for (int j = 0; j < 8; ++j) pv[j] = ((j < 4) ? sx[j & 3] : sy[j & 3]) * (rf * cfF[j]);
          } else if (kpos0 > qlo + 15) {
            const float rb = exp2f(lgb * (float)(kpos0 - qpos));
#pragma unroll
            for (int j = 0; j < 8; ++j) pv[j] = ((j < 4) ? sx[j & 3] : sy[j & 3]) * (rb * cfB[j]);
          } else {
#pragma unroll
            for (int j = 0; j < 8; ++j) {
              const int d = qpos - (kpos0 + quad * 8 + j);
              const float wgt = (d >= 0) ? exp2f(lgf * (float)d) : exp2f(lgb * (float)(-d));
              pv[j] = ((j < 4) ? sx[j & 3] : sy[j & 3]) * wgt;
            }
          }
        } else {
          const float rf = exp2f(lgf * (float)(qpos + 256 - kpos0));
          const float rb = exp2f(lgb * (float)(2048 - qpos + kpos0));
#pragma unroll
          for (int j = 0; j < 8; ++j) pv[j] = ((j < 4) ? sx[j & 3] : sy[j & 3]) * (rf * cfF[j] + rb * cfB[j]);
        }
        pa[qb] = pack8(pv);
      }
#pragma unroll
      for (int db = 0; db < 8; ++db) {
        const bf16x8 vf = *(const bf16x8*)(Vs + (db * 16 + l15) * 80 + g2 * 32 + quad * 8);
        O[0][db] = MFMA16(vf, pa[0], O[0][db]);
        O[1][db] = MFMA16(vf, pa[1], O[1][db]);
      }
    }
    if (ti + 1 < ntiles) {
      bf16_t* d = sm + ((ti + 1) & 1) * STG;
      *(uint4*)(d + swo) = rk0;
      *(uint4*)(d + swo + 32 * 80) = rk1;
      *(uint4*)(d + 64 * 80 + swo) = rv0;
      *(uint4*)(d + 64 * 80 + swo + 32 * 80) = rv1;
      *(uint4*)(d + 64 * 80 + swo + 64 * 80) = rv2;
      *(uint4*)(d + 64 * 80 + swo + 96 * 80) = rv3;
    }
    __syncthreads();
  }
  bf16_t* obase = dry ? (bf16_t*)(p.ws + WS_END) : proj;
  const size_t omask = dry ? (size_t)0x7FFFFF : ~(size_t)0;
#pragma unroll
  for (int qb = 0; qb < 2; ++qb) {
    float s = 0.f;
#pragma unroll
    for (int db = 0; db < 8; ++db) s += (O[qb][db][0] + O[qb][db][1]) + (O[qb][db][2] + O[qb][db][3]);
    s += __shfl_xor(s, 16);
    s += __shfl_xor(s, 32);
    const float mu = s * (1.f / 128.f);
    float v = 0.f;
#pragma unroll
    for (int db = 0; db < 8; ++db)
#pragma unroll
      for (int j = 0; j < 4; ++j) { const float d = O[qb][db][j] - mu; v += d * d; }
    v += __shfl_xor(v, 16);
    v += __shfl_xor(v, 32);
    const float rs = rsqrtf(v * (1.f / 128.f) + 1e-5f);
    const int orow = seqbase + q0w + qb * 16 + l15;
    uint2 gg[8];
#pragma unroll
    for (int db = 0; db < 8; ++db) gg[db] = *(const uint2*)(proj + (size_t)orow * PJ + PC_RG + h * 128 + db * 16 + quad * 4);
#pragma unroll
    for (int db = 0; db < 8; ++db) {
      const float g0 = __uint_as_float(gg[db].x << 16), g1 = __uint_as_float(gg[db].x & 0xffff0000u);
      const float g2 = __uint_as_float(gg[db].y << 16), g3 = __uint_as_float(gg[db].y & 0xffff0000u);
      uint2 o;
      o.x = pack2(siluf_(g0) * (O[qb][db][0] - mu) * rs, siluf_(g1) * (O[qb][db][1] - mu) * rs);
      o.y = pack2(siluf_(g2) * (O[qb][db][2] - mu) * rs, siluf_(g3) * (O[qb][db][3] - mu) * rs);
      *(uint2*)(obase + (((size_t)orow * PJ + PC_RG + h * 128 + db * 16 + quad * 4) & omask)) = o;
    }
  }
}

__device__ __forceinline__ void na_item(const Params& p, int l, int b, int h, int qidx, bool isctx, bool dry, unsigned char* smem) {
  TIDVARS
  bf16_t* proj = (bf16_t*)(p.ws + OFF_PROJ);
  const bf16_t* vT = (const bf16_t*)(p.ws + OFF_VT);
  const int qrow0 = isctx ? b * 256 + qidx * 64 : R_CTX + b * 2048 + qidx * 64;
  float* rpbs = (float*)smem;
  float* part = (float*)(smem + 2048);
  {
    const float* rp = p.rpb + (size_t)(l * 8 + h) * 465;
    for (int i = tid; i < 465; i += 256) rpbs[i] = rp[i];
  }
  bf16x8 bq[4][2];
#pragma unroll
  for (int qb = 0; qb < 4; ++qb)
#pragma unroll
    for (int ks = 0; ks < 2; ++ks)
      bq[qb][ks] = *(const bf16x8*)(proj + (size_t)(qrow0 + qb * 16 + l15) * PJ + PC_NQ + h * 64 + ks * 32 + quad * 8);
  const int r = qidx;
  const int rs = min(max(r - 4, 0), 24);
  const int winbase = R_CTX + b * 2048 + rs * 64;
  float m_run[4], l_run[4];
  f32x4 O[4][4];
#pragma unroll
  for (int qb = 0; qb < 4; ++qb) {
    m_run[qb] = -1e30f;
    l_run[qb] = 0.f;
#pragma unroll
    for (int i = 0; i < 4; ++i) O[qb][i] = f32x4{0.f, 0.f, 0.f, 0.f};
  }
  const int ngr = isctx ? 2 : 6;
  const bf16_t* kbase = proj + PC_NK + h * 64 + quad * 8 + (size_t)((l15 >> 2) * 8 + (l15 & 3)) * PJ;
  const bf16_t* vbase = vT + (size_t)(512 + h * 64 + l15) * R_ALL + quad * 8;
  bf16x8 kf0, kf1, kf2, kf3, vf0, vf1, vf2, vf3;
  {
    const int krow0 = b * 256 + w * 64;
    const bf16_t* kp = kbase + (size_t)krow0 * PJ;
    kf0 = *(const bf16x8*)(kp);
    kf1 = *(const bf16x8*)(kp + 32);
    kf2 = *(const bf16x8*)(kp + 4 * PJ);
    kf3 = *(const bf16x8*)(kp + 4 * PJ + 32);
    vf0 = *(const bf16x8*)(vbase + krow0);
    vf1 = *(const bf16x8*)(vbase + (size_t)16 * R_ALL + krow0);
    vf2 = *(const bf16x8*)(vbase + (size_t)32 * R_ALL + krow0);
    vf3 = *(const bf16x8*)(vbase + (size_t)48 * R_ALL + krow0);
  }
  __syncthreads();
#pragma unroll 1
  for (int g = 0; g < ngr; ++g) {
    bf16x8 nk0, nk1, nk2, nk3, nv0, nv1, nv2, nv3;
    {
      const int gn = (g + 1 < ngr) ? g + 1 : g;
      const int tn = w + 4 * (gn >> 1);
      const int krow0 = ((tn < 4) ? b * 256 + tn * 64 : winbase + (tn - 4) * 64) + (gn & 1) * 32;
      const bf16_t* kp = kbase + (size_t)krow0 * PJ;
      nk0 = *(const bf16x8*)(kp);
      nk1 = *(const bf16x8*)(kp + 32);
      nk2 = *(const bf16x8*)(kp + 4 * PJ);
      nk3 = *(const bf16x8*)(kp + 4 * PJ + 32);
      nv0 = *(const bf16x8*)(vbase + krow0);
      nv1 = *(const bf16x8*)(vbase + (size_t)16 * R_ALL + krow0);
      nv2 = *(const bf16x8*)(vbase + (size_t)32 * R_ALL + krow0);
      nv3 = *(const bf16x8*)(vbase + (size_t)48 * R_ALL + krow0);
    }
    const int t = w + 4 * (g >> 1);
    const int hb = g & 1;
    const bool win = t >= 4;
    const int a = t - 4;
#pragma unroll
    for (int qb = 0; qb < 4; ++qb) {
      if (win && ((qb == 0 && hb == 1) || (qb == 3 && hb == 0))) continue;
      f32x4 sx = f32x4{0.f, 0.f, 0.f, 0.f}, sy = f32x4{0.f, 0.f, 0.f, 0.f};
      sx = MFMA16(kf0, bq[qb][0], sx);
      sx = MFMA16(kf1, bq[qb][1], sx);
      sy = MFMA16(kf2, bq[qb][0], sy);
      sy = MFMA16(kf3, bq[qb][1], sy);
      float s[8];
#pragma unroll
      for (int j = 0; j < 8; ++j) s[j] = (j < 4) ? sx[j & 3] : sy[j & 3];
      if (win) {
        const int c = qb * 16 + l15;
        const int cs = min(max(c - 8, 0), 48);
#pragma unroll
        for (int j = 0; j < 8; ++j) {
          const int kc = hb * 32 + quad * 8 + j;
          const bool valid = (kc >= cs) && (kc < cs + 16);
          const int bi = min(max((rs + a - r + 7) * 31 + (kc - c + 15), 0), 464);
          const float sb = s[j] + rpbs[bi];
          s[j] = valid ? sb : -1e30f;
        }
      }
      float gmax = s[0];
#pragma unroll
      for (int j = 1; j < 8; ++j) gmax = fmaxf(gmax, s[j]);
      gmax = fmaxf(gmax, __shfl_xor(gmax, 16));
      gmax = fmaxf(gmax, __shfl_xor(gmax, 32));
      const float m_new = fmaxf(m_run[qb], gmax);
      const bool grew = m_new > m_run[qb];
      float ps = 0.f;
      float pv[8];
#pragma unroll
      for (int j = 0; j < 8; ++j) {
        pv[j] = __expf(s[j] - m_new);
        ps += pv[j];
      }
      const bf16x8 pa = pack8(pv);
      if (__any(grew)) {
        const float alpha = __expf(m_run[qb] - m_new);
        l_run[qb] *= alpha;
#pragma unroll
        for (int db = 0; db < 4; ++db)
#pragma unroll
          for (int j = 0; j < 4; ++j) O[qb][db][j] *= alpha;
      }
      m_run[qb] = m_new;
      l_run[qb] += ps;
      O[qb][0] = MFMA16(vf0, pa, O[qb][0]);
      O[qb][1] = MFMA16(vf1, pa, O[qb][1]);
      O[qb][2] = MFMA16(vf2, pa, O[qb][2]);
      O[qb][3] = MFMA16(vf3, pa, O[qb][3]);
    }
    kf0 = nk0; kf1 = nk1; kf2 = nk2; kf3 = nk3;
    vf0 = nv0; vf1 = nv1; vf2 = nv2; vf3 = nv3;
  }
#pragma unroll
  for (int qb = 0; qb < 4; ++qb) {
    float lt = l_run[qb];
    lt += __shfl_xor(lt, 16);
    lt += __shfl_xor(lt, 32);
    l_run[qb] = lt;
    if (qb != w) {
      float* ps_ = part + (w * 3 + (qb > w ? qb - 1 : qb)) * 1152;
#pragma unroll
      for (int db = 0; db < 4; ++db)
#pragma unroll
        for (int j = 0; j < 4; ++j) ps_[(db * 4 + j) * 64 + lane] = O[qb][db][j];
      ps_[1024 + lane] = m_run[qb];
      ps_[1088 + lane] = lt;
    }
  }
  __syncthreads();
  float m_own = 0.f, l_own = 0.f;
  f32x4 Oo[4];
#pragma unroll
  for (int qb = 0; qb < 4; ++qb)
    if (qb == w) {
      m_own = m_run[qb];
      l_own = l_run[qb];
#pragma unroll
      for (int db = 0; db < 4; ++db) Oo[db] = O[qb][db];
    }
  float m_tot = m_own;
#pragma unroll
  for (int v = 0; v < 4; ++v) {
    if (v == w) continue;
    const float* ps_ = part + (v * 3 + (w > v ? w - 1 : w)) * 1152;
    m_tot = fmaxf(m_tot, ps_[1024 + lane]);
  }
  {
    const float f = __expf(m_own - m_tot);
    l_own *= f;
#pragma unroll
    for (int db = 0; db < 4; ++db)
#pragma unroll
      for (int j = 0; j < 4; ++j) Oo[db][j] *= f;
  }
#pragma unroll
  for (int v = 0; v < 4; ++v) {
    if (v == w) continue;
    const float* ps_ = part + (v * 3 + (w > v ? w - 1 : w)) * 1152;
    const float f = __expf(ps_[1024 + lane] - m_tot);
    l_own += ps_[1088 + lane] * f;
#pragma unroll
    for (int db = 0; db < 4; ++db)
#pragma unroll
      for (int j = 0; j < 4; ++j) Oo[db][j] += ps_[(db * 4 + j) * 64 + lane] * f;
  }
  bf16_t* obase = dry ? (bf16_t*)(p.ws + WS_END) : proj;
  const size_t omask = dry ? (size_t)0x7FFFFF : ~(size_t)0;
  const float linv = 1.f / l_own;
  const int orow = qrow0 + w * 16 + l15;
#pragma unroll
  for (int db = 0; db < 4; ++db) {
    uint2 o;
    o.x = pack2(Oo[db][0] * linv, Oo[db][1] * linv);
    o.y = pack2(Oo[db][2] * linv, Oo[db][3] * linv);
    *(uint2*)(obase + (((size_t)orow * PJ + PC_NQ + h * 64 + db * 16 + quad * 4) & omask)) = o;
  }
}

struct S5Frag {
  bf16x8 bf[8];
  bf16x8 cf[4];
  float ar, ai;
};

__device__ __forceinline__ void s5_load_frag(const Params& p, S5Frag& f, int ldg, bool need_c) {
  const int lane = opaque_tid() & 63, l15 = lane & 15, quad = lane >> 4;
  const bf16_t* bbt = (const bf16_t*)(p.ws + OFF_S5BB) + (size_t)ldg * 2048;
  const bf16_t* cm = (const bf16_t*)(p.ws + OFF_S5CM) + (size_t)ldg * 2048;
  const float* ab = (const float*)(p.ws + OFF_S5AB) + (size_t)ldg * 128;
  const bf16x8 z = {0, 0, 0, 0, 0, 0, 0, 0};
#pragma unroll
  for (int pb = 0; pb < 8; ++pb)
    f.bf[pb] = (quad < 2) ? *(const bf16x8*)(bbt + (pb * 16 + l15) * 16 + quad * 8) : z;
  if (need_c) {
#pragma unroll
    for (int ks = 0; ks < 4; ++ks) f.cf[ks] = *(const bf16x8*)(cm + l15 * 128 + ks * 32 + quad * 8);
  }
  f.ar = ab[lane * 2];
  f.ai = ab[lane * 2 + 1];
}

template <int DIR>
__device__ __forceinline__ int s5_row(int b, int s0, int l15) {
  const int s = s0 + l15;
  if (s0 < 256) {
    const int j = DIR ? 255 - s : s;
    return b * 256 + j;
  }
  const int t = s - 256;
  const int tt = DIR ? 2047 - t : t;
  return R_CTX + b * 2048 + tt;
}

template <int DIR, bool WRITE>
__device__ __forceinline__ void s5_chunk(const bf16_t* __restrict__ proj, int b, int g, int cseq,
                                         const S5Frag& f, float& xr, float& xi, float* BUs, bf16_t* Xs,
                                         f32x4 (&yacc)[8]) {
  const int lane = opaque_tid() & 63, l15 = lane & 15, quad = lane >> 4;
  const bf16x8 z = {0, 0, 0, 0, 0, 0, 0, 0};
  const bf16_t* ub = proj + PC_U + g * 16 + (quad & 1) * 8;
  bf16x8 ucur = *(const bf16x8*)(ub + (size_t)s5_row<DIR>(b, cseq * 128, l15) * PJ);
#pragma unroll 1
  for (int sbs = 0; sbs < 8; ++sbs) {
    const int sn = cseq * 128 + ((sbs < 7) ? sbs + 1 : sbs) * 16;
    const bf16x8 unext = *(const bf16x8*)(ub + (size_t)s5_row<DIR>(b, sn, l15) * PJ);
    const bf16x8 uf = (quad < 2) ? ucur : z;
    __builtin_amdgcn_wave_barrier();
#pragma unroll
    for (int pb = 0; pb < 8; ++pb) {
      f32x4 bu = f32x4{0.f, 0.f, 0.f, 0.f};
      bu = MFMA16(uf, f.bf[pb], bu);
#pragma unroll
      for (int j = 0; j < 4; ++j) BUs[(quad * 4 + j) * 132 + pb * 16 + l15] = bu[j];
    }
    __builtin_amdgcn_wave_barrier();
    float2 bbv[16];
#pragma unroll
    for (int t = 0; t < 16; ++t) bbv[t] = *(const float2*)(BUs + t * 132 + 2 * lane);
#pragma unroll
    for (int t = 0; t < 16; ++t) {
      const float2 bb = bbv[t];
      const float nr = f.ar * xr - f.ai * xi + bb.x;
      const float ni = f.ar * xi + f.ai * xr + bb.y;
      xr = nr;
      xi = ni;
      if (WRITE) {
        const int rt = DIR ? 15 - t : t;
        *(unsigned*)(Xs + rt * 144 + 2 * lane) = pack2(xr, xi);
      }
    }
    if (WRITE) {
      __builtin_amdgcn_wave_barrier();
      const int tsb = DIR ? 7 - sbs : sbs;
      f32x4 yt = f32x4{0.f, 0.f, 0.f, 0.f};
#pragma unroll
      for (int ks = 0; ks < 4; ++ks) {
        const bf16x8 xa = *(const bf16x8*)(Xs + l15 * 144 + ks * 32 + quad * 8);
        yt = MFMA16(xa, f.cf[ks], yt);
      }
#pragma unroll
      for (int i = 0; i < 8; ++i)
        if (i == tsb) yacc[i] += yt;
    }
    ucur = unext;
  }
}

__device__ __forceinline__ void s5_item(const Params& p, int l, int b, int g, bool last, unsigned char* smem) {
  TIDVARS
  float* bound = (float*)smem;
  float* BUs = (float*)(smem + 18432 + w * 13056);
  bf16_t* Xs = (bf16_t*)(smem + 18432 + w * 13056 + 8448);
  const bf16_t* proj = (const bf16_t*)(p.ws + OFF_PROJ);
  bf16_t* G = (bf16_t*)(p.ws + OFF_G);
  f32x4 yacc[8];
  {
    const bf16_t* uT = (const bf16_t*)(p.ws + OFF_UT);
    bf16_t* tabs = (bf16_t*)(smem + 18432);
#pragma unroll 1
    for (int dir = 0; dir < 2; ++dir) {
      const int ldg = (l * 2 + dir) * 32 + g;
      __syncthreads();
      {
        const bf16_t* vt = (const bf16_t*)(p.ws + OFF_S5V) + (size_t)ldg * 16384;
#pragma unroll
        for (int i = 0; i < 8; ++i) {
          const int id = tid + i * 256, row = id >> 4, cc = id & 15;
          *(uint4*)(tabs + row * 144 + cc * 8) = *(const uint4*)(vt + row * 128 + cc * 8);
        }
      }
      float bre[4][4], bim[4][4];
      {
        const bf16_t* bbt = (const bf16_t*)(p.ws + OFF_S5BB) + (size_t)ldg * 2048;
#pragma unroll
        for (int nb = 0; nb < 4; ++nb) {
          const int ps = nb * 16 + l15;
          const uint2 r2 = *(const uint2*)(bbt + (2 * ps) * 16 + quad * 4);
          const uint2 i2 = *(const uint2*)(bbt + (2 * ps + 1) * 16 + quad * 4);
          bre[nb][0] = __uint_as_float(r2.x << 16); bre[nb][1] = __uint_as_float(r2.x & 0xffff0000u);
          bre[nb][2] = __uint_as_float(r2.y << 16); bre[nb][3] = __uint_as_float(r2.y & 0xffff0000u);
          bim[nb][0] = __uint_as_float(i2.x << 16); bim[nb][1] = __uint_as_float(i2.x & 0xffff0000u);
          bim[nb][2] = __uint_as_float(i2.y << 16); bim[nb][3] = __uint_as_float(i2.y & 0xffff0000u);
        }
      }
      __syncthreads();
#pragma unroll 1
      for (int c = w; c < 17; c += 4) {
        int rowbase;
        if (dir == 0) rowbase = (c < 2) ? b * 256 + 128 * c : R_CTX + b * 2048 + (c - 2) * 128;
        else rowbase = (c < 2) ? b * 256 + 128 * (1 - c) : R_CTX + b * 2048 + 128 * (17 - c);
        bf16x8 ua[4];
#pragma unroll
        for (int ks = 0; ks < 4; ++ks)
          ua[ks] = *(const bf16x8*)(uT + (size_t)(g * 16 + l15) * R_ALL + rowbase + ks * 32 + quad * 8);
        f32x4 z[8];
#pragma unroll
        for (int nb = 0; nb < 8; ++nb) {
          z[nb] = f32x4{0.f, 0.f, 0.f, 0.f};
#pragma unroll
          for (int ks = 0; ks < 4; ++ks) {
            const bf16x8 wf = *(const bf16x8*)(tabs + (nb * 16 + l15) * 144 + ks * 32 + quad * 8);
            z[nb] = MFMA16(ua[ks], wf, z[nb]);
          }
        }
#pragma unroll
        for (int nb = 0; nb < 4; ++nb) {
          float er = 0.f, ei = 0.f;
#pragma unroll
          for (int j = 0; j < 4; ++j) {
            er += bre[nb][j] * z[nb][j] - bim[nb][j] * z[nb + 4][j];
            ei += bre[nb][j] * z[nb + 4][j] + bim[nb][j] * z[nb][j];
          }
          er += __shfl_xor(er, 16);
          er += __shfl_xor(er, 32);
          ei += __shfl_xor(ei, 16);
          ei += __shfl_xor(ei, 32);
          if (quad == 0) {
            bound[(dir * 18 + c + 1) * 128 + nb * 16 + l15] = er;
            bound[(dir * 18 + c + 1) * 128 + 64 + nb * 16 + l15] = ei;
          }
        }
      }
    }
  }
  __syncthreads();
  if (tid < 128) {
    const int d = tid >> 6, pp = tid & 63;
    const float* at = (const float*)(p.ws + OFF_S5AT) + (size_t)((l * 2 + d) * 32 + g) * 128;
    const float tr = at[pp * 2], ti = at[pp * 2 + 1];
    float xr = 0.f, xi = 0.f;
    bound[(d * 18) * 128 + pp] = 0.f;
    bound[(d * 18) * 128 + 64 + pp] = 0.f;
    for (int c = 1; c < 18; ++c) {
      const float er = bound[(d * 18 + c) * 128 + pp], ei = bound[(d * 18 + c) * 128 + 64 + pp];
      const float nr = tr * xr - ti * xi + er;
      const float ni = tr * xi + ti * xr + ei;
      xr = nr;
      xi = ni;
      bound[(d * 18 + c) * 128 + pp] = xr;
      bound[(d * 18 + c) * 128 + 64 + pp] = xi;
    }
  }
  __syncthreads();
  const float dsk = p.s5_d[l * 512 + g * 16 + l15];
  for (int tc = (last ? 2 : 0) + w; tc < 18; tc += 4) {
#pragma unroll
    for (int i = 0; i < 8; ++i) yacc[i] = f32x4{0.f, 0.f, 0.f, 0.f};
    {
      S5Frag f;
      s5_load_frag(p, f, (l * 2 + 0) * 32 + g, true);
      const int cseq = tc;
      float xr = bound[(0 * 18 + cseq) * 128 + lane], xi = bound[(0 * 18 + cseq) * 128 + 64 + lane];
      s5_chunk<0, true>(proj, b, g, cseq, f, xr, xi, BUs, Xs, yacc);
    }
    {
      S5Frag f;
      s5_load_frag(p, f, (l * 2 + 1) * 32 + g, true);
      const int cseq = (tc < 2) ? 1 - tc : 19 - tc;
      float xr = bound[(1 * 18 + cseq) * 128 + lane], xi = bound[(1 * 18 + cseq) * 128 + 64 + lane];
      s5_chunk<1, true>(proj, b, g, cseq, f, xr, xi, BUs, Xs, yacc);
    }
    const int rowbase = (tc < 2) ? b * 256 + tc * 128 : R_CTX + b * 2048 + (tc - 2) * 128;
#pragma unroll
    for (int tsb = 0; tsb < 8; ++tsb)
#pragma unroll
      for (int j = 0; j < 4; ++j) {
        const int row = rowbase + tsb * 16 + quad * 4 + j;
        const float uu = bf2f(proj[(size_t)row * PJ + PC_U + g * 16 + l15]);
        const float y = yacc[tsb][j] + dsk * uu;
        const float zz = 0.7978845608028654f * (y + 0.044715f * y * y * y);
        const float gl = y / (1.f + __expf(-2.f * zz));
        G[(size_t)row * 512 + g * 16 + l15] = f2bf(gl);
      }
  }
}

#define EPI_LOOP(NI_)                                                        \
  _Pragma("unroll") for (int mi = 0; mi < 4; ++mi)                           \
  _Pragma("unroll") for (int ni = 0; ni < NI_; ++ni)                         \
  _Pragma("unroll") for (int j = 0; j < 4; ++j)

__global__ void __launch_bounds__(256, 2) fwd_megakernel(Params p) {
  cg::grid_group grid = cg::this_grid();
  __shared__ __attribute__((aligned(16))) unsigned char smem[SMEM_BYTES];
  __shared__ int s_item;
  __shared__ uint4 xb_words;
  if (threadIdx.x == 0) xb_words = make_uint4(0u, 0u, 0u, 0u);
  __syncthreads();
  const XcdBarrier xb = xcd_barrier_post((unsigned*)(p.ws + OFF_BAR), (volatile LAS unsigned*)&xb_words);
  const int nblk = gridDim.x, bid = blockIdx.x;
  const int lbid = bid;
#define sA ((bf16_t*)smem)
#define sB (((bf16_t*)smem) + 128 * 72)
#define W ((const bf16_t*)(p.ws + OFF_W))
#define hbuf ((bf16_t*)(p.ws + OFF_H))
#define Gbuf ((bf16_t*)(p.ws + OFF_G))
#define proj ((bf16_t*)(p.ws + OFF_PROJ))
#define mbuf ((bf16_t*)(p.ws + OFF_VT))
#define hid ((bf16_t*)(p.ws + OFF_PROJ))
#define ctxs ((float*)(p.ws + OFF_CTXS))
#define modp ((const float*)(p.ws + OFF_MOD))
#define cnt ((int*)(p.ws + OFF_CNT))

#pragma unroll 1
  for (int rep = 0, nrep = REPS61; rep < nrep; ++rep) {
    TIDVARS
    for (int i = (tid < 2 ? bid * 2 + tid : 1024); i < 1024; i += nblk * 2) {
      const int coord = i >> 4, fi = i & 15;
      const float inv = powf(10000.f, -(float)fi / 16.f);
      const float ang = (float)coord * inv;
      float* rot = (float*)(p.ws + OFF_ROT);
      rot[i] = cosf(ang);
      rot[1024 + i] = sinf(ang);
    }
    for (int i = (tid < 16 ? bid * 16 + tid : 8192); i < 8192; i += nblk * 16) s5_tables(p, i);
    for (int it = bid; it < 192; it += nblk) mod_item(p, it, (float*)smem);
    wconv_range(p, 0, (bid + 320) % nblk, nblk, 4480, (float*)smem);
    if (p.fnorm == nullptr) grid.sync();
    xcd_barrier(xb);
  }

  for (int l = 0; l < 2; ++l) {
    const bool last = (l == 1);
    const float* src_ctx = (l == 0) ? p.ctx : ctxs;
    const float* src_x = (l == 0) ? p.x : p.out;
    const int mt_min = last ? 16 : 0;

#pragma unroll 1
    for (int rep = 0, nrep = REPS62; rep < nrep; ++rep) {
      TIDVARS
      const int nnorm = R_ALL / 8;
      for (int it = bid; it < nnorm; it += nblk) norm_rows(p, l, 0, it * 8 + w, src_ctx, src_x);
      if (last) wconv_range(p, 1, bid, nblk, 4480, (float*)smem);
      xcd_barrier(xb);
    }

#pragma unroll 1
    for (int rep = 0, nrep = REPS(1); rep < nrep; ++rep) {
      for (int tile = lbid; tile < 72 * 28; tile += nblk) {
        const int mt = tile / 28, nt = tile % 28;
        if (last && mt < 8 && nt >= 18) continue;
        inproj_tile(p, mt, nt, (bf16_t*)smem);
      }
      xcd_barrier(xb);
    }

#pragma unroll 1
    for (int rep = 0, nrep = (PROBE >= 21 && PROBE <= 23) ? (1 + (int)(p.fnorm != nullptr)) : REPS(2); rep < nrep; ++rep) {
      TIDVARS
      const bool dry = rep > 0;
      const int n_s5 = 256;
      const int n_ret = 512 + (last ? 0 : 64);
      const int n_na = 2048 + (last ? 0 : 256);
      const int total = n_s5 + n_ret + n_na;
      while (true) {
        __syncthreads();
        if (tid == 0) s_item = atomicAdd(&cnt[l + 2 * rep], 1);
        __syncthreads();
        int it = s_item;
#if PROBE == 21
        if (rep > 0 && it >= n_s5) break;
#elif PROBE == 22
        if (rep > 0) { it += n_s5; if (it >= n_s5 + n_ret) break; }
#elif PROBE == 23
        if (rep > 0) it += n_s5 + n_ret;
#endif
        if (it >= total) break;
        if (it < n_s5) {
          __builtin_amdgcn_s_setprio(3);
          s5_item(p, l, it >> 5, it & 31, last, smem);
          __builtin_amdgcn_s_setprio(0);
        } else if (it < n_s5 + n_ret) {
          it -= n_s5;
          const bool ic = it >= 512;
          const int i2 = it - 512;
          ret_item(p, l, ic ? (i2 >> 3) : (it >> 6), ic ? ((i2 >> 1) & 3) : ((it >> 4) & 3), ic ? (i2 & 1) : (it & 15), ic, dry, smem);
        } else {
          it -= n_s5 + n_ret;
          const bool ic = it >= 2048;
          const int i2 = it - 2048;
          na_item(p, l, ic ? (i2 >> 5) : (it >> 8), ic ? ((i2 >> 2) & 7) : ((it >> 5) & 7), ic ? (i2 & 3) : (it & 31), ic, dry, smem);
        }
      }
      xcd_barrier(xb);
    }

#pragma unroll 1
    for (int rep = 0, nrep = REPS(5); rep < nrep; ++rep) {
      for (int tile = lbid + mt_min * 4; tile < 144 * 4; tile += nblk) {
        const int mt = tile >> 2, nt = tile & 3;
        f32x4 acc[4][4];
        zero_acc<4>(acc);
        gemm_core_v1<4, true>(acc, Gbuf + (size_t)mt * 128 * 512, 512, W + W_GLU + (size_t)nt * 128 * 512, 512, 512, (bf16_t*)smem);
        TIDVARS
        float4 bgl[4];
#pragma unroll
        for (int ni = 0; ni < 4; ++ni) bgl[ni] = *(const float4*)(p.b_glu + l * 512 + nt * 128 + wn * 64 + ni * 16 + quad * 4);
#pragma unroll
        for (int mi = 0; mi < 4; ++mi) {
          const int r = mt * 128 + wm * 64 + mi * 16 + l15;
          uint2 gg[4];
#pragma unroll
          for (int ni = 0; ni < 4; ++ni) gg[ni] = *(const uint2*)(Gbuf + (size_t)r * 512 + nt * 128 + wn * 64 + ni * 16 + quad * 4);
#pragma unroll
          for (int ni = 0; ni < 4; ++ni) {
            const int c = nt * 128 + wn * 64 + ni * 16 + quad * 4;
            const float g0 = __uint_as_float(gg[ni].x << 16), g1 = __uint_as_float(gg[ni].x & 0xffff0000u);
            const float g2 = __uint_as_float(gg[ni].y << 16), g3 = __uint_as_float(gg[ni].y & 0xffff0000u);
            uint2 o;
            o.x = pack2(g0 * sigm(acc[mi][ni][0] + bgl[ni].x), g1 * sigm(acc[mi][ni][1] + bgl[ni].y));
            o.y = pack2(g2 * sigm(acc[mi][ni][2] + bgl[ni].z), g3 * sigm(acc[mi][ni][3] + bgl[ni].w));
            *(uint2*)(proj + (size_t)r * PJ + PC_U + c) = o;
          }
        }
      }
      xcd_barrier(xb);
    }

#pragma unroll 1
    for (int rep = 0, nrep = REPS(3); rep < nrep; ++rep) {
      for (int tile = lbid + mt_min * 16; tile < 144 * 16; tile += nblk) {
        const int mt = tile >> 4, nt = tile & 15;
        f32x4 sg[3][4][2];
#pragma unroll
        for (int g = 0; g < 3; ++g) zero_acc<2>(sg[g]);
        gemm_core_g3(sg, hbuf + (size_t)mt * 128 * 1024, 1024, W + W_IN + (size_t)(3584 + nt * 64) * 1024,
                     (size_t)1024 * 1024, 1024, 1024, (bf16_t*)smem);
        unsigned sgp[3][4][2][2];
#pragma unroll
        for (int g = 0; g < 3; ++g)
#pragma unroll
          for (int mi = 0; mi < 4; ++mi)
#pragma unroll
            for (int ni = 0; ni < 2; ++ni) {
              sgp[g][mi][ni][0] = pack2(sigm(sg[g][mi][ni][0]), sigm(sg[g][mi][ni][1]));
              sgp[g][mi][ni][1] = pack2(sigm(sg[g][mi][ni][2]), sigm(sg[g][mi][ni][3]));
            }
        f32x4 tot[4][2];
        zero_acc<2>(tot);
#pragma unroll 1
        for (int i = 0; i < 3; ++i) {
          f32x4 ab[4][2];
          zero_acc<2>(ab);
          const bf16_t* Ai = proj + (size_t)mt * 128 * PJ + (i == 0 ? PC_U : (i == 1 ? PC_RG : PC_NQ));
          const bf16_t* Wi = W + (i == 0 ? W_BS5 : (i == 1 ? W_BRET : W_BNA)) + (size_t)nt * 64 * 512;
          gemm_core_v1<2, true>(ab, Ai, PJ, Wi, 512, 512, (bf16_t*)smem);
#pragma unroll
          for (int mi = 0; mi < 4; ++mi)
#pragma unroll
            for (int ni = 0; ni < 2; ++ni) {
              const unsigned u0 = sgp[0][mi][ni][0], u1 = sgp[0][mi][ni][1];
              tot[mi][ni][0] += __uint_as_float(u0 << 16) * ab[mi][ni][0];
              tot[mi][ni][1] += __uint_as_float(u0 & 0xffff0000u) * ab[mi][ni][1];
              tot[mi][ni][2] += __uint_as_float(u1 << 16) * ab[mi][ni][2];
              tot[mi][ni][3] += __uint_as_float(u1 & 0xffff0000u) * ab[mi][ni][3];
              sgp[0][mi][ni][0] = sgp[1][mi][ni][0];
              sgp[0][mi][ni][1] = sgp[1][mi][ni][1];
              sgp[1][mi][ni][0] = sgp[2][mi][ni][0];
              sgp[1][mi][ni][1] = sgp[2][mi][ni][1];
            }
        }
        TIDVARS
#pragma unroll
        for (int mi = 0; mi < 4; ++mi)
#pragma unroll
          for (int ni = 0; ni < 2; ++ni) {
            const int r = mt * 128 + wm * 64 + mi * 16 + l15;
            const int c = nt * 64 + wn * 32 + ni * 16 + quad * 4;
            uint2 o;
            o.x = pack2(tot[mi][ni][0], tot[mi][ni][1]);
            o.y = pack2(tot[mi][ni][2], tot[mi][ni][3]);
            *(uint2*)(mbuf + (size_t)r * 1024 + c) = o;
          }
      }
      xcd_barrier(xb);
    }

#pragma unroll 1
    for (int rep = 0, nrep = REPS(5); rep < nrep; ++rep) {
      const bool dry = rep > 0;
      float* dctx = dry ? (float*)(p.ws + WS_END) : ctxs;
      float* dx = dry ? (float*)(p.ws + WS_END) : p.out;
      const size_t omask = dry ? (size_t)0x7FFFFF : ~(size_t)0;
      if (last && !dry) {
        for (int tile = lbid + 64; tile < 72 * 8; tile += nblk)
          resid_big_tile(p, l, tile >> 3, tile & 7, mbuf, 1024, W + W_OUT, 1024, 1024, 2048, src_x, p.out, (bf16_t*)smem);
      } else
      for (int tile = lbid + mt_min * 8; tile < 144 * 8; tile += nblk) {
        const int mt = tile >> 3, nt = tile & 7;
        f32x4 acc[4][4];
        zero_acc<4>(acc);
        gemm_core_v1<4, true>(acc, mbuf + (size_t)mt * 128 * 1024, 1024, W + W_OUT + (size_t)nt * 128 * 1024, 1024, 1024, (bf16_t*)smem);
        TIDVARS
        const bool isc = mt < 16;
        const int modrow = isc ? 8 : (mt - 16) >> 4;
        const float* sbase = isc ? src_ctx : src_x;
        float* dbase = isc ? dctx : dx;
        float4 gv[4];
#pragma unroll
        for (int ni = 0; ni < 4; ++ni)
          gv[ni] = *(const float4*)(modp + (size_t)(l * 9 + modrow) * 6144 + 2048 + nt * 128 + wn * 64 + ni * 16 + quad * 4);
#pragma unroll
        for (int mi = 0; mi < 4; ++mi) {
          const int r = mt * 128 + wm * 64 + mi * 16 + l15;
          const size_t o = (size_t)(isc ? r : r - R_CTX) * 1024 + nt * 128 + wn * 64 + quad * 4;
          float4 sv[4];
#pragma unroll
          for (int ni = 0; ni < 4; ++ni) sv[ni] = *(const float4*)(sbase + o + ni * 16);
#pragma unroll
          for (int ni = 0; ni < 4; ++ni) {
            float4 ov;
            ov.x = sv[ni].x + gv[ni].x * acc[mi][ni][0];
            ov.y = sv[ni].y + gv[ni].y * acc[mi][ni][1];
            ov.z = sv[ni].z + gv[ni].z * acc[mi][ni][2];
            ov.w = sv[ni].w + gv[ni].w * acc[mi][ni][3];
            *(float4*)(dbase + ((o + ni * 16) & omask)) = ov;
          }
        }
      }
      xcd_barrier(xb);
    }

#pragma unroll 1
    for (int rep = 0, nrep = REPS63; rep < nrep; ++rep) {
      for (int it = bid + mt_min * 16; it < R_ALL / 8; it += nblk) {
        TIDVARS
        norm_rows(p, l, 1, it * 8 + w, ctxs, p.out);
      }
      xcd_barrier(xb);
    }

#pragma unroll 1
    for (int rep = 0, nrep = REPS(4); rep < nrep; ++rep) {
      for (int tile = lbid + (mt_min >> 1) * 44; tile < 72 * 44; tile += nblk) {
        const int mt = tile / 44, nt = tile % 44;
        f32x4 acc[8][4];
#pragma unroll
        for (int mi = 0; mi < 8; ++mi)
#pragma unroll
          for (int ni = 0; ni < 4; ++ni) acc[mi][ni] = f32x4{0.f, 0.f, 0.f, 0.f};
        gemm_core_big<true>(acc, hbuf + (size_t)mt * 256 * 1024, 1024, W + W_FG + (size_t)nt * 128 * 1024, 1024, 1024, (bf16_t*)smem);
        TIDVARS
#pragma unroll
        for (int mi = 0; mi < 8; ++mi)
#pragma unroll
          for (int ni = 0; ni < 2; ++ni) {
            const int r = mt * 256 + wm * 128 + mi * 16 + l15;
            const int c = nt * 64 + wn * 32 + ni * 16 + quad * 4;
            uint2 o;
            o.x = pack2(siluf_(acc[mi][ni][0]) * acc[mi][ni + 2][0], siluf_(acc[mi][ni][1]) * acc[mi][ni + 2][1]);
            o.y = pack2(siluf_(acc[mi][ni][2]) * acc[mi][ni + 2][2], siluf_(acc[mi][ni][3]) * acc[mi][ni + 2][3]);
            *(uint2*)(hid + (size_t)r * FFN + c) = o;
          }
      }
      xcd_barrier(xb);
    }

#pragma unroll 1
    for (int rep = 0, nrep = REPS(5); rep < nrep; ++rep) {
      const bool dry = rep > 0;
      float* dctx = dry ? (float*)(p.ws + WS_END) : ctxs;
      float* dx = dry ? (float*)(p.ws + WS_END) : p.out;
      const size_t omask = dry ? (size_t)0x7FFFFF : ~(size_t)0;
      if (last && !dry) {
        for (int tile = lbid + 64; tile < 72 * 8; tile += nblk)
          resid_big_tile(p, l, tile >> 3, tile & 7, hid, FFN, W + W_FD, FFN, FFN, 5120, p.out, p.out, (bf16_t*)smem);
      } else
      for (int tile = lbid + mt_min * 8; tile < 144 * 8; tile += nblk) {
        const int mt = tile >> 3, nt = tile & 7;
        f32x4 acc[4][4];
        zero_acc<4>(acc);
        gemm_core_v1<4, true>(acc, hid + (size_t)mt * 128 * FFN, FFN, W + W_FD + (size_t)nt * 128 * FFN, FFN, FFN, (bf16_t*)smem);
        TIDVARS
        const bool isc = mt < 16;
        const int modrow = isc ? 8 : (mt - 16) >> 4;
        const float* sbase = isc ? (const float*)ctxs : (const float*)p.out;
        float* dbase = isc ? dctx : dx;
        float4 gv[4];
#pragma unroll
        for (int ni = 0; ni < 4; ++ni)
          gv[ni] = *(const float4*)(modp + (size_t)(l * 9 + modrow) * 6144 + 5120 + nt * 128 + wn * 64 + ni * 16 + quad * 4);
#pragma unroll
        for (int mi = 0; mi < 4; ++mi) {
          const int r = mt * 128 + wm * 64 + mi * 16 + l15;
          const size_t o = (size_t)(isc ? r : r - R_CTX) * 1024 + nt * 128 + wn * 64 + quad * 4;
          float4 sv[4];
#pragma unroll
          for (int ni = 0; ni < 4; ++ni) sv[ni] = *(const float4*)(sbase + o + ni * 16);
#pragma unroll
          for (int ni = 0; ni < 4; ++ni) {
            float4 ov;
            ov.x = sv[ni].x + gv[ni].x * acc[mi][ni][0];
            ov.y = sv[ni].y + gv[ni].y * acc[mi][ni][1];
            ov.z = sv[ni].z + gv[ni].z * acc[mi][ni][2];
            ov.w = sv[ni].w + gv[ni].w * acc[mi][ni][3];
            *(float4*)(dbase + ((o + ni * 16) & omask)) = ov;
          }
        }
      }
      xcd_barrier(xb);
    }
#if PROBE == 7
    for (int i = 0; i < 10; ++i) xcd_barrier(xb);
#endif
  }

  for (int it = bid; it < (NB * SEQ) / 4; it += nblk) {
    TIDVARS
    const int r = it * 4 + w;
    float* row = p.out + (size_t)r * 1024;
    float4 v[4];
    float ss = 0.f;
#pragma unroll
    for (int i = 0; i < 4; ++i) {
      v[i] = *(const float4*)(row + i * 256 + lane * 4);
      ss += v[i].x * v[i].x + v[i].y * v[i].y + v[i].z * v[i].z + v[i].w * v[i].w;
    }
    ss = wave_sum(ss);
    const float rstd = rsqrtf(ss * (1.f / 1024.f) + 1e-6f);
#pragma unroll
    for (int i = 0; i < 4; ++i) {
      const float4 fn = *(const float4*)(p.fnorm + i * 256 + lane * 4);
      float4 o;
      o.x = v[i].x * rstd * fn.x;
      o.y = v[i].y * rstd * fn.y;
      o.z = v[i].z * rstd * fn.z;
      o.w = v[i].w * rstd * fn.w;
      *(float4*)(row + i * 256 + lane * 4) = o;
    }
  }
}

extern "C" void kernel_launch(void* const* d_in, const int* in_sizes, int n_in, void* d_out, int out_size,
                              void* d_ws, size_t ws_size, hipStream_t stream) {
  static int grid_blocks = 0;
  if (!grid_blocks) {
    int dev = 0, cus = 0, per_cu = 0;
    hipGetDevice(&dev);
    hipDeviceGetAttribute(&cus, hipDeviceAttributeMultiprocessorCount, dev);
    hipOccupancyMaxActiveBlocksPerMultiprocessor(&per_cu, fwd_megakernel, 256, 0);
    if (per_cu > 2) per_cu = 2;
    if (per_cu < 1) per_cu = 1;
    grid_blocks = cus * per_cu;
  }
  if (ws_size < WS_END) fprintf(stderr, "workspace too small: %zu < %zu\n", ws_size, (size_t)WS_END);
  Params p{};
  const float** pp = (const float**)&p;
  for (int i = 0; i < 27; ++i) pp[i] = (const float*)d_in[i];
  p.out = (float*)d_out;
  p.ws = (unsigned char*)d_ws;
  hipMemsetAsync((unsigned char*)d_ws + OFF_CNT, 0, 256 + 16384, stream);
  void* args[] = {&p};
  hipError_t e = hipLaunchCooperativeKernel((void*)fwd_megakernel, dim3(grid_blocks), dim3(256), args, 0, stream);
  if (e != hipSuccess) fprintf(stderr, "cooperative launch failed: %s (grid %d)\n", hipGetErrorString(e), grid_blocks);
}
```

```cpp
#include <hip/hip_runtime.h>
#include <hip/hip_cooperative_groups.h>
#include <cstdio>
#include <cstdint>
namespace cg = cooperative_groups;

typedef unsigned short bf16_t;
using bf16x8 = __attribute__((ext_vector_type(8))) short;
using f32x4 = __attribute__((ext_vector_type(4))) float;

#ifndef PROBE
#define PROBE 0
#endif
#define REPS(n) ((PROBE == (n)) ? (1 + (int)(p.fnorm != nullptr)) : 1)
#define REPS61 ((PROBE == 6 || PROBE == 61) ? (1 + (int)(p.fnorm != nullptr)) : 1)
#define REPS62 ((PROBE == 6 || PROBE == 62) ? (1 + (int)(p.fnorm != nullptr)) : 1)
#define REPS63 ((PROBE == 6 || PROBE == 63) ? (1 + (int)(p.fnorm != nullptr)) : 1)
#define MFMA16(a, b, c) __builtin_amdgcn_mfma_f32_16x16x32_bf16((a), (b), (c), 0, 0, 0)

constexpr int NB = 8, SEQ = 2048, CTXL = 256;
constexpr int R_CTX = NB * CTXL;
constexpr int R_ALL = R_CTX + NB * SEQ;
constexpr int N_IN = 6656, FFN = 2816;
constexpr int PJ = 2560;
constexpr int PC_U = 0, PC_RK = 512, PC_NK = 768, PC_RQ = 1280, PC_RG = 1536, PC_NQ = 2048;

constexpr size_t OFF_CTXS = 0;
constexpr size_t OFF_MOD = 8388608;
constexpr size_t OFF_ROT = OFF_MOD + 442368;
constexpr size_t OFF_CNT = OFF_ROT + 8192;
constexpr size_t OFF_BAR = OFF_CNT + 256;
constexpr size_t OFF_S5BB = OFF_BAR + 16384;
constexpr size_t OFF_S5CM = OFF_S5BB + 524288;
constexpr size_t OFF_S5AB = OFF_S5CM + 524288;
constexpr size_t OFF_S5AT = OFF_S5AB + 65536;
constexpr size_t OFF_W = OFF_S5AT + 65536;
constexpr size_t OFF_H = OFF_W + 36700160;
constexpr size_t OFF_G = OFF_H + 37748736;
constexpr size_t OFF_PROJ = OFF_G + 18874368;
constexpr size_t OFF_VT = OFF_PROJ + 94371840;
constexpr size_t OFF_UT = OFF_VT + 37748736;
constexpr size_t OFF_S5V = OFF_UT + 18874368;
constexpr size_t WS_END = OFF_S5V + 4194304;

constexpr int W_IN = 0, W_GLU = 6815744, W_BS5 = 7077888, W_BRET = 7602176, W_BNA = 8126464,
              W_OUT = 8650752, W_FG = 9699328, W_FU = 12582912, W_FD = 15466496;

constexpr int SMEM_BYTES = 73728;

struct Params {
  const float *x, *c, *ctx, *c_ctx, *w_ada, *b_ada, *w_in, *lam_re, *lam_im, *log_dt, *b_re, *b_im,
      *c_re, *c_im, *s5_d, *w_glu, *b_glu, *theta, *rpb, *w_bs5, *w_bret, *w_bna, *w_out, *w_fg,
      *w_fu, *w_fd, *fnorm;
  float* out;
  unsigned char* ws;
};

__device__ __forceinline__ bf16_t f2bf(float f) {
  unsigned u = __float_as_uint(f);
  u += 0x7fffu + ((u >> 16) & 1u);
  return (bf16_t)(u >> 16);
}
__device__ __forceinline__ float bf2f(bf16_t h) { return __uint_as_float(((unsigned)h) << 16); }
__device__ __forceinline__ float sigm(float x) { return __builtin_amdgcn_rcpf(1.f + __expf(-x)); }
__device__ __forceinline__ float siluf_(float x) { return x * sigm(x); }
typedef __bf16 bf16x2_t __attribute__((ext_vector_type(2)));
typedef float f32x2_t __attribute__((ext_vector_type(2)));
__device__ __forceinline__ unsigned pack2(float a, float b) {
  f32x2_t v = {a, b};
  bf16x2_t r = __builtin_convertvector(v, bf16x2_t);
  return __builtin_bit_cast(unsigned, r);
}
__device__ __forceinline__ bf16x8 pack8(const float (&v)[8]) {
  union { unsigned u[4]; bf16x8 h; } x;
  x.u[0] = pack2(v[0], v[1]);
  x.u[1] = pack2(v[2], v[3]);
  x.u[2] = pack2(v[4], v[5]);
  x.u[3] = pack2(v[6], v[7]);
  return x.h;
}

__device__ __forceinline__ int opaque_tid() {
  int x = threadIdx.x;
  asm volatile("" : "+v"(x));
  return x;
}
#define TIDVARS                                                                          \
  const int tid = opaque_tid(), lane = tid & 63, w = tid >> 6, wm = w >> 1, wn = w & 1; \
  const int l15 = lane & 15, quad = lane >> 4;                                           \
  (void)wm; (void)wn; (void)l15; (void)quad; (void)lane; (void)w;

#define XB_TMO      128
#define XB_XCNT(j)  (256  + 64 * (j))
#define XB_XSUB(j)  (1280 + 64 * (j))
#define XB_XGEN(j)  (2304 + 64 * (j))
#define XB_TOP      3328
#define XB_TOPGEN   3392
#define XCD_BAR_WORDS 3456
#define XB_SPIN_CAP (1u << 22)
#define LAS __attribute__((address_space(3)))

__device__ __forceinline__ unsigned xb_ld(unsigned* p) { return __hip_atomic_load(p, __ATOMIC_RELAXED, __HIP_MEMORY_SCOPE_AGENT); }
__device__ __forceinline__ unsigned xb_add(unsigned* p, unsigned v) { return __hip_atomic_fetch_add(p, v, __ATOMIC_RELAXED, __HIP_MEMORY_SCOPE_AGENT); }
__device__ __forceinline__ unsigned xb_xcc_id() { return (unsigned)__builtin_amdgcn_s_getreg((3 << 11) | 20) & 0xFu; }
#define XB_SPIN(cond, bar) do { unsigned _sp = 0; while (cond) { __builtin_amdgcn_s_sleep(1); \
    if ((++_sp & 255u) == 0u) { if (xb_ld(&(bar)[XB_TMO])) break; if (_sp > XB_SPIN_CAP) { atomicAdd(&(bar)[XB_TMO], 1u); break; } } } } while (0)

struct XcdBarrier {
  unsigned* bar; unsigned x;
  volatile LAS unsigned* st;
};
__device__ __forceinline__ XcdBarrier xcd_barrier_post(unsigned* bar, volatile LAS unsigned* st) {
  XcdBarrier b; b.bar = bar; b.x = xb_xcc_id(); b.st = st;
  if (threadIdx.x == 0) (void)xb_add(&bar[XB_XCNT(b.x)], 1u);
  return b;
}
__device__ __forceinline__ void xcd_barrier_complete(unsigned* bar, unsigned x, unsigned& nloc, unsigned& nx) {
  const unsigned G = gridDim.x * gridDim.y * gridDim.z;
  unsigned sum, cnt_, mine, sp = 0u;
  for (;;) {
    sum = 0u; cnt_ = 0u; mine = 0u;
#pragma unroll
    for (unsigned j = 0; j < 16; ++j) { const unsigned c = xb_ld(&bar[XB_XCNT(j)]); sum += c; cnt_ += (c > 0u) ? 1u : 0u; mine = (j == x) ? c : mine; }
    if (sum == G) break;
    __builtin_amdgcn_s_sleep(1);
    if ((++sp & 255u) == 0u) { if (xb_ld(&bar[XB_TMO])) break; if (sp > XB_SPIN_CAP) { atomicAdd(&bar[XB_TMO], 1u); break; } }
  }
  nloc = mine > 0u ? mine : 1u; nx = cnt_ > 0u ? cnt_ : 1u;
}
__device__ __forceinline__ void xcd_barrier(const XcdBarrier& b) {
  asm volatile("s_waitcnt vmcnt(0)" ::: "memory");
  __syncthreads();
  if (threadIdx.x == 0) {
    unsigned* bar = b.bar;
    __builtin_amdgcn_s_waitcnt(0);
    unsigned nloc = b.st[0], nx = b.st[1];
    if (nloc == 0u) { xcd_barrier_complete(bar, b.x, nloc, nx); b.st[0] = nloc; b.st[1] = nx; }
    const unsigned old = xb_add(&bar[XB_XSUB(b.x)], 1u);
    const unsigned gen = old / nloc;
    if (old + 1u == (gen + 1u) * nloc) {
      __builtin_amdgcn_fence(__ATOMIC_RELEASE, "agent");
      asm volatile("s_waitcnt vmcnt(0)" ::: "memory");
      const unsigned og = xb_add(&bar[XB_TOP], 1u);
      const unsigned tg = og / nx;
      if (og + 1u == (tg + 1u) * nx) xb_add(&bar[XB_TOPGEN], 1u);
      else XB_SPIN(xb_ld(&bar[XB_TOPGEN]) == tg, bar);
      __builtin_amdgcn_fence(__ATOMIC_ACQUIRE, "agent");
      xb_add(&bar[XB_XGEN(b.x)], 1u);
      asm volatile("s_waitcnt vmcnt(0)" ::: "memory");
    } else {
      XB_SPIN(xb_ld(&bar[XB_XGEN(b.x)]) == gen, bar);
      __builtin_amdgcn_fence(__ATOMIC_ACQUIRE, "agent");
      asm volatile("s_waitcnt vmcnt(0)" ::: "memory");
    }
  }
  __syncthreads();
}

constexpr int GEMM_STG = 18432;
template <int NI, bool SWAP>
__device__ __forceinline__ void gemm_core(f32x4 (&acc)[4][NI], const bf16_t* __restrict__ A, int lda,
                                          const bf16_t* __restrict__ Bt, int ldb, int K, bf16_t* sm) {
  constexpr int LS = 72;
  TIDVARS
  const int lrow = tid >> 3, lcc = tid & 7;
  const bf16_t* ap = A + (size_t)lrow * lda + lcc * 8;
  const bf16_t* bp = Bt + (size_t)lrow * ldb + lcc * 8;
  const size_t as = (size_t)32 * lda, bs = (size_t)32 * ldb;
  const int nk = K >> 6;
  uint4 xa0, xa1, xa2, xa3, xb0, xb1, xb2, xb3, ya0, ya1, ya2, ya3, yb0, yb1, yb2, yb3;
#define G_ISSUE(P, kt)                                              \
  {                                                                 \
    const int k_ = (((kt) < nk) ? (kt) : nk - 1) << 6;              \
    P##a0 = *(const uint4*)(ap + k_);                               \
    P##a1 = *(const uint4*)(ap + as + k_);                          \
    P##a2 = *(const uint4*)(ap + 2 * as + k_);                      \
    P##a3 = *(const uint4*)(ap + 3 * as + k_);                      \
    P##b0 = *(const uint4*)(bp + k_);                               \
    P##b1 = *(const uint4*)(bp + bs + k_);                          \
    if (NI > 2) {                                                   \
      P##b2 = *(const uint4*)(bp + 2 * bs + k_);                    \
      P##b3 = *(const uint4*)(bp + 3 * bs + k_);                    \
    }                                                               \
  }
#define G_WRITE(P, stage)                                           \
  {                                                                 \
    bf16_t* d_ = sm + (stage) * GEMM_STG + lrow * LS + lcc * 8;     \
    *(uint4*)(d_) = P##a0;                                          \
    *(uint4*)(d_ + 32 * LS) = P##a1;                                \
    *(uint4*)(d_ + 64 * LS) = P##a2;                                \
    *(uint4*)(d_ + 96 * LS) = P##a3;                                \
    *(uint4*)(d_ + 128 * LS) = P##b0;                               \
    *(uint4*)(d_ + 160 * LS) = P##b1;                               \
    if (NI > 2) {                                                   \
      *(uint4*)(d_ + 192 * LS) = P##b2;                             \
      *(uint4*)(d_ + 224 * LS) = P##b3;                             \
    }                                                               \
  }
#define G_COMPUTE(stage)                                                                           \
  {                                                                                                \
    const bf16_t* sra_ = sm + (stage) * GEMM_STG + (wm * 64 + l15) * LS + quad * 8;                \
    const bf16_t* srb_ = sm + (stage) * GEMM_STG + (128 + wn * 16 * NI + l15) * LS + quad * 8;     \
    __builtin_amdgcn_s_setprio(1);                                                                 \
    _Pragma("unroll") for (int ks = 0; ks < 2; ++ks) {                                             \
      bf16x8 a_[4], b_[NI];                                                                        \
      _Pragma("unroll") for (int mi = 0; mi < 4; ++mi) a_[mi] = *(const bf16x8*)(sra_ + mi * 16 * LS + ks * 32); \
      _Pragma("unroll") for (int ni = 0; ni < NI; ++ni) b_[ni] = *(const bf16x8*)(srb_ + ni * 16 * LS + ks * 32); \
      _Pragma("unroll") for (int mi = 0; mi < 4; ++mi)                                             \
      _Pragma("unroll") for (int ni = 0; ni < NI; ++ni)                                            \
        acc[mi][ni] = SWAP ? MFMA16(b_[ni], a_[mi], acc[mi][ni]) : MFMA16(a_[mi], b_[ni], acc[mi][ni]); \
    }                                                                                              \
    __builtin_amdgcn_s_setprio(0);                                                                 \
  }
  G_ISSUE(x, 0)
  G_ISSUE(y, 1)
  __syncthreads();
  G_WRITE(x, 0)
  G_ISSUE(x, 2)
  __syncthreads();
#pragma unroll 1
  for (int kt = 0; kt < nk; kt += 2) {
    G_WRITE(y, 1)
    G_ISSUE(y, kt + 3)
    G_COMPUTE(0)
    __syncthreads();
    G_WRITE(x, 0)
    G_ISSUE(x, kt + 4)
    G_COMPUTE(1)
    __syncthreads();
  }
#undef G_ISSUE
#undef G_WRITE
#undef G_COMPUTE
}

template <bool SWAP>
__device__ __forceinline__ void gemm_core_big(f32x4 (&acc)[8][4], const bf16_t* __restrict__ A, int lda,
                                              const bf16_t* __restrict__ Bt, int ldb, int K, bf16_t* sm) {
  constexpr int LS = 80;
  TIDVARS
  const int lrow = tid >> 3, lcc = tid & 7;
  const bf16_t* ap = A + (size_t)lrow * lda + lcc * 8;
  const bf16_t* bp = Bt + (size_t)lrow * ldb + lcc * 8;
  const size_t as = (size_t)32 * lda, bs = (size_t)32 * ldb;
  uint4 ra0, ra1, ra2, ra3, ra4, ra5, ra6, ra7, rb0, rb1, rb2, rb3;
#define GB_ISSUE(k_)                              \
  ra0 = *(const uint4*)(ap + (k_));               \
  ra1 = *(const uint4*)(ap + as + (k_));          \
  ra2 = *(const uint4*)(ap + 2 * as + (k_));      \
  ra3 = *(const uint4*)(ap + 3 * as + (k_));      \
  ra4 = *(const uint4*)(ap + 4 * as + (k_));      \
  ra5 = *(const uint4*)(ap + 5 * as + (k_));      \
  ra6 = *(const uint4*)(ap + 6 * as + (k_));      \
  ra7 = *(const uint4*)(ap + 7 * as + (k_));      \
  rb0 = *(const uint4*)(bp + (k_));               \
  rb1 = *(const uint4*)(bp + bs + (k_));          \
  rb2 = *(const uint4*)(bp + 2 * bs + (k_));      \
  rb3 = *(const uint4*)(bp + 3 * bs + (k_));
  GB_ISSUE(0)
  bf16_t* swa = sm + lrow * LS + lcc * 8;
  const bf16_t* sra = sm + (wm * 128 + l15) * LS + quad * 8;
  const bf16_t* srb = sm + (256 + wn * 64 + l15) * LS + quad * 8;
#pragma unroll 1
  for (int k0 = 0; k0 < K; k0 += 64) {
    __syncthreads();
    *(uint4*)(swa) = ra0;
    *(uint4*)(swa + 32 * LS) = ra1;
    *(uint4*)(swa + 64 * LS) = ra2;
    *(uint4*)(swa + 96 * LS) = ra3;
    *(uint4*)(swa + 128 * LS) = ra4;
    *(uint4*)(swa + 160 * LS) = ra5;
    *(uint4*)(swa + 192 * LS) = ra6;
    *(uint4*)(swa + 224 * LS) = ra7;
    *(uint4*)(swa + 256 * LS) = rb0;
    *(uint4*)(swa + 288 * LS) = rb1;
    *(uint4*)(swa + 320 * LS) = rb2;
    *(uint4*)(swa + 352 * LS) = rb3;
    __syncthreads();
    const int kn = (k0 + 64 < K) ? k0 + 64 : k0;
    GB_ISSUE(kn)
    __builtin_amdgcn_s_setprio(1);
#pragma unroll
    for (int ks = 0; ks < 2; ++ks) {
      bf16x8 b_[4];
#pragma unroll
      for (int ni = 0; ni < 4; ++ni) b_[ni] = *(const bf16x8*)(srb + ni * 16 * LS + ks * 32);
#pragma unroll
      for (int mh = 0; mh < 2; ++mh) {
        bf16x8 a_[4];
#pragma unroll
        for (int mi = 0; mi < 4; ++mi) a_[mi] = *(const bf16x8*)(sra + (mh * 4 + mi) * 16 * LS + ks * 32);
#pragma unroll
        for (int mi = 0; mi < 4; ++mi)
#pragma unroll
          for (int ni = 0; ni < 4; ++ni)
            acc[mh * 4 + mi][ni] = SWAP ? MFMA16(b_[ni], a_[mi], acc[mh * 4 + mi][ni]) : MFMA16(a_[mi], b_[ni], acc[mh * 4 + mi][ni]);
      }
    }
    __builtin_amdgcn_s_setprio(0);
  }
#undef GB_ISSUE
}

template <int NI, bool SWAP>
__device__ __forceinline__ void gemm_core_v1(f32x4 (&acc)[4][NI], const bf16_t* __restrict__ A, int lda,
                                             const bf16_t* __restrict__ Bt, int ldb, int K, bf16_t* sm) {
  constexpr int LS = 80;
  TIDVARS
  bf16_t* sA_ = sm;
  bf16_t* sB_ = sm + 128 * LS;
  const int lrow = tid >> 3, lcc = tid & 7;
  const bf16_t* ap = A + (size_t)lrow * lda + lcc * 8;
  const bf16_t* bp = Bt + (size_t)lrow * ldb + lcc * 8;
  const size_t as = (size_t)32 * lda, bs = (size_t)32 * ldb;
  uint4 ra0, ra1, ra2, ra3, rb0, rb1, rb2, rb3;
  ra0 = *(const uint4*)(ap);
  ra1 = *(const uint4*)(ap + as);
  ra2 = *(const uint4*)(ap + 2 * as);
  ra3 = *(const uint4*)(ap + 3 * as);
  rb0 = *(const uint4*)(bp);
  rb1 = *(const uint4*)(bp + bs);
  if (NI > 2) {
    rb2 = *(const uint4*)(bp + 2 * bs);
    rb3 = *(const uint4*)(bp + 3 * bs);
  } else {
    rb2 = rb0;
    rb3 = rb0;
  }
  bf16_t* swa = sA_ + lrow * LS + lcc * 8;
  bf16_t* swb = sB_ + lrow * LS + lcc * 8;
  const bf16_t* sra = sA_ + (wm * 64 + l15) * LS + quad * 8;
  const bf16_t* srb = sB_ + (wn * 16 * NI + l15) * LS + quad * 8;
  for (int k0 = 0; k0 < K; k0 += 64) {
    __syncthreads();
    *(uint4*)(swa) = ra0;
    *(uint4*)(swa + 32 * LS) = ra1;
    *(uint4*)(swa + 64 * LS) = ra2;
    *(uint4*)(swa + 96 * LS) = ra3;
    *(uint4*)(swb) = rb0;
    *(uint4*)(swb + 32 * LS) = rb1;
    if (NI > 2) {
      *(uint4*)(swb + 64 * LS) = rb2;
      *(uint4*)(swb + 96 * LS) = rb3;
    }
    __syncthreads();
    const int kn = (k0 + 64 < K) ? k0 + 64 : k0;
    ra0 = *(const uint4*)(ap + kn);
    ra1 = *(const uint4*)(ap + as + kn);
    ra2 = *(const uint4*)(ap + 2 * as + kn);
    ra3 = *(const uint4*)(ap + 3 * as + kn);
    rb0 = *(const uint4*)(bp + kn);
    rb1 = *(const uint4*)(bp + bs + kn);
    if (NI > 2) {
      rb2 = *(const uint4*)(bp + 2 * bs + kn);
      rb3 = *(const uint4*)(bp + 3 * bs + kn);
    }
    __builtin_amdgcn_s_setprio(1);
#pragma unroll
    for (int ks = 0; ks < 2; ++ks) {
      bf16x8 a[4], b[NI];
#pragma unroll
      for (int mi = 0; mi < 4; ++mi) a[mi] = *(const bf16x8*)(sra + mi * 16 * LS + ks * 32);
#pragma unroll
      for (int ni = 0; ni < NI; ++ni) b[ni] = *(const bf16x8*)(srb + ni * 16 * LS + ks * 32);
#pragma unroll
      for (int mi = 0; mi < 4; ++mi)
#pragma unroll
        for (int ni = 0; ni < NI; ++ni)
          acc[mi][ni] = SWAP ? MFMA16(b[ni], a[mi], acc[mi][ni]) : MFMA16(a[mi], b[ni], acc[mi][ni]);
    }
    __builtin_amdgcn_s_setprio(0);
  }
}

__device__ __forceinline__ void gemm_core_g3(f32x4 (&acc)[3][4][2], const bf16_t* __restrict__ A, int lda,
                                             const bf16_t* __restrict__ Bt, size_t gstride, int ldb, int K, bf16_t* sm) {
  constexpr int LS = 80;
  TIDVARS
  const int lrow = tid >> 3, lcc = tid & 7;
  const bf16_t* ap = A + (size_t)lrow * lda + lcc * 8;
  const bf16_t* bp = Bt + (size_t)lrow * ldb + lcc * 8;
  const size_t as = (size_t)32 * lda, bs = (size_t)32 * ldb;
  uint4 ra0, ra1, ra2, ra3, rb0, rb1, rb2, rb3, rb4, rb5;
#define G3_ISSUE(k_)                                    \
  ra0 = *(const uint4*)(ap + (k_));                     \
  ra1 = *(const uint4*)(ap + as + (k_));                \
  ra2 = *(const uint4*)(ap + 2 * as + (k_));            \
  ra3 = *(const uint4*)(ap + 3 * as + (k_));            \
  rb0 = *(const uint4*)(bp + (k_));                     \
  rb1 = *(const uint4*)(bp + bs + (k_));                \
  rb2 = *(const uint4*)(bp + gstride + (k_));           \
  rb3 = *(const uint4*)(bp + gstride + bs + (k_));      \
  rb4 = *(const uint4*)(bp + 2 * gstride + (k_));       \
  rb5 = *(const uint4*)(bp + 2 * gstride + bs + (k_));
  G3_ISSUE(0)
  bf16_t* swa = sm + lrow * LS + lcc * 8;
  const bf16_t* sra = sm + (wm * 64 + l15) * LS + quad * 8;
  const bf16_t* srb = sm + (128 + wn * 32 + l15) * LS + quad * 8;
#pragma unroll 1
  for (int k0 = 0; k0 < K; k0 += 64) {
    __syncthreads();
    *(uint4*)(swa) = ra0;
    *(uint4*)(swa + 32 * LS) = ra1;
    *(uint4*)(swa + 64 * LS) = ra2;
    *(uint4*)(swa + 96 * LS) = ra3;
    *(uint4*)(swa + 128 * LS) = rb0;
    *(uint4*)(swa + 160 * LS) = rb1;
    *(uint4*)(swa + 192 * LS) = rb2;
    *(uint4*)(swa + 224 * LS) = rb3;
    *(uint4*)(swa + 256 * LS) = rb4;
    *(uint4*)(swa + 288 * LS) = rb5;
    __syncthreads();
    const int kn = (k0 + 64 < K) ? k0 + 64 : k0;
    G3_ISSUE(kn)
    __builtin_amdgcn_s_setprio(1);
#pragma unroll
    for (int ks = 0; ks < 2; ++ks) {
      bf16x8 a_[4];
#pragma unroll
      for (int mi = 0; mi < 4; ++mi) a_[mi] = *(const bf16x8*)(sra + mi * 16 * LS + ks * 32);
#pragma unroll
      for (int g = 0; g < 3; ++g) {
        bf16x8 b_[2];
#pragma unroll
        for (int ni = 0; ni < 2; ++ni) b_[ni] = *(const bf16x8*)(srb + (g * 64 + ni * 16) * LS + ks * 32);
#pragma unroll
        for (int mi = 0; mi < 4; ++mi)
#pragma unroll
          for (int ni = 0; ni < 2; ++ni) acc[g][mi][ni] = MFMA16(b_[ni], a_[mi], acc[g][mi][ni]);
        __builtin_amdgcn_sched_barrier(0);
      }
    }
    __builtin_amdgcn_s_setprio(0);
  }
#undef G3_ISSUE
}

template <int NI>
__device__ __forceinline__ void zero_acc(f32x4 (&acc)[4][NI]) {
#pragma unroll
  for (int mi = 0; mi < 4; ++mi)
#pragma unroll
    for (int ni = 0; ni < NI; ++ni) acc[mi][ni] = f32x4{0.f, 0.f, 0.f, 0.f};
}

__device__ __forceinline__ float wave_sum(float v) {
#pragma unroll
  for (int off = 32; off >= 1; off >>= 1) v += __shfl_xor(v, off);
  return v;
}

__device__ void s5_tables(const Params& p, int idx) {
  bf16_t* bbt = (bf16_t*)(p.ws + OFF_S5BB);
  bf16_t* cm = (bf16_t*)(p.ws + OFF_S5CM);
  float* ab = (float*)(p.ws + OFF_S5AB);
  float* at = (float*)(p.ws + OFF_S5AT);
  const int pp = idx & 63, ldg = idx >> 6;
  const float lr = p.lam_re[idx], li = p.lam_im[idx];
  const float dt = expf(p.log_dt[ldg]);
  const float mag = expf(lr * dt), ang = li * dt;
  const float abr = mag * cosf(ang), abi = mag * sinf(ang);
  const float den = lr * lr + li * li;
  const float fr = ((abr - 1.f) * lr + abi * li) / den;
  const float fi = (abi * lr - (abr - 1.f) * li) / den;
  for (int h = 0; h < 16; ++h) {
    const float br = p.b_re[(size_t)idx * 16 + h], bi = p.b_im[(size_t)idx * 16 + h];
    bbt[(size_t)ldg * 2048 + (2 * pp) * 16 + h] = f2bf(fr * br - fi * bi);
    bbt[(size_t)ldg * 2048 + (2 * pp + 1) * 16 + h] = f2bf(fr * bi + fi * br);
    const size_t ci = ((size_t)ldg * 16 + h) * 64 + pp;
    cm[(size_t)ldg * 2048 + h * 128 + 2 * pp] = f2bf(p.c_re[ci]);
    cm[(size_t)ldg * 2048 + h * 128 + 2 * pp + 1] = f2bf(-p.c_im[ci]);
  }
  ab[idx * 2] = abr;
  ab[idx * 2 + 1] = abi;
  float tr = abr, ti = abi;
  for (int i = 0; i < 7; ++i) {
    const float nr = tr * tr - ti * ti, ni = 2.f * tr * ti;
    tr = nr;
    ti = ni;
  }
  at[idx * 2] = tr;
  at[idx * 2 + 1] = ti;
  bf16_t* vt = (bf16_t*)(p.ws + OFF_S5V) + (size_t)ldg * 16384;
  const int d = (ldg >> 5) & 1;
  float qr = 1.f, qi = 0.f;
  for (int k = 0; k < 128; ++k) {
    const int tp = d ? k : 127 - k;
    vt[pp * 128 + tp] = f2bf(qr);
    vt[(64 + pp) * 128 + tp] = f2bf(qi);
    const float nr = qr * abr - qi * abi, ni = qr * abi + qi * abr;
    qr = nr;
    qi = ni;
  }
}

__device__ void mod_item(const Params& p, int item, float* smem) {
  const int l = item / 96, cgp = item % 96;
  const int tid = opaque_tid();
  float* sc = smem;
  float* red = smem + 9 * 1024;
  __syncthreads();
  for (int i = tid; i < 9 * 1024; i += 256) {
    const int r = i >> 10, k = i & 1023;
    const float v = (r < 8) ? p.c[r * 1024 + k] : p.c_ctx[k];
    sc[i] = siluf_(v);
  }
  __syncthreads();
  const int col = cgp * 64 + (tid & 63), kq = tid >> 6;
  float acc[9];
#pragma unroll
  for (int r = 0; r < 9; ++r) acc[r] = 0.f;
  const float* wp = p.w_ada + (size_t)l * 1024 * 6144 + col;
#pragma unroll 1
  for (int k0 = kq * 256; k0 < kq * 256 + 256; k0 += 16) {
    float wv[16];
#pragma unroll
    for (int u = 0; u < 16; ++u) wv[u] = __builtin_nontemporal_load(wp + (size_t)(k0 + u) * 6144);
#pragma unroll
    for (int u = 0; u < 16; ++u)
#pragma unroll
      for (int r = 0; r < 9; ++r) acc[r] += sc[r * 1024 + k0 + u] * wv[u];
  }
#pragma unroll
  for (int r = 0; r < 9; ++r) red[(kq * 9 + r) * 64 + (tid & 63)] = acc[r];
  __syncthreads();
  float* mod = (float*)(p.ws + OFF_MOD);
  for (int i = tid; i < 9 * 64; i += 256) {
    const int r = i >> 6, cc = i & 63;
    const float s = red[(0 * 9 + r) * 64 + cc] + red[(1 * 9 + r) * 64 + cc] + red[(2 * 9 + r) * 64 + cc] +
                    red[(3 * 9 + r) * 64 + cc];
    mod[(size_t)(l * 9 + r) * 6144 + cgp * 64 + cc] = s + p.b_ada[l * 6144 + cgp * 64 + cc];
  }
}

__device__ __forceinline__ float4 nt_ld4(const float* p_) {
  const f32x4 v = __builtin_nontemporal_load((const f32x4*)p_);
  return float4{v[0], v[1], v[2], v[3]};
}
struct WcDesc { const float* src; int K, N, dst, gu, kt, nt; };
__device__ __forceinline__ WcDesc wc_decode(const Params& p, int l, int it) {
  WcDesc d;
  d.gu = -1;
  if (it < 1664) { d.src = p.w_in + (size_t)l * 1024 * 6656; d.K = 1024; d.N = 6656; d.dst = W_IN; }
  else if (it < 1728) { it -= 1664; d.src = p.w_glu + (size_t)l * 512 * 512; d.K = 512; d.N = 512; d.dst = W_GLU; }
  else if (it < 1856) { it -= 1728; d.src = p.w_bs5 + (size_t)l * 512 * 1024; d.K = 512; d.N = 1024; d.dst = W_BS5; }
  else if (it < 1984) { it -= 1856; d.src = p.w_bret + (size_t)l * 512 * 1024; d.K = 512; d.N = 1024; d.dst = W_BRET; }
  else if (it < 2112) { it -= 1984; d.src = p.w_bna + (size_t)l * 512 * 1024; d.K = 512; d.N = 1024; d.dst = W_BNA; }
  else if (it < 2368) { it -= 2112; d.src = p.w_out + (size_t)l * 1024 * 1024; d.K = 1024; d.N = 1024; d.dst = W_OUT; }
  else if (it < 3072) { it -= 2368; d.src = p.w_fg + (size_t)l * 1024 * 2816; d.K = 1024; d.N = 2816; d.dst = W_FG; d.gu = 0; }
  else if (it < 3776) { it -= 3072; d.src = p.w_fu + (size_t)l * 1024 * 2816; d.K = 1024; d.N = 2816; d.dst = W_FG; d.gu = 1; }
  else { it -= 3776; d.src = p.w_fd + (size_t)l * 2816 * 1024; d.K = 2816; d.N = 1024; d.dst = W_FD; }
  const int ntn = d.N >> 6;
  d.kt = it / ntn;
  d.nt = it % ntn;
  return d;
}
__device__ void wconv_range(const Params& p, int l, int first, int stride, int n, float* tile) {
  const int tid = opaque_tid();
  const int kr0 = tid >> 4, nc = (tid & 15) * 4;
  int it = first;
  if (it >= n) return;
  WcDesc d = wc_decode(p, l, it);
  float4 v0, v1, v2, v3;
#define WC_LOAD(D)                                                                           \
  {                                                                                          \
    const float* s_ = (D).src + (size_t)((D).kt * 64 + kr0) * (D).N + (D).nt * 64 + nc;      \
    v0 = nt_ld4((s_));                                    \
    v1 = nt_ld4((s_ + (size_t)16 * (D).N));               \
    v2 = nt_ld4((s_ + (size_t)32 * (D).N));               \
    v3 = nt_ld4((s_ + (size_t)48 * (D).N));               \
  }
  WC_LOAD(d)
  while (true) {
    __syncthreads();
    {
      float* t0 = tile + kr0 * 65 + nc;
      t0[0] = v0.x; t0[1] = v0.y; t0[2] = v0.z; t0[3] = v0.w;
      t0[16 * 65 + 0] = v1.x; t0[16 * 65 + 1] = v1.y; t0[16 * 65 + 2] = v1.z; t0[16 * 65 + 3] = v1.w;
      t0[32 * 65 + 0] = v2.x; t0[32 * 65 + 1] = v2.y; t0[32 * 65 + 2] = v2.z; t0[32 * 65 + 3] = v2.w;
      t0[48 * 65 + 0] = v3.x; t0[48 * 65 + 1] = v3.y; t0[48 * 65 + 2] = v3.z; t0[48 * 65 + 3] = v3.w;
    }
    __syncthreads();
    const int nx = it + stride;
    WcDesc dn = d;
    if (nx < n) {
      dn = wc_decode(p, l, nx);
      WC_LOAD(dn)
    }
    const int nn = tid >> 2, kq = tid & 3;
    unsigned u[8];
#pragma unroll
    for (int i = 0; i < 8; ++i)
      u[i] = pack2(tile[(kq * 16 + 2 * i) * 65 + nn], tile[(kq * 16 + 2 * i + 1) * 65 + nn]);
    bf16_t* Wd = (bf16_t*)(p.ws + OFF_W) + d.dst;
    int drow = d.nt * 64 + nn;
    if (d.gu >= 0) drow = (drow >> 6) * 128 + ((drow >> 5) & 1) * 64 + d.gu * 32 + (drow & 31);
    uint4* dp = (uint4*)(Wd + (size_t)drow * d.K + d.kt * 64 + kq * 16);
    dp[0] = uint4{u[0], u[1], u[2], u[3]};
    dp[1] = uint4{u[4], u[5], u[6], u[7]};
    if (nx >= n) break;
    it = nx;
    d = dn;
  }
#undef WC_LOAD
}

__device__ void norm_rows(const Params& p, int l, int which, int r, const float* src_ctx, const float* src_x) {
  const int lane = opaque_tid() & 63;
  float4 v[2][4];
  const float* mod[2];
#pragma unroll
  for (int q = 0; q < 2; ++q) {
    const int rr = r + q * 4;
    const float* src = (rr < R_CTX) ? src_ctx + (size_t)rr * 1024 : src_x + (size_t)(rr - R_CTX) * 1024;
    const int modrow = (rr < R_CTX) ? 8 : (rr - R_CTX) >> 11;
    mod[q] = (const float*)(p.ws + OFF_MOD) + (size_t)(l * 9 + modrow) * 6144 + which * 3072;
#pragma unroll
    for (int i = 0; i < 4; ++i)
      v[q][i] = (l == 0 && which == 0) ? nt_ld4(src + i * 256 + lane * 4)
                                       : *(const float4*)(src + i * 256 + lane * 4);
  }
#pragma unroll
  for (int q = 0; q < 2; ++q) {
    const int rr = r + q * 4;
    float ss = 0.f;
#pragma unroll
    for (int i = 0; i < 4; ++i) ss += v[q][i].x * v[q][i].x + v[q][i].y * v[q][i].y + v[q][i].z * v[q][i].z + v[q][i].w * v[q][i].w;
    ss = wave_sum(ss);
    const float rstd = rsqrtf(ss * (1.f / 1024.f) + 1e-6f);
    bf16_t* h = (bf16_t*)(p.ws + OFF_H) + (size_t)rr * 1024;
#pragma unroll
    for (int i = 0; i < 4; ++i) {
      const int c0 = i * 256 + lane * 4;
      const float4 sh = *(const float4*)(mod[q] + c0);
      const float4 sc = *(const float4*)(mod[q] + 1024 + c0);
      uint2 o;
      o.x = pack2(v[q][i].x * rstd * (1.f + sc.x) + sh.x, v[q][i].y * rstd * (1.f + sc.y) + sh.y);
      o.y = pack2(v[q][i].z * rstd * (1.f + sc.z) + sh.z, v[q][i].w * rstd * (1.f + sc.w) + sh.w);
      *(uint2*)(h + c0) = o;
    }
  }
}

__device__ __forceinline__ void resid_big_tile(const Params& p, int l, int mt, int nt, const bf16_t* A, int lda,
                                               const bf16_t* Bt, int ldb, int K, int goff, const float* sx, float* dx,
                                               bf16_t* smem) {
  f32x4 acc[8][4];
#pragma unroll
  for (int mi = 0; mi < 8; ++mi)
#pragma unroll
    for (int ni = 0; ni < 4; ++ni) acc[mi][ni] = f32x4{0.f, 0.f, 0.f, 0.f};
  gemm_core_big<true>(acc, A + (size_t)mt * 256 * lda, lda, Bt + (size_t)nt * 128 * ldb, ldb, K, smem);
  TIDVARS
  const int modrow = (mt - 8) >> 3;
  const float* modp_ = (const float*)(p.ws + OFF_MOD);
  float4 gv[4];
#pragma unroll
  for (int ni = 0; ni < 4; ++ni)
    gv[ni] = *(const float4*)(modp_ + (size_t)(l * 9 + modrow) * 6144 + goff + nt * 128 + wn * 64 + ni * 16 + quad * 4);
#pragma unroll
  for (int mi = 0; mi < 8; ++mi) {
    const int r = mt * 256 + wm * 128 + mi * 16 + l15;
    const size_t o = (size_t)(r - R_CTX) * 1024 + nt * 128 + wn * 64 + quad * 4;
    float4 sv[4];
#pragma unroll
    for (int ni = 0; ni < 4; ++ni) sv[ni] = *(const float4*)(sx + o + ni * 16);
#pragma unroll
    for (int ni = 0; ni < 4; ++ni) {
      float4 ov;
      ov.x = sv[ni].x + gv[ni].x * acc[mi][ni][0];
      ov.y = sv[ni].y + gv[ni].y * acc[mi][ni][1];
      ov.z = sv[ni].z + gv[ni].z * acc[mi][ni][2];
      ov.w = sv[ni].w + gv[ni].w * acc[mi][ni][3];
      *(float4*)(dx + o + ni * 16) = ov;
    }
  }
}

__device__ __forceinline__ void inproj_tile(const Params& p, int mt, int nt, bf16_t* smem) {
  const bf16_t* h = (const bf16_t*)(p.ws + OFF_H);
  const bf16_t* W = (const bf16_t*)(p.ws + OFF_W);
  bf16_t* proj = (bf16_t*)(p.ws + OFF_PROJ);
  bf16_t* vT = (bf16_t*)(p.ws + OFF_VT);
  const float* rot = (const float*)(p.ws + OFF_ROT);
  int colbase = 0, vrow = -1;
  float scale = 1.f;
  bool rotary = false;
  if (nt < 4) colbase = PC_U + nt * 128;
  else if (nt < 6) { colbase = PC_RK + (nt - 4) * 128; scale = 0.125f; rotary = true; }
  else if (nt < 10) vrow = (nt - 6) * 128;
  else if (nt < 14) colbase = PC_NK + (nt - 10) * 128;
  else if (nt < 18) vrow = 512 + (nt - 14) * 128;
  else if (nt < 20) { colbase = PC_RQ + (nt - 18) * 128; rotary = true; }
  else if (nt < 24) colbase = PC_RG + (nt - 20) * 128;
  else { colbase = PC_NQ + (nt - 24) * 128; scale = 0.125f; }
  f32x4 acc[8][4];
#pragma unroll
  for (int mi = 0; mi < 8; ++mi)
#pragma unroll
    for (int ni = 0; ni < 4; ++ni) acc[mi][ni] = f32x4{0.f, 0.f, 0.f, 0.f};
  if (vrow >= 0) {
    gemm_core_big<false>(acc, h + (size_t)mt * 256 * 1024, 1024, W + W_IN + (size_t)nt * 128 * 1024, 1024, 1024, smem);
    TIDVARS
    const int m0 = mt * 256 + wm * 128;
#pragma unroll
    for (int mi = 0; mi < 8; ++mi) {
      const int r0 = m0 + mi * 16 + quad * 4;
#pragma unroll
      for (int ni = 0; ni < 4; ++ni) {
        const int vr = vrow + wn * 64 + ni * 16 + l15;
        uint2 o;
        o.x = pack2(acc[mi][ni][0], acc[mi][ni][1]);
        o.y = pack2(acc[mi][ni][2], acc[mi][ni][3]);
        *(uint2*)(vT + (size_t)vr * R_ALL + r0) = o;
      }
    }
    return;
  }
  gemm_core_big<true>(acc, h + (size_t)mt * 256 * 1024, 1024, W + W_IN + (size_t)nt * 128 * 1024, 1024, 1024, smem);
  TIDVARS
  const int m0 = mt * 256 + wm * 128;
  if (rotary && mt >= 8) {
#pragma unroll
    for (int mi = 0; mi < 8; ++mi) {
      const int r = m0 + mi * 16 + l15;
      const int t = (r - R_CTX) & 2047;
      const int cr = t >> 6, cc = t & 63;
      const float4 c1 = *(const float4*)(rot + cr * 16 + quad * 4), s1 = *(const float4*)(rot + 1024 + cr * 16 + quad * 4);
      const float4 c2 = *(const float4*)(rot + cc * 16 + quad * 4), s2 = *(const float4*)(rot + 1024 + cc * 16 + quad * 4);
      const float cs1[4] = {c1.x, c1.y, c1.z, c1.w}, sn1[4] = {s1.x, s1.y, s1.z, s1.w};
      const float cs2[4] = {c2.x, c2.y, c2.z, c2.w}, sn2[4] = {s2.x, s2.y, s2.z, s2.w};
#pragma unroll
      for (int j = 0; j < 4; ++j) {
        const float a = acc[mi][0][j], bb = acc[mi][1][j];
        acc[mi][0][j] = a * cs1[j] - bb * sn1[j];
        acc[mi][1][j] = a * sn1[j] + bb * cs1[j];
        const float a2 = acc[mi][2][j], b2 = acc[mi][3][j];
        acc[mi][2][j] = a2 * cs2[j] - b2 * sn2[j];
        acc[mi][3][j] = a2 * sn2[j] + b2 * cs2[j];
      }
    }
  }
#pragma unroll
  for (int mi = 0; mi < 8; ++mi) {
    const int r = m0 + mi * 16 + l15;
#pragma unroll
    for (int ni = 0; ni < 4; ++ni) {
      uint2 o;
      o.x = pack2(acc[mi][ni][0] * scale, acc[mi][ni][1] * scale);
      o.y = pack2(acc[mi][ni][2] * scale, acc[mi][ni][3] * scale);
      *(uint2*)(proj + (size_t)r * PJ + colbase + wn * 64 + ni * 16 + quad * 4) = o;
    }
  }
  if (nt < 4) {
    bf16_t* uT = (bf16_t*)(p.ws + OFF_UT);
#pragma unroll
    for (int mi = 0; mi < 8; ++mi) {
      const int r = m0 + mi * 16 + l15;
#pragma unroll
      for (int ni = 0; ni < 4; ++ni)
#pragma unroll
        for (int j = 0; j < 4; ++j)
          uT[(size_t)(nt * 128 + wn * 64 + ni * 16 + quad * 4 + j) * R_ALL + r] = f2bf(acc[mi][ni][j]);
    }
  }
}

__device__ __forceinline__ void ret_item(const Params& p, int l, int b, int h, int qt, bool isctx, bool dry, unsigned char* smem) {
  TIDVARS
  bf16_t* proj = (bf16_t*)(p.ws + OFF_PROJ);
  const bf16_t* vT = (const bf16_t*)(p.ws + OFF_VT);
  const float LOG2E = 1.4426950408889634f;
  const float thf = p.theta[l * 8 + h], thb = p.theta[l * 8 + 4 + h];
  const float lgf = -log1pf(expf(-thf)) * LOG2E;
  const float lgb = -log1pf(expf(-thb)) * LOG2E;
  const int seqbase = isctx ? b * 256 : R_CTX + b * 2048;
  const int q0w = qt * 128 + w * 32;
  bf16x8 bq[2][2];
#pragma unroll
  for (int qb = 0; qb < 2; ++qb)
#pragma unroll
    for (int ks = 0; ks < 2; ++ks)
      bq[qb][ks] = *(const bf16x8*)(proj + (size_t)(seqbase + q0w + qb * 16 + l15) * PJ + PC_RQ + h * 64 + ks * 32 + quad * 8);
  float cfF[8], cfB[8];
#pragma unroll
  for (int j = 0; j < 8; ++j) {
    cfF[j] = exp2f(-lgf * (float)(quad * 8 + j));
    cfB[j] = exp2f(lgb * (float)(quad * 8 + j));
  }
  f32x4 O[2][8];
#pragma unroll
  for (int qb = 0; qb < 2; ++qb)
#pragma unroll
    for (int i = 0; i < 8; ++i) O[qb][i] = f32x4{0.f, 0.f, 0.f, 0.f};
  const int ntiles = isctx ? 4 : 36;
  const int lrow = tid >> 3, lcc = tid & 7;
  const bf16_t* kg = proj + PC_RK + h * 64 + lcc * 8 + (size_t)lrow * PJ;
  const bf16_t* vg = vT + (size_t)(h * 128 + lrow) * R_ALL + lcc * 8;
  constexpr int STG = 15360;
  bf16_t* sm = (bf16_t*)smem;
  const int swo = lrow * 80 + lcc * 8;
  uint4 rk0, rk1, rv0, rv1, rv2, rv3;
  {
    const int krow0 = b * 256;
    rk0 = *(const uint4*)(kg + (size_t)krow0 * PJ);
    rk1 = *(const uint4*)(kg + (size_t)(krow0 + 32) * PJ);
    rv0 = *(const uint4*)(vg + krow0);
    rv1 = *(const uint4*)(vg + (size_t)32 * R_ALL + krow0);
    rv2 = *(const uint4*)(vg + (size_t)64 * R_ALL + krow0);
    rv3 = *(const uint4*)(vg + (size_t)96 * R_ALL + krow0);
    *(uint4*)(sm + swo) = rk0;
    *(uint4*)(sm + swo + 32 * 80) = rk1;
    *(uint4*)(sm + 64 * 80 + swo) = rv0;
    *(uint4*)(sm + 64 * 80 + swo + 32 * 80) = rv1;
    *(uint4*)(sm + 64 * 80 + swo + 64 * 80) = rv2;
    *(uint4*)(sm + 64 * 80 + swo + 96 * 80) = rv3;
  }
  __syncthreads();
#pragma unroll 1
  for (int ti = 0; ti < ntiles; ++ti) {
    {
      const int tn = (ti + 1 < ntiles) ? ti + 1 : ti;
      const int krow0 = (tn < 4) ? b * 256 + tn * 64 : R_CTX + b * 2048 + (tn - 4) * 64;
      rk0 = *(const uint4*)(kg + (size_t)krow0 * PJ);
      rk1 = *(const uint4*)(kg + (size_t)(krow0 + 32) * PJ);
      rv0 = *(const uint4*)(vg + krow0);
      rv1 = *(const uint4*)(vg + (size_t)32 * R_ALL + krow0);
      rv2 = *(const uint4*)(vg + (size_t)64 * R_ALL + krow0);
      rv3 = *(const uint4*)(vg + (size_t)96 * R_ALL + krow0);
    }
    const bf16_t* Ks = sm + (ti & 1) * STG;
    const bf16_t* Vs = Ks + 64 * 80;
    const bool kctx = ti < 4;
#pragma unroll
    for (int g2 = 0; g2 < 2; ++g2) {
      const int kpos0 = (kctx ? ti * 64 : (ti - 4) * 64) + g2 * 32;
      const bf16_t* kr = Ks + (g2 * 32 + (l15 >> 2) * 8 + (l15 & 3)) * 80 + quad * 8;
      const bf16x8 kf0 = *(const bf16x8*)(kr), kf1 = *(const bf16x8*)(kr + 32);
      const bf16x8 kf2 = *(const bf16x8*)(kr + 4 * 80), kf3 = *(const bf16x8*)(kr + 4 * 80 + 32);
      bf16x8 pa[2];
#pragma unroll
      for (int qb = 0; qb < 2; ++qb) {
        f32x4 sx = f32x4{0.f, 0.f, 0.f, 0.f}, sy = f32x4{0.f, 0.f, 0.f, 0.f};
        sx = MFMA16(kf0, bq[qb][0], sx);
        sx = MFMA16(kf1, bq[qb][1], sx);
        sy = MFMA16(kf2, bq[qb][0], sy);
        sy = MFMA16(kf3, bq[qb][1], sy);
        const int qlo = q0w + qb * 16;
        const int qpos = qlo + l15;
        float pv[8];
        if (isctx || !kctx) {
          if (kpos0 + 31 <= qlo) {
            const float rf = exp2f(lgf * (float)(qpos - kpos0));
#pragma unroll
            for (int j = 0; j < 8; ++j) pv[j] = ((j < 4) ? sx[j & 3] : sy[j & 3]) * (rf * cfF[j]);
          } else if (kpos0 > qlo + 15) {
            const float rb = exp2f(lgb * (float)(kpos0 - qpos));
#pragma unroll
            for (int j = 0; j < 8; ++j) pv[j] = ((j < 4) ? sx[j & 3] : sy[j & 3]) * (rb * cfB[j]);
          } else {
#pragma unroll
            for (int j = 0; j < 8; ++j) {
              const int d = qpos - (kpos0 + quad * 8 + j);
              const float wgt = (d >= 0) ? exp2f(lgf * (float)d) : exp2f(lgb * (float)(-d));
              pv[j] = ((j < 4) ? sx[j & 3] : sy[j & 3]) * wgt;
            }
          }
        } else {
          const float rf = exp2f(lgf * (float)(qpos + 256 - kpos0));
          const float rb = exp2f(lgb * (float)(2048 - qpos + kpos0));
#pragma unroll
          for (int j = 0; j < 8; ++j) pv[j] = ((j < 4) ? sx[j & 3] : sy[j & 3]) * (rf * cfF[j] + rb * cfB[j]);
        }
        pa[qb] = pack8(pv);
      }
#pragma unroll
      for (int db = 0; db < 8; ++db) {
        const bf16x8 vf = *(const bf16x8*)(Vs + (db * 16 + l15) * 80 + g2 * 32 + quad * 8);
        O[0][db] = MFMA16(vf, pa[0], O[0][db]);
        O[1][db] = MFMA16(vf, pa[1], O[1][db]);
      }
    }
    if (ti + 1 < ntiles) {
      bf16_t* d = sm + ((ti + 1) & 1) * STG;
      *(uint4*)(d + swo) = rk0;
      *(uint4*)(d + swo + 32 * 80) = rk1;
      *(uint4*)(d + 64 * 80 + swo) = rv0;
      *(uint4*)(d + 64 * 80 + swo + 32 * 80) = rv1;
      *(uint4*)(d + 64 * 80 + swo + 64 * 80) = rv2;
      *(uint4*)(d + 64 * 80 + swo + 96 * 80) = rv3;
    }
    __syncthreads();
  }
  bf16_t* obase = dry ? (bf16_t*)(p.ws + WS_END) : proj;
  const size_t omask = dry ? (size_t)0x7FFFFF : ~(size_t)0;
#pragma unroll
  for (int qb = 0; qb < 2; ++qb) {
    float s = 0.f;
#pragma unroll
    for (int db = 0; db < 8; ++db) s += (O[qb][db][0] + O[qb][db][1]) + (O[qb][db][2] + O[qb][db][3]);
    s += __shfl_xor(s, 16);
    s += __shfl_xor(s, 32);
    const float mu = s * (1.f / 128.f);
    float v = 0.f;
#pragma unroll
    for (int db = 0; db < 8; ++db)
#pragma unroll
      for (int j = 0; j < 4; ++j) { const float d = O[qb][db][j] - mu; v += d * d; }
    v += __shfl_xor(v, 16);
    v += __shfl_xor(v, 32);
    const float rs = rsqrtf(v * (1.f / 128.f) + 1e-5f);
    const int orow = seqbase + q0w + qb * 16 + l15;
    uint2 gg[8];
#pragma unroll
    for (int db = 0; db < 8; ++db) gg[db] = *(const uint2*)(proj + (size_t)orow * PJ + PC_RG + h * 128 + db * 16 + quad * 4);
#pragma unroll
    for (int db = 0; db < 8; ++db) {
      const float g0 = __uint_as_float(gg[db].x << 16), g1 = __uint_as_float(gg[db].x & 0xffff0000u);
      const float g2 = __uint_as_float(gg[db].y << 16), g3 = __uint_as_float(gg[db].y & 0xffff0000u);
      uint2 o;
      o.x = pack2(siluf_(g0) * (O[qb][db][0] - mu) * rs, siluf_(g1) * (O[qb][db][1] - mu) * rs);
      o.y = pack2(siluf_(g2) * (O[qb][db][2] - mu) * rs, siluf_(g3) * (O[qb][db][3] - mu) * rs);
      *(uint2*)(obase + (((size_t)orow * PJ + PC_RG + h * 128 + db * 16 + quad * 4) & omask)) = o;
    }
  }
}

__device__ __forceinline__ void na_item(const Params& p, int l, int b, int h, int qidx, bool isctx, bool dry, unsigned char* smem) {
  TIDVARS
  bf16_t* proj = (bf16_t*)(p.ws + OFF_PROJ);
  const bf16_t* vT = (const bf16_t*)(p.ws + OFF_VT);
  const int qrow0 = isctx ? b * 256 + qidx * 64 : R_CTX + b * 2048 + qidx * 64;
  float* rpbs = (float*)smem;
  float* part = (float*)(smem + 2048);
  {
    const float* rp = p.rpb + (size_t)(l * 8 + h) * 465;
    for (int i = tid; i < 465; i += 256) rpbs[i] = rp[i];
  }
  bf16x8 bq[4][2];
#pragma unroll
  for (int qb = 0; qb < 4; ++qb)
#pragma unroll
    for (int ks = 0; ks < 2; ++ks)
      bq[qb][ks] = *(const bf16x8*)(proj + (size_t)(qrow0 + qb * 16 + l15) * PJ + PC_NQ + h * 64 + ks * 32 + quad * 8);
  const int r = qidx;
  const int rs = min(max(r - 4, 0), 24);
  const int winbase = R_CTX + b * 2048 + rs * 64;
  float m_run[4], l_run[4];
  f32x4 O[4][4];
#pragma unroll
  for (int qb = 0; qb < 4; ++qb) {
    m_run[qb] = -1e30f;
    l_run[qb] = 0.f;
#pragma unroll
    for (int i = 0; i < 4; ++i) O[qb][i] = f32x4{0.f, 0.f, 0.f, 0.f};
  }
  const int ngr = isctx ? 2 : 6;
  const bf16_t* kbase = proj + PC_NK + h * 64 + quad * 8 + (size_t)((l15 >> 2) * 8 + (l15 & 3)) * PJ;
  const bf16_t* vbase = vT + (size_t)(512 + h * 64 + l15) * R_ALL + quad * 8;
  bf16x8 kf0, kf1, kf2, kf3, vf0, vf1, vf2, vf3;
  {
    const int krow0 = b * 256 + w * 64;
    const bf16_t* kp = kbase + (size_t)krow0 * PJ;
    kf0 = *(const bf16x8*)(kp);
    kf1 = *(const bf16x8*)(kp + 32);
    kf2 = *(const bf16x8*)(kp + 4 * PJ);
    kf3 = *(const bf16x8*)(kp + 4 * PJ + 32);
    vf0 = *(const bf16x8*)(vbase + krow0);
    vf1 = *(const bf16x8*)(vbase + (size_t)16 * R_ALL + krow0);
    vf2 = *(const bf16x8*)(vbase + (size_t)32 * R_ALL + krow0);
    vf3 = *(const bf16x8*)(vbase + (size_t)48 * R_ALL + krow0);
  }
  __syncthreads();
#pragma unroll 1
  for (int g = 0; g < ngr; ++g) {
    bf16x8 nk0, nk1, nk2, nk3, nv0, nv1, nv2, nv3;
    {
      const int gn = (g + 1 < ngr) ? g + 1 : g;
      const int tn = w + 4 * (gn >> 1);
      const int krow0 = ((tn < 4) ? b * 256 + tn * 64 : winbase + (tn - 4) * 64) + (gn & 1) * 32;
      const bf16_t* kp = kbase + (size_t)krow0 * PJ;
      nk0 = *(const bf16x8*)(kp);
      nk1 = *(const bf16x8*)(kp + 32);
      nk2 = *(const bf16x8*)(kp + 4 * PJ);
      nk3 = *(const bf16x8*)(kp + 4 * PJ + 32);
      nv0 = *(const bf16x8*)(vbase + krow0);
      nv1 = *(const bf16x8*)(vbase + (size_t)16 * R_ALL + krow0);
      nv2 = *(const bf16x8*)(vbase + (size_t)32 * R_ALL + krow0);
      nv3 = *(const bf16x8*)(vbase + (size_t)48 * R_ALL + krow0);
    }
    const int t = w + 4 * (g >> 1);
    const int hb = g & 1;
    const bool win = t >= 4;
    const int a = t - 4;
#pragma unroll
    for (int qb = 0; qb < 4; ++qb) {
      if (win && ((qb == 0 && hb == 1) || (qb == 3 && hb == 0))) continue;
      f32x4 sx = f32x4{0.f, 0.f, 0.f, 0.f}, sy = f32x4{0.f, 0.f, 0.f, 0.f};
      sx = MFMA16(kf0, bq[qb][0], sx);
      sx = MFMA16(kf1, bq[qb][1], sx);
      sy = MFMA16(kf2, bq[qb][0], sy);
      sy = MFMA16(kf3, bq[qb][1], sy);
      float s[8];
#pragma unroll
      for (int j = 0; j < 8; ++j) s[j] = (j < 4) ? sx[j & 3] : sy[j & 3];
      if (win) {
        const int c = qb * 16 + l15;
        const int cs = min(max(c - 8, 0), 48);
#pragma unroll
        for (int j = 0; j < 8; ++j) {
          const int kc = hb * 32 + quad * 8 + j;
          const bool valid = (kc >= cs) && (kc < cs + 16);
          const int bi = min(max((rs + a - r + 7) * 31 + (kc - c + 15), 0), 464);
          const float sb = s[j] + rpbs[bi];
          s[j] = valid ? sb : -1e30f;
        }
      }
      float gmax = s[0];
#pragma unroll
      for (int j = 1; j < 8; ++j) gmax = fmaxf(gmax, s[j]);
      gmax = fmaxf(gmax, __shfl_xor(gmax, 16));
      gmax = fmaxf(gmax, __shfl_xor(gmax, 32));
      float m_ref = m_run[qb];
      const float m_new = fmaxf(m_ref, gmax);
      const bool grew = m_new > m_ref + 4.f;
      if (__any(grew)) {
        const float alpha = __expf(m_ref - m_new);
        l_run[qb] *= alpha;
#pragma unroll
        for (int db = 0; db < 4; ++db)
#pragma unroll
          for (int j = 0; j < 4; ++j) O[qb][db][j] *= alpha;
        m_ref = m_new;
      }
      float ps = 0.f;
      float pv[8];
#pragma unroll
      for (int j = 0; j < 8; ++j) {
        pv[j] = __expf(s[j] - m_ref);
        ps += pv[j];
      }
      const bf16x8 pa = pack8(pv);
      m_run[qb] = m_ref;
      l_run[qb] += ps;
      O[qb][0] = MFMA16(vf0, pa, O[qb][0]);
      O[qb][1] = MFMA16(vf1, pa, O[qb][1]);
      O[qb][2] = MFMA16(vf2, pa, O[qb][2]);
      O[qb][3] = MFMA16(vf3, pa, O[qb][3]);
    }
    kf0 = nk0; kf1 = nk1; kf2 = nk2; kf3 = nk3;
    vf0 = nv0; vf1 = nv1; vf2 = nv2; vf3 = nv3;
  }
#pragma unroll
  for (int qb = 0; qb < 4; ++qb) {
    float lt = l_run[qb];
    lt += __shfl_xor(lt, 16);
    lt += __shfl_xor(lt, 32);
    l_run[qb] = lt;
    if (qb != w) {
      float* ps_ = part + (w * 3 + (qb > w ? qb - 1 : qb)) * 1152;
#pragma unroll
      for (int db = 0; db < 4; ++db)
#pragma unroll
        for (int j = 0; j < 4; ++j) ps_[(db * 4 + j) * 64 + lane] = O[qb][db][j];
      ps_[1024 + lane] = m_run[qb];
      ps_[1088 + lane] = lt;
    }
  }
  __syncthreads();
  float m_own = 0.f, l_own = 0.f;
  f32x4 Oo[4];
#pragma unroll
  for (int qb = 0; qb < 4; ++qb)
    if (qb == w) {
      m_own = m_run[qb];
      l_own = l_run[qb];
#pragma unroll
      for (int db = 0; db < 4; ++db) Oo[db] = O[qb][db];
    }
  float m_tot = m_own;
#pragma unroll
  for (int v = 0; v < 4; ++v) {
    if (v == w) continue;
    const float* ps_ = part + (v * 3 + (w > v ? w - 1 : w)) * 1152;
    m_tot = fmaxf(m_tot, ps_[1024 + lane]);
  }
  {
    const float f = __expf(m_own - m_tot);
    l_own *= f;
#pragma unroll
    for (int db = 0; db < 4; ++db)
#pragma unroll
      for (int j = 0; j < 4; ++j) Oo[db][j] *= f;
  }
#pragma unroll
  for (int v = 0; v < 4; ++v) {
    if (v == w) continue;
    const float* ps_ = part + (v * 3 + (w > v ? w - 1 : w)) * 1152;
    const float f = __expf(ps_[1024 + lane] - m_tot);
    l_own += ps_[1088 + lane] * f;
#pragma unroll
    for (int db = 0; db < 4; ++db)
#pragma unroll
      for (int j = 0; j < 4; ++j) Oo[db][j] += ps_[(db * 4 + j) * 64 + lane] * f;
  }
  bf16_t* obase = dry ? (bf16_t*)(p.ws + WS_END) : proj;
  const size_t omask = dry ? (size_t)0x7FFFFF : ~(size_t)0;
  const float linv = 1.f / l_own;
  const int orow = qrow0 + w * 16 + l15;
#pragma unroll
  for (int db = 0; db < 4; ++db) {
    uint2 o;
    o.x = pack2(Oo[db][0] * linv, Oo[db][1] * linv);
    o.y = pack2(Oo[db][2] * linv, Oo[db][3] * linv);
    *(uint2*)(obase + (((size_t)orow * PJ + PC_NQ + h * 64 + db * 16 + quad * 4) & omask)) = o;
  }
}

struct S5Frag {
  bf16x8 bf[8];
  bf16x8 cf[4];
  float ar, ai;
};

__device__ __forceinline__ void s5_load_frag(const Params& p, S5Frag& f, int ldg, bool need_c) {
  const int lane = opaque_tid() & 63, l15 = lane & 15, quad = lane >> 4;
  const bf16_t* bbt = (const bf16_t*)(p.ws + OFF_S5BB) + (size_t)ldg * 2048;
  const bf16_t* cm = (const bf16_t*)(p.ws + OFF_S5CM) + (size_t)ldg * 2048;
  const float* ab = (const float*)(p.ws + OFF_S5AB) + (size_t)ldg * 128;
  const bf16x8 z = {0, 0, 0, 0, 0, 0, 0, 0};
#pragma unroll
  for (int pb = 0; pb < 8; ++pb)
    f.bf[pb] = (quad < 2) ? *(const bf16x8*)(bbt + (pb * 16 + l15) * 16 + quad * 8) : z;
  if (need_c) {
#pragma unroll
    for (int ks = 0; ks < 4; ++ks) f.cf[ks] = *(const bf16x8*)(cm + l15 * 128 + ks * 32 + quad * 8);
  }
  f.ar = ab[lane * 2];
  f.ai = ab[lane * 2 + 1];
}

template <int DIR>
__device__ __forceinline__ int s5_row(int b, int s0, int l15) {
  const int s = s0 + l15;
  if (s0 < 256) {
    const int j = DIR ? 255 - s : s;
    return b * 256 + j;
  }
  const int t = s - 256;
  const int tt = DIR ? 2047 - t : t;
  return R_CTX + b * 2048 + tt;
}

template <int DIR, bool WRITE>
__device__ __forceinline__ void s5_chunk(const bf16_t* __restrict__ proj, int b, int g, int cseq,
                                         const S5Frag& f, float& xr, float& xi, float* BUs, bf16_t* Xs,
                                         f32x4 (&yacc)[8]) {
  const int lane = opaque_tid() & 63, l15 = lane & 15, quad = lane >> 4;
  const bf16x8 z = {0, 0, 0, 0, 0, 0, 0, 0};
  const bf16_t* ub = proj + PC_U + g * 16 + (quad & 1) * 8;
  bf16x8 ucur = *(const bf16x8*)(ub + (size_t)s5_row<DIR>(b, cseq * 128, l15) * PJ);
#pragma unroll 1
  for (int sbs = 0; sbs < 8; ++sbs) {
    const int sn = cseq * 128 + ((sbs < 7) ? sbs + 1 : sbs) * 16;
    const bf16x8 unext = *(const bf16x8*)(ub + (size_t)s5_row<DIR>(b, sn, l15) * PJ);
    const bf16x8 uf = (quad < 2) ? ucur : z;
    __builtin_amdgcn_wave_barrier();
#pragma unroll
    for (int pb = 0; pb < 8; ++pb) {
      f32x4 bu = f32x4{0.f, 0.f, 0.f, 0.f};
      bu = MFMA16(uf, f.bf[pb], bu);
#pragma unroll
      for (int j = 0; j < 4; ++j) BUs[(quad * 4 + j) * 132 + pb * 16 + l15] = bu[j];
    }
    __builtin_amdgcn_wave_barrier();
    float2 bbv[16];
#pragma unroll
    for (int t = 0; t < 16; ++t) bbv[t] = *(const float2*)(BUs + t * 132 + 2 * lane);
#pragma unroll
    for (int t = 0; t < 16; ++t) {
      const float2 bb = bbv[t];
      const float nr = f.ar * xr - f.ai * xi + bb.x;
      const float ni = f.ar * xi + f.ai * xr + bb.y;
      xr = nr;
      xi = ni;
      if (WRITE) {
        const int rt = DIR ? 15 - t : t;
        *(unsigned*)(Xs + rt * 144 + 2 * lane) = pack2(xr, xi);
      }
    }
    if (WRITE) {
      __builtin_amdgcn_wave_barrier();
      const int tsb = DIR ? 7 - sbs : sbs;
      f32x4 yt = f32x4{0.f, 0.f, 0.f, 0.f};
#pragma unroll
      for (int ks = 0; ks < 4; ++ks) {
        const bf16x8 xa = *(const bf16x8*)(Xs + l15 * 144 + ks * 32 + quad * 8);
        yt = MFMA16(xa, f.cf[ks], yt);
      }
#pragma unroll
      for (int i = 0; i < 8; ++i)
        if (i == tsb) yacc[i] += yt;
    }
    ucur = unext;
  }
}

__device__ __forceinline__ void s5_item(const Params& p, int l, int b, int g, bool last, unsigned char* smem) {
  TIDVARS
  float* bound = (float*)smem;
  float* BUs = (float*)(smem + 18432 + w * 13056);
  bf16_t* Xs = (bf16_t*)(smem + 18432 + w * 13056 + 8448);
  const bf16_t* proj = (const bf16_t*)(p.ws + OFF_PROJ);
  bf16_t* G = (bf16_t*)(p.ws + OFF_G);
  f32x4 yacc[8];
  {
    const bf16_t* uT = (const bf16_t*)(p.ws + OFF_UT);
    bf16_t* tabs = (bf16_t*)(smem + 18432);
#pragma unroll 1
    for (int dir = 0; dir < 2; ++dir) {
      const int ldg = (l * 2 + dir) * 32 + g;
      __syncthreads();
      {
        const bf16_t* vt = (const bf16_t*)(p.ws + OFF_S5V) + (size_t)ldg * 16384;
#pragma unroll
        for (int i = 0; i < 8; ++i) {
          const int id = tid + i * 256, row = id >> 4, cc = id & 15;
          *(uint4*)(tabs + row * 144 + cc * 8) = *(const uint4*)(vt + row * 128 + cc * 8);
        }
      }
      float bre[4][4], bim[4][4];
      {
        const bf16_t* bbt = (const bf16_t*)(p.ws + OFF_S5BB) + (size_t)ldg * 2048;
#pragma unroll
        for (int nb = 0; nb < 4; ++nb) {
          const int ps = nb * 16 + l15;
          const uint2 r2 = *(const uint2*)(bbt + (2 * ps) * 16 + quad * 4);
          const uint2 i2 = *(const uint2*)(bbt + (2 * ps + 1) * 16 + quad * 4);
          bre[nb][0] = __uint_as_float(r2.x << 16); bre[nb][1] = __uint_as_float(r2.x & 0xffff0000u);
          bre[nb][2] = __uint_as_float(r2.y << 16); bre[nb][3] = __uint_as_float(r2.y & 0xffff0000u);
          bim[nb][0] = __uint_as_float(i2.x << 16); bim[nb][1] = __uint_as_float(i2.x & 0xffff0000u);
          bim[nb][2] = __uint_as_float(i2.y << 16); bim[nb][3] = __uint_as_float(i2.y & 0xffff0000u);
        }
      }
      __syncthreads();
#pragma unroll 1
      for (int c = w; c < 17; c += 4) {
        int rowbase;
        if (dir == 0) rowbase = (c < 2) ? b * 256 + 128 * c : R_CTX + b * 2048 + (c - 2) * 128;
        else rowbase = (c < 2) ? b * 256 + 128 * (1 - c) : R_CTX + b * 2048 + 128 * (17 - c);
        bf16x8 ua[4];
#pragma unroll
        for (int ks = 0; ks < 4; ++ks)
          ua[ks] = *(const bf16x8*)(uT + (size_t)(g * 16 + l15) * R_ALL + rowbase + ks * 32 + quad * 8);
        f32x4 z[8];
#pragma unroll
        for (int nb = 0; nb < 8; ++nb) {
          z[nb] = f32x4{0.f, 0.f, 0.f, 0.f};
#pragma unroll
          for (int ks = 0; ks < 4; ++ks) {
            const bf16x8 wf = *(const bf16x8*)(tabs + (nb * 16 + l15) * 144 + ks * 32 + quad * 8);
            z[nb] = MFMA16(ua[ks], wf, z[nb]);
          }
        }
#pragma unroll
        for (int nb = 0; nb < 4; ++nb) {
          float er = 0.f, ei = 0.f;
#pragma unroll
          for (int j = 0; j < 4; ++j) {
            er += bre[nb][j] * z[nb][j] - bim[nb][j] * z[nb + 4][j];
            ei += bre[nb][j] * z[nb + 4][j] + bim[nb][j] * z[nb][j];
          }
          er += __shfl_xor(er, 16);
          er += __shfl_xor(er, 32);
          ei += __shfl_xor(ei, 16);
          ei += __shfl_xor(ei, 32);
          if (quad == 0) {
            bound[(dir * 18 + c + 1) * 128 + nb * 16 + l15] = er;
            bound[(dir * 18 + c + 1) * 128 + 64 + nb * 16 + l15] = ei;
          }
        }
      }
    }
  }
  __syncthreads();
  if (tid < 128) {
    const int d = tid >> 6, pp = tid & 63;
    const float* at = (const float*)(p.ws + OFF_S5AT) + (size_t)((l * 2 + d) * 32 + g) * 128;
    const float tr = at[pp * 2], ti = at[pp * 2 + 1];
    float xr = 0.f, xi = 0.f;
    bound[(d * 18) * 128 + pp] = 0.f;
    bound[(d * 18) * 128 + 64 + pp] = 0.f;
    for (int c = 1; c < 18; ++c) {
      const float er = bound[(d * 18 + c) * 128 + pp], ei = bound[(d * 18 + c) * 128 + 64 + pp];
      const float nr = tr * xr - ti * xi + er;
      const float ni = tr * xi + ti * xr + ei;
      xr = nr;
      xi = ni;
      bound[(d * 18 + c) * 128 + pp] = xr;
      bound[(d * 18 + c) * 128 + 64 + pp] = xi;
    }
  }
  __syncthreads();
  const float dsk = p.s5_d[l * 512 + g * 16 + l15];
  for (int tc = (last ? 2 : 0) + w; tc < 18; tc += 4) {
#pragma unroll
    for (int i = 0; i < 8; ++i) yacc[i] = f32x4{0.f, 0.f, 0.f, 0.f};
    {
      S5Frag f;
      s5_load_frag(p, f, (l * 2 + 0) * 32 + g, true);
      const int cseq = tc;
      float xr = bound[(0 * 18 + cseq) * 128 + lane], xi = bound[(0 * 18 + cseq) * 128 + 64 + lane];
      s5_chunk<0, true>(proj, b, g, cseq, f, xr, xi, BUs, Xs, yacc);
    }
    {
      S5Frag f;
      s5_load_frag(p, f, (l * 2 + 1) * 32 + g, true);
      const int cseq = (tc < 2) ? 1 - tc : 19 - tc;
      float xr = bound[(1 * 18 + cseq) * 128 + lane], xi = bound[(1 * 18 + cseq) * 128 + 64 + lane];
      s5_chunk<1, true>(proj, b, g, cseq, f, xr, xi, BUs, Xs, yacc);
    }
    const int rowbase = (tc < 2) ? b * 256 + tc * 128 : R_CTX + b * 2048 + (tc - 2) * 128;
#pragma unroll
    for (int tsb = 0; tsb < 8; ++tsb)
#pragma unroll
      for (int j = 0; j < 4; ++j) {
        const int row = rowbase + tsb * 16 + quad * 4 + j;
        const float uu = bf2f(proj[(size_t)row * PJ + PC_U + g * 16 + l15]);
        const float y = yacc[tsb][j] + dsk * uu;
        const float zz = 0.7978845608028654f * (y + 0.044715f * y * y * y);
        const float gl = y / (1.f + __expf(-2.f * zz));
        G[(size_t)row * 512 + g * 16 + l15] = f2bf(gl);
      }
  }
}

#define EPI_LOOP(NI_)                                                        \
  _Pragma("unroll") for (int mi = 0; mi < 4; ++mi)                           \
  _Pragma("unroll") for (int ni = 0; ni < NI_; ++ni)                         \
  _Pragma("unroll") for (int j = 0; j < 4; ++j)

__global__ void __launch_bounds__(256, 2) fwd_megakernel(Params p) {
  cg::grid_group grid = cg::this_grid();
  __shared__ __attribute__((aligned(16))) unsigned char smem[SMEM_BYTES];
  __shared__ int s_item;
  __shared__ uint4 xb_words;
  if (threadIdx.x == 0) xb_words = make_uint4(0u, 0u, 0u, 0u);
  __syncthreads();
  const XcdBarrier xb = xcd_barrier_post((unsigned*)(p.ws + OFF_BAR), (volatile LAS unsigned*)&xb_words);
  const int nblk = gridDim.x, bid = blockIdx.x;
  const int lbid = bid;
#define sA ((bf16_t*)smem)
#define sB (((bf16_t*)smem) + 128 * 72)
#define W ((const bf16_t*)(p.ws + OFF_W))
#define hbuf ((bf16_t*)(p.ws + OFF_H))
#define Gbuf ((bf16_t*)(p.ws + OFF_G))
#define proj ((bf16_t*)(p.ws + OFF_PROJ))
#define mbuf ((bf16_t*)(p.ws + OFF_VT))
#define hid ((bf16_t*)(p.ws + OFF_PROJ))
#define ctxs ((float*)(p.ws + OFF_CTXS))
#define modp ((const float*)(p.ws + OFF_MOD))
#define cnt ((int*)(p.ws + OFF_CNT))

#pragma unroll 1
  for (int rep = 0, nrep = REPS61; rep < nrep; ++rep) {
    TIDVARS
    for (int i = (tid < 2 ? bid * 2 + tid : 1024); i < 1024; i += nblk * 2) {
      const int coord = i >> 4, fi = i & 15;
      const float inv = powf(10000.f, -(float)fi / 16.f);
      const float ang = (float)coord * inv;
      float* rot = (float*)(p.ws + OFF_ROT);
      rot[i] = cosf(ang);
      rot[1024 + i] = sinf(ang);
    }
    for (int i = (tid < 16 ? bid * 16 + tid : 8192); i < 8192; i += nblk * 16) s5_tables(p, i);
    for (int it = bid; it < 192; it += nblk) mod_item(p, it, (float*)smem);
    wconv_range(p, 0, (bid + 320) % nblk, nblk, 4480, (float*)smem);
    if (p.fnorm == nullptr) grid.sync();
    xcd_barrier(xb);
  }

  for (int l = 0; l < 2; ++l) {
    const bool last = (l == 1);
    const float* src_ctx = (l == 0) ? p.ctx : ctxs;
    const float* src_x = (l == 0) ? p.x : p.out;
    const int mt_min = last ? 16 : 0;

#pragma unroll 1
    for (int rep = 0, nrep = REPS62; rep < nrep; ++rep) {
      TIDVARS
      const int nnorm = R_ALL / 8;
      for (int it = bid; it < nnorm; it += nblk) norm_rows(p, l, 0, it * 8 + w, src_ctx, src_x);
      if (last) wconv_range(p, 1, bid, nblk, 4480, (float*)smem);
      xcd_barrier(xb);
    }

#pragma unroll 1
    for (int rep = 0, nrep = REPS(1); rep < nrep; ++rep) {
      for (int tile = lbid; tile < 72 * 28; tile += nblk) {
        const int mt = tile / 28, nt = tile % 28;
        if (last && mt < 8 && nt >= 18) continue;
        inproj_tile(p, mt, nt, (bf16_t*)smem);
      }
      xcd_barrier(xb);
    }

#pragma unroll 1
    for (int rep = 0, nrep = (PROBE >= 21 && PROBE <= 23) ? (1 + (int)(p.fnorm != nullptr)) : REPS(2); rep < nrep; ++rep) {
      TIDVARS
      const bool dry = rep > 0;
      const int n_s5 = 256;
      const int n_ret = 512 + (last ? 0 : 64);
      const int n_na = 2048 + (last ? 0 : 256);
      const int total = n_s5 + n_ret + n_na;
      while (true) {
        __syncthreads();
        if (tid == 0) s_item = atomicAdd(&cnt[l + 2 * rep], 1);
        __syncthreads();
        int it = s_item;
#if PROBE == 21
        if (rep > 0 && it >= n_s5) break;
#elif PROBE == 22
        if (rep > 0) { it += n_s5; if (it >= n_s5 + n_ret) break; }
#elif PROBE == 23
        if (rep > 0) it += n_s5 + n_ret;
#endif
        if (it >= total) break;
        if (it < n_s5) {
          __builtin_amdgcn_s_setprio(3);
          s5_item(p, l, it >> 5, it & 31, last, smem);
          __builtin_amdgcn_s_setprio(0);
        } else if (it < n_s5 + n_ret) {
          it -= n_s5;
          const bool ic = it >= 512;
          const int i2 = it - 512;
          ret_item(p, l, ic ? (i2 >> 3) : (it >> 6), ic ? ((i2 >> 1) & 3) : ((it >> 4) & 3), ic ? (i2 & 1) : (it & 15), ic, dry, smem);
        } else {
          it -= n_s5 + n_ret;
          const bool ic = it >= 2048;
          const int i2 = it - 2048;
          na_item(p, l, ic ? (i2 >> 5) : (it >> 8), ic ? ((i2 >> 2) & 7) : ((it >> 5) & 7), ic ? (i2 & 3) : (it & 31), ic, dry, smem);
        }
      }
      xcd_barrier(xb);
    }

#pragma unroll 1
    for (int rep = 0, nrep = REPS(5); rep < nrep; ++rep) {
      for (int tile = lbid + mt_min * 4; tile < 144 * 4; tile += nblk) {
        const int mt = tile >> 2, nt = tile & 3;
        f32x4 acc[4][4];
        zero_acc<4>(acc);
        gemm_core_v1<4, true>(acc, Gbuf + (size_t)mt * 128 * 512, 512, W + W_GLU + (size_t)nt * 128 * 512, 512, 512, (bf16_t*)smem);
        TIDVARS
        float4 bgl[4];
#pragma unroll
        for (int ni = 0; ni < 4; ++ni) bgl[ni] = *(const float4*)(p.b_glu + l * 512 + nt * 128 + wn * 64 + ni * 16 + quad * 4);
#pragma unroll
        for (int mi = 0; mi < 4; ++mi) {
          const int r = mt * 128 + wm * 64 + mi * 16 + l15;
          uint2 gg[4];
#pragma unroll
          for (int ni = 0; ni < 4; ++ni) gg[ni] = *(const uint2*)(Gbuf + (size_t)r * 512 + nt * 128 + wn * 64 + ni * 16 + quad * 4);
#pragma unroll
          for (int ni = 0; ni < 4; ++ni) {
            const int c = nt * 128 + wn * 64 + ni * 16 + quad * 4;
            const float g0 = __uint_as_float(gg[ni].x << 16), g1 = __uint_as_float(gg[ni].x & 0xffff0000u);
            const float g2 = __uint_as_float(gg[ni].y << 16), g3 = __uint_as_float(gg[ni].y & 0xffff0000u);
            uint2 o;
            o.x = pack2(g0 * sigm(acc[mi][ni][0] + bgl[ni].x), g1 * sigm(acc[mi][ni][1] + bgl[ni].y));
            o.y = pack2(g2 * sigm(acc[mi][ni][2] + bgl[ni].z), g3 * sigm(acc[mi][ni][3] + bgl[ni].w));
            *(uint2*)(proj + (size_t)r * PJ + PC_U + c) = o;
          }
        }
      }
      xcd_barrier(xb);
    }

#pragma unroll 1
    for (int rep = 0, nrep = REPS(3); rep < nrep; ++rep) {
      for (int tile = lbid + mt_min * 16; tile < 144 * 16; tile += nblk) {
        const int mt = tile >> 4, nt = tile & 15;
        f32x4 sg[3][4][2];
#pragma unroll
        for (int g = 0; g < 3; ++g) zero_acc<2>(sg[g]);
        gemm_core_g3(sg, hbuf + (size_t)mt * 128 * 1024, 1024, W + W_IN + (size_t)(3584 + nt * 64) * 1024,
                     (size_t)1024 * 1024, 1024, 1024, (bf16_t*)smem);
        unsigned sgp[3][4][2][2];
#pragma unroll
        for (int g = 0; g < 3; ++g)
#pragma unroll
          for (int mi = 0; mi < 4; ++mi)
#pragma unroll
            for (int ni = 0; ni < 2; ++ni) {
              sgp[g][mi][ni][0] = pack2(sigm(sg[g][mi][ni][0]), sigm(sg[g][mi][ni][1]));
              sgp[g][mi][ni][1] = pack2(sigm(sg[g][mi][ni][2]), sigm(sg[g][mi][ni][3]));
            }
        f32x4 tot[4][2];
        zero_acc<2>(tot);
#pragma unroll 1
        for (int i = 0; i < 3; ++i) {
          f32x4 ab[4][2];
          zero_acc<2>(ab);
          const bf16_t* Ai = proj + (size_t)mt * 128 * PJ + (i == 0 ? PC_U : (i == 1 ? PC_RG : PC_NQ));
          const bf16_t* Wi = W + (i == 0 ? W_BS5 : (i == 1 ? W_BRET : W_BNA)) + (size_t)nt * 64 * 512;
          gemm_core_v1<2, true>(ab, Ai, PJ, Wi, 512, 512, (bf16_t*)smem);
#pragma unroll
          for (int mi = 0; mi < 4; ++mi)
#pragma unroll
            for (int ni = 0; ni < 2; ++ni) {
              const unsigned u0 = sgp[0][mi][ni][0], u1 = sgp[0][mi][ni][1];
              tot[mi][ni][0] += __uint_as_float(u0 << 16) * ab[mi][ni][0];
              tot[mi][ni][1] += __uint_as_float(u0 & 0xffff0000u) * ab[mi][ni][1];
              tot[mi][ni][2] += __uint_as_float(u1 << 16) * ab[mi][ni][2];
              tot[mi][ni][3] += __uint_as_float(u1 & 0xffff0000u) * ab[mi][ni][3];
              sgp[0][mi][ni][0] = sgp[1][mi][ni][0];
              sgp[0][mi][ni][1] = sgp[1][mi][ni][1];
              sgp[1][mi][ni][0] = sgp[2][mi][ni][0];
              sgp[1][mi][ni][1] = sgp[2][mi][ni][1];
            }
        }
        TIDVARS
#pragma unroll
        for (int mi = 0; mi < 4; ++mi)
#pragma unroll
          for (int ni = 0; ni < 2; ++ni) {
            const int r = mt * 128 + wm * 64 + mi * 16 + l15;
            const int c = nt * 64 + wn * 32 + ni * 16 + quad * 4;
            uint2 o;
            o.x = pack2(tot[mi][ni][0], tot[mi][ni][1]);
            o.y = pack2(tot[mi][ni][2], tot[mi][ni][3]);
            *(uint2*)(mbuf + (size_t)r * 1024 + c) = o;
          }
      }
      xcd_barrier(xb);
    }

#pragma unroll 1
    for (int rep = 0, nrep = REPS(5); rep < nrep; ++rep) {
      const bool dry = rep > 0;
      float* dctx = dry ? (float*)(p.ws + WS_END) : ctxs;
      float* dx = dry ? (float*)(p.ws + WS_END) : p.out;
      const size_t omask = dry ? (size_t)0x7FFFFF : ~(size_t)0;
      if (last && !dry) {
        for (int tile = lbid + 64; tile < 72 * 8; tile += nblk)
          resid_big_tile(p, l, tile >> 3, tile & 7, mbuf, 1024, W + W_OUT, 1024, 1024, 2048, src_x, p.out, (bf16_t*)smem);
      } else
      for (int tile = lbid + mt_min * 8; tile < 144 * 8; tile += nblk) {
        const int mt = tile >> 3, nt = tile & 7;
        f32x4 acc[4][4];
        zero_acc<4>(acc);
        gemm_core_v1<4, true>(acc, mbuf + (size_t)mt * 128 * 1024, 1024, W + W_OUT + (size_t)nt * 128 * 1024, 1024, 1024, (bf16_t*)smem);
        TIDVARS
        const bool isc = mt < 16;
        const int modrow = isc ? 8 : (mt - 16) >> 4;
        const float* sbase = isc ? src_ctx : src_x;
        float* dbase = isc ? dctx : dx;
        float4 gv[4];
#pragma unroll
        for (int ni = 0; ni < 4; ++ni)
          gv[ni] = *(const float4*)(modp + (size_t)(l * 9 + modrow) * 6144 + 2048 + nt * 128 + wn * 64 + ni * 16 + quad * 4);
#pragma unroll
        for (int mi = 0; mi < 4; ++mi) {
          const int r = mt * 128 + wm * 64 + mi * 16 + l15;
          const size_t o = (size_t)(isc ? r : r - R_CTX) * 1024 + nt * 128 + wn * 64 + quad * 4;
          float4 sv[4];
#pragma unroll
          for (int ni = 0; ni < 4; ++ni) sv[ni] = *(const float4*)(sbase + o + ni * 16);
#pragma unroll
          for (int ni = 0; ni < 4; ++ni) {
            float4 ov;
            ov.x = sv[ni].x + gv[ni].x * acc[mi][ni][0];
            ov.y = sv[ni].y + gv[ni].y * acc[mi][ni][1];
            ov.z = sv[ni].z + gv[ni].z * acc[mi][ni][2];
            ov.w = sv[ni].w + gv[ni].w * acc[mi][ni][3];
            *(float4*)(dbase + ((o + ni * 16) & omask)) = ov;
          }
        }
      }
      xcd_barrier(xb);
    }

#pragma unroll 1
    for (int rep = 0, nrep = REPS63; rep < nrep; ++rep) {
      for (int it = bid + mt_min * 16; it < R_ALL / 8; it += nblk) {
        TIDVARS
        norm_rows(p, l, 1, it * 8 + w, ctxs, p.out);
      }
      xcd_barrier(xb);
    }

#pragma unroll 1
    for (int rep = 0, nrep = REPS(4); rep < nrep; ++rep) {
      for (int tile = lbid + (mt_min >> 1) * 44; tile < 72 * 44; tile += nblk) {
        const int mt = tile / 44, nt = tile % 44;
        f32x4 acc[8][4];
#pragma unroll
        for (int mi = 0; mi < 8; ++mi)
#pragma unroll
          for (int ni = 0; ni < 4; ++ni) acc[mi][ni] = f32x4{0.f, 0.f, 0.f, 0.f};
        gemm_core_big<true>(acc, hbuf + (size_t)mt * 256 * 1024, 1024, W + W_FG + (size_t)nt * 128 * 1024, 1024, 1024, (bf16_t*)smem);
        TIDVARS
#pragma unroll
        for (int mi = 0; mi < 8; ++mi)
#pragma unroll
          for (int ni = 0; ni < 2; ++ni) {
            const int r = mt * 256 + wm * 128 + mi * 16 + l15;
            const int c = nt * 64 + wn * 32 + ni * 16 + quad * 4;
            uint2 o;
            o.x = pack2(siluf_(acc[mi][ni][0]) * acc[mi][ni + 2][0], siluf_(acc[mi][ni][1]) * acc[mi][ni + 2][1]);
            o.y = pack2(siluf_(acc[mi][ni][2]) * acc[mi][ni + 2][2], siluf_(acc[mi][ni][3]) * acc[mi][ni + 2][3]);
            *(uint2*)(hid + (size_t)r * FFN + c) = o;
          }
      }
      xcd_barrier(xb);
    }

#pragma unroll 1
    for (int rep = 0, nrep = REPS(5); rep < nrep; ++rep) {
      const bool dry = rep > 0;
      float* dctx = dry ? (float*)(p.ws + WS_END) : ctxs;
      float* dx = dry ? (float*)(p.ws + WS_END) : p.out;
      const size_t omask = dry ? (size_t)0x7FFFFF : ~(size_t)0;
      if (last && !dry) {
        for (int tile = lbid + 64; tile < 72 * 8; tile += nblk)
          resid_big_tile(p, l, tile >> 3, tile & 7, hid, FFN, W + W_FD, FFN, FFN, 5120, p.out, p.out, (bf16_t*)smem);
      } else
      for (int tile = lbid + mt_min * 8; tile < 144 * 8; tile += nblk) {
        const int mt = tile >> 3, nt = tile & 7;
        f32x4 acc[4][4];
        zero_acc<4>(acc);
        gemm_core_v1<4, true>(acc, hid + (size_t)mt * 128 * FFN, FFN, W + W_FD + (size_t)nt * 128 * FFN, FFN, FFN, (bf16_t*)smem);
        TIDVARS
        const bool isc = mt < 16;
        const int modrow = isc ? 8 : (mt - 16) >> 4;
        const float* sbase = isc ? (const float*)ctxs : (const float*)p.out;
        float* dbase = isc ? dctx : dx;
        float4 gv[4];
#pragma unroll
        for (int ni = 0; ni < 4; ++ni)
          gv[ni] = *(const float4*)(modp + (size_t)(l * 9 + modrow) * 6144 + 5120 + nt * 128 + wn * 64 + ni * 16 + quad * 4);
#pragma unroll
        for (int mi = 0; mi < 4; ++mi) {
          const int r = mt * 128 + wm * 64 + mi * 16 + l15;
          const size_t o = (size_t)(isc ? r : r - R_CTX) * 1024 + nt * 128 + wn * 64 + quad * 4;
          float4 sv[4];
#pragma unroll
          for (int ni = 0; ni < 4; ++ni) sv[ni] = *(const float4*)(sbase + o + ni * 16);
#pragma unroll
          for (int ni = 0; ni < 4; ++ni) {
            float4 ov;
            ov.x = sv[ni].x + gv[ni].x * acc[mi][ni][0];
            ov.y = sv[ni].y + gv[ni].y * acc[mi][ni][1];
            ov.z = sv[ni].z + gv[ni].z * acc[mi][ni][2];
            ov.w = sv[ni].w + gv[ni].w * acc[mi][ni][3];
            *(float4*)(dbase + ((o + ni * 16) & omask)) = ov;
          }
        }
      }
      xcd_barrier(xb);
    }
#if PROBE == 7
    for (int i = 0; i < 10; ++i) xcd_barrier(xb);
#endif
  }

  for (int it = bid; it < (NB * SEQ) / 4; it += nblk) {
    TIDVARS
    const int r = it * 4 + w;
    float* row = p.out + (size_t)r * 1024;
    float4 v[4];
    float ss = 0.f;
#pragma unroll
    for (int i = 0; i < 4; ++i) {
      v[i] = *(const float4*)(row + i * 256 + lane * 4);
      ss += v[i].x * v[i].x + v[i].y * v[i].y + v[i].z * v[i].z + v[i].w * v[i].w;
    }
    ss = wave_sum(ss);
    const float rstd = rsqrtf(ss * (1.f / 1024.f) + 1e-6f);
#pragma unroll
    for (int i = 0; i < 4; ++i) {
      const float4 fn = *(const float4*)(p.fnorm + i * 256 + lane * 4);
      float4 o;
      o.x = v[i].x * rstd * fn.x;
      o.y = v[i].y * rstd * fn.y;
      o.z = v[i].z * rstd * fn.z;
      o.w = v[i].w * rstd * fn.w;
      *(float4*)(row + i * 256 + lane * 4) = o;
    }
  }
}

extern "C" void kernel_launch(void* const* d_in, const int* in_sizes, int n_in, void* d_out, int out_size,
                              void* d_ws, size_t ws_size, hipStream_t stream) {
  static int grid_blocks = 0;
  if (!grid_blocks) {
    int dev = 0, cus = 0, per_cu = 0;
    hipGetDevice(&dev);
    hipDeviceGetAttribute(&cus, hipDeviceAttributeMultiprocessorCount, dev);
    hipOccupancyMaxActiveBlocksPerMultiprocessor(&per_cu, fwd_megakernel, 256, 0);
    if (per_cu > 2) per_cu = 2;
    if (per_cu < 1) per_cu = 1;
    grid_blocks = cus * per_cu;
  }
  if (ws_size < WS_END) fprintf(stderr, "workspace too small: %zu < %zu\n", ws_size, (size_t)WS_END);
  Params p{};
  const float** pp = (const float**)&p;
  for (int i = 0; i < 27; ++i) pp[i] = (const float*)d_in[i];
  p.out = (float*)d_out;
  p.ws = (unsigned char*)d_ws;
  hipMemsetAsync((unsigned char*)d_ws + OFF_CNT, 0, 256 + 16384, stream);
  void* args[] = {&p};
  hipError_t e = hipLaunchCooperativeKernel((void*)fwd_megakernel, dim3(grid_blocks), dim3(256), args, 0, stream);
  if (e != hipSuccess) fprintf(stderr, "cooperative launch failed: %s (grid %d)\n", hipGetErrorString(e), grid_blocks);
}
```

```cpp
#include <hip/hip_runtime.h>
#include <hip/hip_cooperative_groups.h>
#include <cstdio>
#include <cstdint>
namespace cg = cooperative_groups;

typedef unsigned short bf16_t;
using bf16x8 = __attribute__((ext_vector_type(8))) short;
using f32x4 = __attribute__((ext_vector_type(4))) float;

#ifndef PROBE
#define PROBE 0
#endif
#define REPS(n) ((PROBE == (n)) ? (1 + (int)(p.fnorm != nullptr)) : 1)
#define REPS61 ((PROBE == 6 || PROBE == 61) ? (1 + (int)(p.fnorm != nullptr)) : 1)
#define REPS62 ((PROBE == 6 || PROBE == 62) ? (1 + (int)(p.fnorm != nullptr)) : 1)
#define REPS63 ((PROBE == 6 || PROBE == 63) ? (1 + (int)(p.fnorm != nullptr)) : 1)
#define MFMA16(a, b, c) __builtin_amdgcn_mfma_f32_16x16x32_bf16((a), (b), (c), 0, 0, 0)

constexpr int NB = 8, SEQ = 2048, CTXL = 256;
constexpr int R_CTX = NB * CTXL;
constexpr int R_ALL = R_CTX + NB * SEQ;
constexpr int N_IN = 6656, FFN = 2816;
constexpr int PJ = 2560;
constexpr int PC_U = 0, PC_RK = 512, PC_NK = 768, PC_RQ = 1280, PC_RG = 1536, PC_NQ = 2048;

constexpr size_t OFF_CTXS = 0;
constexpr size_t OFF_MOD = 8388608;
constexpr size_t OFF_ROT = OFF_MOD + 442368;
constexpr size_t OFF_CNT = OFF_ROT + 8192;
constexpr size_t OFF_BAR = OFF_CNT + 256;
constexpr size_t OFF_S5BB = OFF_BAR + 16384;
constexpr size_t OFF_S5CM = OFF_S5BB + 524288;
constexpr size_t OFF_S5AB = OFF_S5CM + 524288;
constexpr size_t OFF_S5AT = OFF_S5AB + 65536;
constexpr size_t OFF_W = OFF_S5AT + 65536;
constexpr size_t OFF_H = OFF_W + 36700160;
constexpr size_t OFF_G = OFF_H + 37748736;
constexpr size_t OFF_PROJ = OFF_G + 18874368;
constexpr size_t OFF_VT = OFF_PROJ + 94371840;
constexpr size_t OFF_UT = OFF_VT + 37748736;
constexpr size_t OFF_S5V = OFF_UT + 18874368;
constexpr size_t WS_END = OFF_S5V + 4194304;

constexpr int W_IN = 0, W_GLU = 6815744, W_BS5 = 7077888, W_BRET = 7602176, W_BNA = 8126464,
              W_OUT = 8650752, W_FG = 9699328, W_FU = 12582912, W_FD = 15466496;

constexpr int SMEM_BYTES = 73728;

struct Params {
  const float *x, *c, *ctx, *c_ctx, *w_ada, *b_ada, *w_in, *lam_re, *lam_im, *log_dt, *b_re, *b_im,
      *c_re, *c_im, *s5_d, *w_glu, *b_glu, *theta, *rpb, *w_bs5, *w_bret, *w_bna, *w_out, *w_fg,
      *w_fu, *w_fd, *fnorm;
  float* out;
  unsigned char* ws;
};

__device__ __forceinline__ bf16_t f2bf(float f) {
  unsigned u = __float_as_uint(f);
  u += 0x7fffu + ((u >> 16) & 1u);
  return (bf16_t)(u >> 16);
}
__device__ __forceinline__ float bf2f(bf16_t h) { return __uint_as_float(((unsigned)h) << 16); }
__device__ __forceinline__ float sigm(float x) { return __builtin_amdgcn_rcpf(1.f + __expf(-x)); }
__device__ __forceinline__ float siluf_(float x) { return x * sigm(x); }
typedef __bf16 bf16x2_t __attribute__((ext_vector_type(2)));
typedef float f32x2_t __attribute__((ext_vector_type(2)));
__device__ __forceinline__ unsigned pack2(float a, float b) {
  f32x2_t v = {a, b};
  bf16x2_t r = __builtin_convertvector(v, bf16x2_t);
  return __builtin_bit_cast(unsigned, r);
}
__device__ __forceinline__ bf16x8 pack8(const float (&v)[8]) {
  union { unsigned u[4]; bf16x8 h; } x;
  x.u[0] = pack2(v[0], v[1]);
  x.u[1] = pack2(v[2], v[3]);
  x.u[2] = pack2(v[4], v[5]);
  x.u[3] = pack2(v[6], v[7]);
  return x.h;
}

__device__ __forceinline__ int opaque_tid() {
  int x = threadIdx.x;
  asm volatile("" : "+v"(x));
  return x;
}
#define TIDVARS                                                                          \
  const int tid = opaque_tid(), lane = tid & 63, w = tid >> 6, wm = w >> 1, wn = w & 1; \
  const int l15 = lane & 15, quad = lane >> 4;                                           \
  (void)wm; (void)wn; (void)l15; (void)quad; (void)lane; (void)w;

#define XB_TMO      128
#define XB_XCNT(j)  (256  + 64 * (j))
#define XB_XSUB(j)  (1280 + 64 * (j))
#define XB_XGEN(j)  (2304 + 64 * (j))
#define XB_TOP      3328
#define XB_TOPGEN   3392
#define XCD_BAR_WORDS 3456
#define XB_SPIN_CAP (1u << 22)
#define LAS __attribute__((address_space(3)))

__device__ __forceinline__ unsigned xb_ld(unsigned* p) { return __hip_atomic_load(p, __ATOMIC_RELAXED, __HIP_MEMORY_SCOPE_AGENT); }
__device__ __forceinline__ unsigned xb_add(unsigned* p, unsigned v) { return __hip_atomic_fetch_add(p, v, __ATOMIC_RELAXED, __HIP_MEMORY_SCOPE_AGENT); }
__device__ __forceinline__ unsigned xb_xcc_id() { return (unsigned)__builtin_amdgcn_s_getreg((3 << 11) | 20) & 0xFu; }
#define XB_SPIN(cond, bar) do { unsigned _sp = 0; while (cond) { __builtin_amdgcn_s_sleep(1); \
    if ((++_sp & 255u) == 0u) { if (xb_ld(&(bar)[XB_TMO])) break; if (_sp > XB_SPIN_CAP) { atomicAdd(&(bar)[XB_TMO], 1u); break; } } } } while (0)

struct XcdBarrier {
  unsigned* bar; unsigned x;
  volatile LAS unsigned* st;
};
__device__ __forceinline__ XcdBarrier xcd_barrier_post(unsigned* bar, volatile LAS unsigned* st) {
  XcdBarrier b; b.bar = bar; b.x = xb_xcc_id(); b.st = st;
  if (threadIdx.x == 0) (void)xb_add(&bar[XB_XCNT(b.x)], 1u);
  return b;
}
__device__ __forceinline__ void xcd_barrier_complete(unsigned* bar, unsigned x, unsigned& nloc, unsigned& nx) {
  const unsigned G = gridDim.x * gridDim.y * gridDim.z;
  unsigned sum, cnt_, mine, sp = 0u;
  for (;;) {
    sum = 0u; cnt_ = 0u; mine = 0u;
#pragma unroll
    for (unsigned j = 0; j < 16; ++j) { const unsigned c = xb_ld(&bar[XB_XCNT(j)]); sum += c; cnt_ += (c > 0u) ? 1u : 0u; mine = (j == x) ? c : mine; }
    if (sum == G) break;
    __builtin_amdgcn_s_sleep(1);
    if ((++sp & 255u) == 0u) { if (xb_ld(&bar[XB_TMO])) break; if (sp > XB_SPIN_CAP) { atomicAdd(&bar[XB_TMO], 1u); break; } }
  }
  nloc = mine > 0u ? mine : 1u; nx = cnt_ > 0u ? cnt_ : 1u;
}
__device__ __forceinline__ void xcd_barrier(const XcdBarrier& b) {
  asm volatile("s_waitcnt vmcnt(0)" ::: "memory");
  __syncthreads();
  if (threadIdx.x == 0) {
    unsigned* bar = b.bar;
    __builtin_amdgcn_s_waitcnt(0);
    unsigned nloc = b.st[0], nx = b.st[1];
    if (nloc == 0u) { xcd_barrier_complete(bar, b.x, nloc, nx); b.st[0] = nloc; b.st[1] = nx; }
    const unsigned old = xb_add(&bar[XB_XSUB(b.x)], 1u);
    const unsigned gen = old / nloc;
    if (old + 1u == (gen + 1u) * nloc) {
      __builtin_amdgcn_fence(__ATOMIC_RELEASE, "agent");
      asm volatile("s_waitcnt vmcnt(0)" ::: "memory");
      const unsigned og = xb_add(&bar[XB_TOP], 1u);
      const unsigned tg = og / nx;
      if (og + 1u == (tg + 1u) * nx) xb_add(&bar[XB_TOPGEN], 1u);
      else XB_SPIN(xb_ld(&bar[XB_TOPGEN]) == tg, bar);
      __builtin_amdgcn_fence(__ATOMIC_ACQUIRE, "agent");
      xb_add(&bar[XB_XGEN(b.x)], 1u);
      asm volatile("s_waitcnt vmcnt(0)" ::: "memory");
    } else {
      XB_SPIN(xb_ld(&bar[XB_XGEN(b.x)]) == gen, bar);
      __builtin_amdgcn_fence(__ATOMIC_ACQUIRE, "agent");
      asm volatile("s_waitcnt vmcnt(0)" ::: "memory");
    }
  }
  __syncthreads();
}

constexpr int GEMM_STG = 18432;
template <int NI, bool SWAP>
__device__ __forceinline__ void gemm_core(f32x4 (&acc)[4][NI], const bf16_t* __restrict__ A, int lda,
                                          const bf16_t* __restrict__ Bt, int ldb, int K, bf16_t* sm) {
  constexpr int LS = 72;
  TIDVARS
  const int lrow = tid >> 3, lcc = tid & 7;
  const bf16_t* ap = A + (size_t)lrow * lda + lcc * 8;
  const bf16_t* bp = Bt + (size_t)lrow * ldb + lcc * 8;
  const size_t as = (size_t)32 * lda, bs = (size_t)32 * ldb;
  const int nk = K >> 6;
  uint4 xa0, xa1, xa2, xa3, xb0, xb1, xb2, xb3, ya0, ya1, ya2, ya3, yb0, yb1, yb2, yb3;
#define G_ISSUE(P, kt)                                              \
  {                                                                 \
    const int k_ = (((kt) < nk) ? (kt) : nk - 1) << 6;              \
    P##a0 = *(const uint4*)(ap + k_);                               \
    P##a1 = *(const uint4*)(ap + as + k_);                          \
    P##a2 = *(const uint4*)(ap + 2 * as + k_);                      \
    P##a3 = *(const uint4*)(ap + 3 * as + k_);                      \
    P##b0 = *(const uint4*)(bp + k_);                               \
    P##b1 = *(const uint4*)(bp + bs + k_);                          \
    if (NI > 2) {                                                   \
      P##b2 = *(const uint4*)(bp + 2 * bs + k_);                    \
      P##b3 = *(const uint4*)(bp + 3 * bs + k_);                    \
    }                                                               \
  }
#define G_WRITE(P, stage)                                           \
  {                                                                 \
    bf16_t* d_ = sm + (stage) * GEMM_STG + lrow * LS + lcc * 8;     \
    *(uint4*)(d_) = P##a0;                                          \
    *(uint4*)(d_ + 32 * LS) = P##a1;                                \
    *(uint4*)(d_ + 64 * LS) = P##a2;                                \
    *(uint4*)(d_ + 96 * LS) = P##a3;                                \
    *(uint4*)(d_ + 128 * LS) = P##b0;                               \
    *(uint4*)(d_ + 160 * LS) = P##b1;                               \
    if (NI > 2) {                                                   \
      *(uint4*)(d_ + 192 * LS) = P##b2;                             \
      *(uint4*)(d_ + 224 * LS) = P##b3;                             \
    }                                                               \
  }
#define G_COMPUTE(stage)                                                                           \
  {                                                                                                \
    const bf16_t* sra_ = sm + (stage) * GEMM_STG + (wm * 64 + l15) * LS + quad * 8;                \
    const bf16_t* srb_ = sm + (stage) * GEMM_STG + (128 + wn * 16 * NI + l15) * LS + quad * 8;     \
    __builtin_amdgcn_s_setprio(1);                                                                 \
    _Pragma("unroll") for (int ks = 0; ks < 2; ++ks) {                                             \
      bf16x8 a_[4], b_[NI];                                                                        \
      _Pragma("unroll") for (int mi = 0; mi < 4; ++mi) a_[mi] = *(const bf16x8*)(sra_ + mi * 16 * LS + ks * 32); \
      _Pragma("unroll") for (int ni = 0; ni < NI; ++ni) b_[ni] = *(const bf16x8*)(srb_ + ni * 16 * LS + ks * 32); \
      _Pragma("unroll") for (int mi = 0; mi < 4; ++mi)                                             \
      _Pragma("unroll") for (int ni = 0; ni < NI; ++ni)                                            \
        acc[mi][ni] = SWAP ? MFMA16(b_[ni], a_[mi], acc[mi][ni]) : MFMA16(a_[mi], b_[ni], acc[mi][ni]); \
    }                                                                                              \
    __builtin_amdgcn_s_setprio(0);                                                                 \
  }
  G_ISSUE(x, 0)
  G_ISSUE(y, 1)
  __syncthreads();
  G_WRITE(x, 0)
  G_ISSUE(x, 2)
  __syncthreads();
#pragma unroll 1
  for (int kt = 0; kt < nk; kt += 2) {
    G_WRITE(y, 1)
    G_ISSUE(y, kt + 3)
    G_COMPUTE(0)
    __syncthreads();
    G_WRITE(x, 0)
    G_ISSUE(x, kt + 4)
    G_COMPUTE(1)
    __syncthreads();
  }
#undef G_ISSUE
#undef G_WRITE
#undef G_COMPUTE
}

template <bool SWAP>
__device__ __forceinline__ void gemm_core_big(f32x4 (&acc)[8][4], const bf16_t* __restrict__ A, int lda,
                                              const bf16_t* __restrict__ Bt, int ldb, int K, bf16_t* sm) {
  constexpr int LS = 80;
  TIDVARS
  const int lrow = tid >> 3, lcc = tid & 7;
  const bf16_t* ap = A + (size_t)lrow * lda + lcc * 8;
  const bf16_t* bp = Bt + (size_t)lrow * ldb + lcc * 8;
  const size_t as = (size_t)32 * lda, bs = (size_t)32 * ldb;
  uint4 ra0, ra1, ra2, ra3, ra4, ra5, ra6, ra7, rb0, rb1, rb2, rb3;
#define GB_ISSUE(k_)                              \
  ra0 = *(const uint4*)(ap + (k_));               \
  ra1 = *(const uint4*)(ap + as + (k_));          \
  ra2 = *(const uint4*)(ap + 2 * as + (k_));      \
  ra3 = *(const uint4*)(ap + 3 * as + (k_));      \
  ra4 = *(const uint4*)(ap + 4 * as + (k_));      \
  ra5 = *(const uint4*)(ap + 5 * as + (k_));      \
  ra6 = *(const uint4*)(ap + 6 * as + (k_));      \
  ra7 = *(const uint4*)(ap + 7 * as + (k_));      \
  rb0 = *(const uint4*)(bp + (k_));               \
  rb1 = *(const uint4*)(bp + bs + (k_));          \
  rb2 = *(const uint4*)(bp + 2 * bs + (k_));      \
  rb3 = *(const uint4*)(bp + 3 * bs + (k_));
  GB_ISSUE(0)
  bf16_t* swa = sm + lrow * LS + lcc * 8;
  const bf16_t* sra = sm + (wm * 128 + l15) * LS + quad * 8;
  const bf16_t* srb = sm + (256 + wn * 64 + l15) * LS + quad * 8;
#pragma unroll 1
  for (int k0 = 0; k0 < K; k0 += 64) {
    __syncthreads();
    *(uint4*)(swa) = ra0;
    *(uint4*)(swa + 32 * LS) = ra1;
    *(uint4*)(swa + 64 * LS) = ra2;
    *(uint4*)(swa + 96 * LS) = ra3;
    *(uint4*)(swa + 128 * LS) = ra4;
    *(uint4*)(swa + 160 * LS) = ra5;
    *(uint4*)(swa + 192 * LS) = ra6;
    *(uint4*)(swa + 224 * LS) = ra7;
    *(uint4*)(swa + 256 * LS) = rb0;
    *(uint4*)(swa + 288 * LS) = rb1;
    *(uint4*)(swa + 320 * LS) = rb2;
    *(uint4*)(swa + 352 * LS) = rb3;
    __syncthreads();
    const int kn = (k0 + 64 < K) ? k0 + 64 : k0;
    GB_ISSUE(kn)
    __builtin_amdgcn_s_setprio(1);
#pragma unroll
    for (int ks = 0; ks < 2; ++ks) {
      bf16x8 b_[4];
#pragma unroll
      for (int ni = 0; ni < 4; ++ni) b_[ni] = *(const bf16x8*)(srb + ni * 16 * LS + ks * 32);
#pragma unroll
      for (int mh = 0; mh < 2; ++mh) {
        bf16x8 a_[4];
#pragma unroll
        for (int mi = 0; mi < 4; ++mi) a_[mi] = *(const bf16x8*)(sra + (mh * 4 + mi) * 16 * LS + ks * 32);
#pragma unroll
        for (int mi = 0; mi < 4; ++mi)
#pragma unroll
          for (int ni = 0; ni < 4; ++ni)
            acc[mh * 4 + mi][ni] = SWAP ? MFMA16(b_[ni], a_[mi], acc[mh * 4 + mi][ni]) : MFMA16(a_[mi], b_[ni], acc[mh * 4 + mi][ni]);
      }
    }
    __builtin_amdgcn_s_setprio(0);
  }
#undef GB_ISSUE
}

template <int NI, bool SWAP>
__device__ __forceinline__ void gemm_core_v1(f32x4 (&acc)[4][NI], const bf16_t* __restrict__ A, int lda,
                                             const bf16_t* __restrict__ Bt, int ldb, int K, bf16_t* sm) {
  constexpr int LS = 80;
  TIDVARS
  bf16_t* sA_ = sm;
  bf16_t* sB_ = sm + 128 * LS;
  const int lrow = tid >> 3, lcc = tid & 7;
  const bf16_t* ap = A + (size_t)lrow * lda + lcc * 8;
  const bf16_t* bp = Bt + (size_t)lrow * ldb + lcc * 8;
  const size_t as = (size_t)32 * lda, bs = (size_t)32 * ldb;
  uint4 ra0, ra1, ra2, ra3, rb0, rb1, rb2, rb3;
  ra0 = *(const uint4*)(ap);
  ra1 = *(const uint4*)(ap + as);
  ra2 = *(const uint4*)(ap + 2 * as);
  ra3 = *(const uint4*)(ap + 3 * as);
  rb0 = *(const uint4*)(bp);
  rb1 = *(const uint4*)(bp + bs);
  if (NI > 2) {
    rb2 = *(const uint4*)(bp + 2 * bs);
    rb3 = *(const uint4*)(bp + 3 * bs);
  } else {
    rb2 = rb0;
    rb3 = rb0;
  }
  bf16_t* swa = sA_ + lrow * LS + lcc * 8;
  bf16_t* swb = sB_ + lrow * LS + lcc * 8;
  const bf16_t* sra = sA_ + (wm * 64 + l15) * LS + quad * 8;
  const bf16_t* srb = sB_ + (wn * 16 * NI + l15) * LS + quad * 8;
  for (int k0 = 0; k0 < K; k0 += 64) {
    __syncthreads();
    *(uint4*)(swa) = ra0;
    *(uint4*)(swa + 32 * LS) = ra1;
    *(uint4*)(swa + 64 * LS) = ra2;
    *(uint4*)(swa + 96 * LS) = ra3;
    *(uint4*)(swb) = rb0;
    *(uint4*)(swb + 32 * LS) = rb1;
    if (NI > 2) {
      *(uint4*)(swb + 64 * LS) = rb2;
      *(uint4*)(swb + 96 * LS) = rb3;
    }
    __syncthreads();
    const int kn = (k0 + 64 < K) ? k0 + 64 : k0;
    ra0 = *(const uint4*)(ap + kn);
    ra1 = *(const uint4*)(ap + as + kn);
    ra2 = *(const uint4*)(ap + 2 * as + kn);
    ra3 = *(const uint4*)(ap + 3 * as + kn);
    rb0 = *(const uint4*)(bp + kn);
    rb1 = *(const uint4*)(bp + bs + kn);
    if (NI > 2) {
      rb2 = *(const uint4*)(bp + 2 * bs + kn);
      rb3 = *(const uint4*)(bp + 3 * bs + kn);
    }
    __builtin_amdgcn_s_setprio(1);
#pragma unroll
    for (int ks = 0; ks < 2; ++ks) {
      bf16x8 a[4], b[NI];
#pragma unroll
      for (int mi = 0; mi < 4; ++mi) a[mi] = *(const bf16x8*)(sra + mi * 16 * LS + ks * 32);
#pragma unroll
      for (int ni = 0; ni < NI; ++ni) b[ni] = *(const bf16x8*)(srb + ni * 16 * LS + ks * 32);
#pragma unroll
      for (int mi = 0; mi < 4; ++mi)
#pragma unroll
        for (int ni = 0; ni < NI; ++ni)
          acc[mi][ni] = SWAP ? MFMA16(b[ni], a[mi], acc[mi][ni]) : MFMA16(a[mi], b[ni], acc[mi][ni]);
    }
    __builtin_amdgcn_s_setprio(0);
  }
}

__device__ __forceinline__ void gemm_core_g3(f32x4 (&acc)[3][4][2], const bf16_t* __restrict__ A, int lda,
                                             const bf16_t* __restrict__ Bt, size_t gstride, int ldb, int K, bf16_t* sm) {
  constexpr int LS = 80;
  TIDVARS
  const int lrow = tid >> 3, lcc = tid & 7;
  const bf16_t* ap = A + (size_t)lrow * lda + lcc * 8;
  const bf16_t* bp = Bt + (size_t)lrow * ldb + lcc * 8;
  const size_t as = (size_t)32 * lda, bs = (size_t)32 * ldb;
  uint4 ra0, ra1, ra2, ra3, rb0, rb1, rb2, rb3, rb4, rb5;
#define G3_ISSUE(k_)                                    \
  ra0 = *(const uint4*)(ap + (k_));                     \
  ra1 = *(const uint4*)(ap + as + (k_));                \
  ra2 = *(const uint4*)(ap + 2 * as + (k_));            \
  ra3 = *(const uint4*)(ap + 3 * as + (k_));            \
  rb0 = *(const uint4*)(bp + (k_));                     \
  rb1 = *(const uint4*)(bp + bs + (k_));                \
  rb2 = *(const uint4*)(bp + gstride + (k_));           \
  rb3 = *(const uint4*)(bp + gstride + bs + (k_));      \
  rb4 = *(const uint4*)(bp + 2 * gstride + (k_));       \
  rb5 = *(const uint4*)(bp + 2 * gstride + bs + (k_));
  G3_ISSUE(0)
  bf16_t* swa = sm + lrow * LS + lcc * 8;
  const bf16_t* sra = sm + (wm * 64 + l15) * LS + quad * 8;
  const bf16_t* srb = sm + (128 + wn * 32 + l15) * LS + quad * 8;
#pragma unroll 1
  for (int k0 = 0; k0 < K; k0 += 64) {
    __syncthreads();
    *(uint4*)(swa) = ra0;
    *(uint4*)(swa + 32 * LS) = ra1;
    *(uint4*)(swa + 64 * LS) = ra2;
    *(uint4*)(swa + 96 * LS) = ra3;
    *(uint4*)(swa + 128 * LS) = rb0;
    *(uint4*)(swa + 160 * LS) = rb1;
    *(uint4*)(swa + 192 * LS) = rb2;
    *(uint4*)(swa + 224 * LS) = rb3;
    *(uint4*)(swa + 256 * LS) = rb4;
    *(uint4*)(swa + 288 * LS) = rb5;
    __syncthreads();
    const int kn = (k0 + 64 < K) ? k0 + 64 : k0;
    G3_ISSUE(kn)
    __builtin_amdgcn_s_setprio(1);
#pragma unroll
    for (int ks = 0; ks < 2; ++ks) {
      bf16x8 a_[4];
#pragma unroll
      for (int mi = 0; mi < 4; ++mi) a_[mi] = *(const bf16x8*)(sra + mi * 16 * LS + ks * 32);
#pragma unroll
      for (int g = 0; g < 3; ++g) {
        bf16x8 b_[2];
#pragma unroll
        for (int ni = 0; ni < 2; ++ni) b_[ni] = *(const bf16x8*)(srb + (g * 64 + ni * 16) * LS + ks * 32);
#pragma unroll
        for (int mi = 0; mi < 4; ++mi)
#pragma unroll
          for (int ni = 0; ni < 2; ++ni) acc[g][mi][ni] = MFMA16(b_[ni], a_[mi], acc[g][mi][ni]);
        __builtin_amdgcn_sched_barrier(0);
      }
    }
    __builtin_amdgcn_s_setprio(0);
  }
#undef G3_ISSUE
}

template <int NI>
__device__ __forceinline__ void zero_acc(f32x4 (&acc)[4][NI]) {
#pragma unroll
  for (int mi = 0; mi < 4; ++mi)
#pragma unroll
    for (int ni = 0; ni < NI; ++ni) acc[mi][ni] = f32x4{0.f, 0.f, 0.f, 0.f};
}

__device__ __forceinline__ float wave_sum(float v) {
#pragma unroll
  for (int off = 32; off >= 1; off >>= 1) v += __shfl_xor(v, off);
  return v;
}

__device__ void s5_tables(const Params& p, int idx) {
  bf16_t* bbt = (bf16_t*)(p.ws + OFF_S5BB);
  bf16_t* cm = (bf16_t*)(p.ws + OFF_S5CM);
  float* ab = (float*)(p.ws + OFF_S5AB);
  float* at = (float*)(p.ws + OFF_S5AT);
  const int pp = idx & 63, ldg = idx >> 6;
  const float lr = p.lam_re[idx], li = p.lam_im[idx];
  const float dt = expf(p.log_dt[ldg]);
  const float mag = expf(lr * dt), ang = li * dt;
  const float abr = mag * cosf(ang), abi = mag * sinf(ang);
  const float den = lr * lr + li * li;
  const float fr = ((abr - 1.f) * lr + abi * li) / den;
  const float fi = (abi * lr - (abr - 1.f) * li) / den;
  for (int h = 0; h < 16; ++h) {
    const float br = p.b_re[(size_t)idx * 16 + h], bi = p.b_im[(size_t)idx * 16 + h];
    bbt[(size_t)ldg * 2048 + (2 * pp) * 16 + h] = f2bf(fr * br - fi * bi);
    bbt[(size_t)ldg * 2048 + (2 * pp + 1) * 16 + h] = f2bf(fr * bi + fi * br);
    const size_t ci = ((size_t)ldg * 16 + h) * 64 + pp;
    cm[(size_t)ldg * 2048 + h * 128 + 2 * pp] = f2bf(p.c_re[ci]);
    cm[(size_t)ldg * 2048 + h * 128 + 2 * pp + 1] = f2bf(-p.c_im[ci]);
  }
  ab[idx * 2] = abr;
  ab[idx * 2 + 1] = abi;
  float tr = abr, ti = abi;
  for (int i = 0; i < 7; ++i) {
    const float nr = tr * tr - ti * ti, ni = 2.f * tr * ti;
    tr = nr;
    ti = ni;
  }
  at[idx * 2] = tr;
  at[idx * 2 + 1] = ti;
  bf16_t* vt = (bf16_t*)(p.ws + OFF_S5V) + (size_t)ldg * 16384;
  const int d = (ldg >> 5) & 1;
  float qr = 1.f, qi = 0.f;
  for (int k = 0; k < 128; ++k) {
    const int tp = d ? k : 127 - k;
    vt[pp * 128 + tp] = f2bf(qr);
    vt[(64 + pp) * 128 + tp] = f2bf(qi);
    const float nr = qr * abr - qi * abi, ni = qr * abi + qi * abr;
    qr = nr;
    qi = ni;
  }
}

__device__ void mod_item(const Params& p, int item, float* smem) {
  const int l = item / 96, cgp = item % 96;
  const int tid = opaque_tid();
  float* sc = smem;
  float* red = smem + 9 * 1024;
  __syncthreads();
  for (int i = tid; i < 9 * 1024; i += 256) {
    const int r = i >> 10, k = i & 1023;
    const float v = (r < 8) ? p.c[r * 1024 + k] : p.c_ctx[k];
    sc[i] = siluf_(v);
  }
  __syncthreads();
  const int col = cgp * 64 + (tid & 63), kq = tid >> 6;
  float acc[9];
#pragma unroll
  for (int r = 0; r < 9; ++r) acc[r] = 0.f;
  const float* wp = p.w_ada + (size_t)l * 1024 * 6144 + col;
#pragma unroll 1
  for (int k0 = kq * 256; k0 < kq * 256 + 256; k0 += 16) {
    float wv[16];
#pragma unroll
    for (int u = 0; u < 16; ++u) wv[u] = __builtin_nontemporal_load(wp + (size_t)(k0 + u) * 6144);
#pragma unroll
    for (int u = 0; u < 16; ++u)
#pragma unroll
      for (int r = 0; r < 9; ++r) acc[r] += sc[r * 1024 + k0 + u] * wv[u];
  }
#pragma unroll
  for (int r = 0; r < 9; ++r) red[(kq * 9 + r) * 64 + (tid & 63)] = acc[r];
  __syncthreads();
  float* mod = (float*)(p.ws + OFF_MOD);
  for (int i = tid; i < 9 * 64; i += 256) {
    const int r = i >> 6, cc = i & 63;
    const float s = red[(0 * 9 + r) * 64 + cc] + red[(1 * 9 + r) * 64 + cc] + red[(2 * 9 + r) * 64 + cc] +
                    red[(3 * 9 + r) * 64 + cc];
    mod[(size_t)(l * 9 + r) * 6144 + cgp * 64 + cc] = s + p.b_ada[l * 6144 + cgp * 64 + cc];
  }
}

__device__ __forceinline__ float4 nt_ld4(const float* p_) {
  const f32x4 v = __builtin_nontemporal_load((const f32x4*)p_);
  return float4{v[0], v[1], v[2], v[3]};
}
struct WcDesc { const float* src; int K, N, dst, gu, kt, nt; };
__device__ __forceinline__ WcDesc wc_decode(const Params& p, int l, int it) {
  WcDesc d;
  d.gu = -1;
  if (it < 1664) { d.src = p.w_in + (size_t)l * 1024 * 6656; d.K = 1024; d.N = 6656; d.dst = W_IN; }
  else if (it < 1728) { it -= 1664; d.src = p.w_glu + (size_t)l * 512 * 512; d.K = 512; d.N = 512; d.dst = W_GLU; }
  else if (it < 1856) { it -= 1728; d.src = p.w_bs5 + (size_t)l * 512 * 1024; d.K = 512; d.N = 1024; d.dst = W_BS5; }
  else if (it < 1984) { it -= 1856; d.src = p.w_bret + (size_t)l * 512 * 1024; d.K = 512; d.N = 1024; d.dst = W_BRET; }
  else if (it < 2112) { it -= 1984; d.src = p.w_bna + (size_t)l * 512 * 1024; d.K = 512; d.N = 1024; d.dst = W_BNA; }
  else if (it < 2368) { it -= 2112; d.src = p.w_out + (size_t)l * 1024 * 1024; d.K = 1024; d.N = 1024; d.dst = W_OUT; }
  else if (it < 3072) { it -= 2368; d.src = p.w_fg + (size_t)l * 1024 * 2816; d.K = 1024; d.N = 2816; d.dst = W_FG; d.gu = 0; }
  else if (it < 3776) { it -= 3072; d.src = p.w_fu + (size_t)l * 1024 * 2816; d.K = 1024; d.N = 2816; d.dst = W_FG; d.gu = 1; }
  else { it -= 3776; d.src = p.w_fd + (size_t)l * 2816 * 1024; d.K = 2816; d.N = 1024; d.dst = W_FD; }
  const int ntn = d.N >> 6;
  d.kt = it / ntn;
  d.nt = it % ntn;
  return d;
}
__device__ void wconv_range(const Params& p, int l, int first, int stride, int n, float* tile) {
  const int tid = opaque_tid();
  const int kr0 = tid >> 4, nc = (tid & 15) * 4;
  int it = first;
  if (it >= n) return;
  WcDesc d = wc_decode(p, l, it);
  float4 v0, v1, v2, v3;
#define WC_LOAD(D)                                                                           \
  {                                                                                          \
    const float* s_ = (D).src + (size_t)((D).kt * 64 + kr0) * (D).N + (D).nt * 64 + nc;      \
    v0 = nt_ld4((s_));                                    \
    v1 = nt_ld4((s_ + (size_t)16 * (D).N));               \
    v2 = nt_ld4((s_ + (size_t)32 * (D).N));               \
    v3 = nt_ld4((s_ + (size_t)48 * (D).N));               \
  }
  WC_LOAD(d)
  while (true) {
    __syncthreads();
    {
      float* t0 = tile + kr0 * 65 + nc;
      t0[0] = v0.x; t0[1] = v0.y; t0[2] = v0.z; t0[3] = v0.w;
      t0[16 * 65 + 0] = v1.x; t0[16 * 65 + 1] = v1.y; t0[16 * 65 + 2] = v1.z; t0[16 * 65 + 3] = v1.w;
      t0[32 * 65 + 0] = v2.x; t0[32 * 65 + 1] = v2.y; t0[32 * 65 + 2] = v2.z; t0[32 * 65 + 3] = v2.w;
      t0[48 * 65 + 0] = v3.x; t0[48 * 65 + 1] = v3.y; t0[48 * 65 + 2] = v3.z; t0[48 * 65 + 3] = v3.w;
    }
    __syncthreads();
    const int nx = it + stride;
    WcDesc dn = d;
    if (nx < n) {
      dn = wc_decode(p, l, nx);
      WC_LOAD(dn)
    }
    const int nn = tid >> 2, kq = tid & 3;
    unsigned u[8];
#pragma unroll
    for (int i = 0; i < 8; ++i)
      u[i] = pack2(tile[(kq * 16 + 2 * i) * 65 + nn], tile[(kq * 16 + 2 * i + 1) * 65 + nn]);
    bf16_t* Wd = (bf16_t*)(p.ws + OFF_W) + d.dst;
    int drow = d.nt * 64 + nn;
    if (d.gu >= 0) drow = (drow >> 6) * 128 + ((drow >> 5) & 1) * 64 + d.gu * 32 + (drow & 31);
    uint4* dp = (uint4*)(Wd + (size_t)drow * d.K + d.kt * 64 + kq * 16);
    dp[0] = uint4{u[0], u[1], u[2], u[3]};
    dp[1] = uint4{u[4], u[5], u[6], u[7]};
    if (nx >= n) break;
    it = nx;
    d = dn;
  }
#undef WC_LOAD
}

__device__ void norm_rows(const Params& p, int l, int which, int r, const float* src_ctx, const float* src_x) {
  const int lane = opaque_tid() & 63;
  float4 v[2][4];
  const float* mod[2];
#pragma unroll
  for (int q = 0; q < 2; ++q) {
    const int rr = r + q * 4;
    const float* src = (rr < R_CTX) ? src_ctx + (size_t)rr * 1024 : src_x + (size_t)(rr - R_CTX) * 1024;
    const int modrow = (rr < R_CTX) ? 8 : (rr - R_CTX) >> 11;
    mod[q] = (const float*)(p.ws + OFF_MOD) + (size_t)(l * 9 + modrow) * 6144 + which * 3072;
#pragma unroll
    for (int i = 0; i < 4; ++i)
      v[q][i] = (l == 0 && which == 0) ? nt_ld4(src + i * 256 + lane * 4)
                                       : *(const float4*)(src + i * 256 + lane * 4);
  }
#pragma unroll
  for (int q = 0; q < 2; ++q) {
    const int rr = r + q * 4;
    float ss = 0.f;
#pragma unroll
    for (int i = 0; i < 4; ++i) ss += v[q][i].x * v[q][i].x + v[q][i].y * v[q][i].y + v[q][i].z * v[q][i].z + v[q][i].w * v[q][i].w;
    ss = wave_sum(ss);
    const float rstd = rsqrtf(ss * (1.f / 1024.f) + 1e-6f);
    bf16_t* h = (bf16_t*)(p.ws + OFF_H) + (size_t)rr * 1024;
#pragma unroll
    for (int i = 0; i < 4; ++i) {
      const int c0 = i * 256 + lane * 4;
      const float4 sh = *(const float4*)(mod[q] + c0);
      const float4 sc = *(const float4*)(mod[q] + 1024 + c0);
      uint2 o;
      o.x = pack2(v[q][i].x * rstd * (1.f + sc.x) + sh.x, v[q][i].y * rstd * (1.f + sc.y) + sh.y);
      o.y = pack2(v[q][i].z * rstd * (1.f + sc.z) + sh.z, v[q][i].w * rstd * (1.f + sc.w) + sh.w);
      *(uint2*)(h + c0) = o;
    }
  }
}

__device__ __forceinline__ void resid_big_tile(const Params& p, int l, int mt, int nt, const bf16_t* A, int lda,
                                               const bf16_t* Bt, int ldb, int K, int goff, const float* sx, float* dx,
                                               bf16_t* smem) {
  f32x4 acc[8][4];
#pragma unroll
  for (int mi = 0; mi < 8; ++mi)
#pragma unroll
    for (int ni = 0; ni < 4; ++ni) acc[mi][ni] = f32x4{0.f, 0.f, 0.f, 0.f};
  gemm_core_big<true>(acc, A + (size_t)mt * 256 * lda, lda, Bt + (size_t)nt * 128 * ldb, ldb, K, smem);
  TIDVARS
  const int modrow = (mt - 8) >> 3;
  const float* modp_ = (const float*)(p.ws + OFF_MOD);
  float4 gv[4];
#pragma unroll
  for (int ni = 0; ni < 4; ++ni)
    gv[ni] = *(const float4*)(modp_ + (size_t)(l * 9 + modrow) * 6144 + goff + nt * 128 + wn * 64 + ni * 16 + quad * 4);
#pragma unroll
  for (int mi = 0; mi < 8; ++mi) {
    const int r = mt * 256 + wm * 128 + mi * 16 + l15;
    const size_t o = (size_t)(r - R_CTX) * 1024 + nt * 128 + wn * 64 + quad * 4;
    float4 sv[4];
#pragma unroll
    for (int ni = 0; ni < 4; ++ni) sv[ni] = *(const float4*)(sx + o + ni * 16);
#pragma unroll
    for (int ni = 0; ni < 4; ++ni) {
      float4 ov;
      ov.x = sv[ni].x + gv[ni].x * acc[mi][ni][0];
      ov.y = sv[ni].y + gv[ni].y * acc[mi][ni][1];
      ov.z = sv[ni].z + gv[ni].z * acc[mi][ni][2];
      ov.w = sv[ni].w + gv[ni].w * acc[mi][ni][3];
      *(float4*)(dx + o + ni * 16) = ov;
    }
  }
}

__device__ __forceinline__ void inproj_tile(const Params& p, int mt, int nt, bf16_t* smem) {
  const bf16_t* h = (const bf16_t*)(p.ws + OFF_H);
  const bf16_t* W = (const bf16_t*)(p.ws + OFF_W);
  bf16_t* proj = (bf16_t*)(p.ws + OFF_PROJ);
  bf16_t* vT = (bf16_t*)(p.ws + OFF_VT);
  const float* rot = (const float*)(p.ws + OFF_ROT);
  int colbase = 0, vrow = -1;
  float scale = 1.f;
  bool rotary = false;
  if (nt < 4) colbase = PC_U + nt * 128;
  else if (nt < 6) { colbase = PC_RK + (nt - 4) * 128; scale = 0.125f; rotary = true; }
  else if (nt < 10) vrow = (nt - 6) * 128;
  else if (nt < 14) colbase = PC_NK + (nt - 10) * 128;
  else if (nt < 18) vrow = 512 + (nt - 14) * 128;
  else if (nt < 20) { colbase = PC_RQ + (nt - 18) * 128; rotary = true; }
  else if (nt < 24) colbase = PC_RG + (nt - 20) * 128;
  else { colbase = PC_NQ + (nt - 24) * 128; scale = 0.125f; }
  f32x4 acc[8][4];
#pragma unroll
  for (int mi = 0; mi < 8; ++mi)
#pragma unroll
    for (int ni = 0; ni < 4; ++ni) acc[mi][ni] = f32x4{0.f, 0.f, 0.f, 0.f};
  if (vrow >= 0) {
    gemm_core_big<false>(acc, h + (size_t)mt * 256 * 1024, 1024, W + W_IN + (size_t)nt * 128 * 1024, 1024, 1024, smem);
    TIDVARS
    const int m0 = mt * 256 + wm * 128;
#pragma unroll
    for (int mi = 0; mi < 8; ++mi) {
      const int r0 = m0 + mi * 16 + quad * 4;
#pragma unroll
      for (int ni = 0; ni < 4; ++ni) {
        const int vr = vrow + wn * 64 + ni * 16 + l15;
        uint2 o;
        o.x = pack2(acc[mi][ni][0], acc[mi][ni][1]);
        o.y = pack2(acc[mi][ni][2], acc[mi][ni][3]);
        *(uint2*)(vT + (size_t)vr * R_ALL + r0) = o;
      }
    }
    return;
  }
  gemm_core_big<true>(acc, h + (size_t)mt * 256 * 1024, 1024, W + W_IN + (size_t)nt * 128 * 1024, 1024, 1024, smem);
  TIDVARS
  const int m0 = mt * 256 + wm * 128;
  if (rotary && mt >= 8) {
#pragma unroll
    for (int mi = 0; mi < 8; ++mi) {
      const int r = m0 + mi * 16 + l15;
      const int t = (r - R_CTX) & 2047;
      const int cr = t >> 6, cc = t & 63;
      const float4 c1 = *(const float4*)(rot + cr * 16 + quad * 4), s1 = *(const float4*)(rot + 1024 + cr * 16 + quad * 4);
      const float4 c2 = *(const float4*)(rot + cc * 16 + quad * 4), s2 = *(const float4*)(rot + 1024 + cc * 16 + quad * 4);
      const float cs1[4] = {c1.x, c1.y, c1.z, c1.w}, sn1[4] = {s1.x, s1.y, s1.z, s1.w};
      const float cs2[4] = {c2.x, c2.y, c2.z, c2.w}, sn2[4] = {s2.x, s2.y, s2.z, s2.w};
#pragma unroll
      for (int j = 0; j < 4; ++j) {
        const float a = acc[mi][0][j], bb = acc[mi][1][j];
        acc[mi][0][j] = a * cs1[j] - bb * sn1[j];
        acc[mi][1][j] = a * sn1[j] + bb * cs1[j];
        const float a2 = acc[mi][2][j], b2 = acc[mi][3][j];
        acc[mi][2][j] = a2 * cs2[j] - b2 * sn2[j];
        acc[mi][3][j] = a2 * sn2[j] + b2 * cs2[j];
      }
    }
  }
#pragma unroll
  for (int mi = 0; mi < 8; ++mi) {
    const int r = m0 + mi * 16 + l15;
#pragma unroll
    for (int ni = 0; ni < 4; ++ni) {
      uint2 o;
      o.x = pack2(acc[mi][ni][0] * scale, acc[mi][ni][1] * scale);
      o.y = pack2(acc[mi][ni][2] * scale, acc[mi][ni][3] * scale);
      *(uint2*)(proj + (size_t)r * PJ + colbase + wn * 64 + ni * 16 + quad * 4) = o;
    }
  }
  if (nt < 4) {
    bf16_t* uT = (bf16_t*)(p.ws + OFF_UT);
#pragma unroll
    for (int mi = 0; mi < 8; ++mi) {
      const int r = m0 + mi * 16 + l15;
#pragma unroll
      for (int ni = 0; ni < 4; ++ni)
#pragma unroll
        for (int j = 0; j < 4; ++j)
          uT[(size_t)(nt * 128 + wn * 64 + ni * 16 + quad * 4 + j) * R_ALL + r] = f2bf(acc[mi][ni][j]);
    }
  }
}

__device__ __forceinline__ void ret_item(const Params& p, int l, int b, int h, int qt, bool isctx, bool dry, unsigned char* smem) {
  TIDVARS
  bf16_t* proj = (bf16_t*)(p.ws + OFF_PROJ);
  const bf16_t* vT = (const bf16_t*)(p.ws + OFF_VT);
  const float LOG2E = 1.4426950408889634f;
  const float thf = p.theta[l * 8 + h], thb = p.theta[l * 8 + 4 + h];
  const float lgf = -log1pf(expf(-thf)) * LOG2E;
  const float lgb = -log1pf(expf(-thb)) * LOG2E;
  const int seqbase = isctx ? b * 256 : R_CTX + b * 2048;
  const int q0w = qt * 128 + w * 32;
  bf16x8 bq[2][2];
#pragma unroll
  for (int qb = 0; qb < 2; ++qb)
#pragma unroll
    for (int ks = 0; ks < 2; ++ks)
      bq[qb][ks] = *(const bf16x8*)(proj + (size_t)(seqbase + q0w + qb * 16 + l15) * PJ + PC_RQ + h * 64 + ks * 32 + quad * 8);
  float cfF[8], cfB[8];
#pragma unroll
  for (int j = 0; j < 8; ++j) {
    cfF[j] = exp2f(-lgf * (float)(quad * 8 + j));
    cfB[j] = exp2f(lgb * (float)(quad * 8 + j));
  }
  f32x4 O[2][8];
#pragma unroll
  for (int qb = 0; qb < 2; ++qb)
#pragma unroll
    for (int i = 0; i < 8; ++i) O[qb][i] = f32x4{0.f, 0.f, 0.f, 0.f};
  const int ntiles = isctx ? 4 : 36;
  const int lrow = tid >> 3, lcc = tid & 7;
  const bf16_t* kg = proj + PC_RK + h * 64 + lcc * 8 + (size_t)lrow * PJ;
  const bf16_t* vg = vT + (size_t)(h * 128 + lrow) * R_ALL + lcc * 8;
  constexpr int STG = 15360;
  bf16_t* sm = (bf16_t*)smem;
  const int swo = lrow * 80 + lcc * 8;
  uint4 rk0, rk1, rv0, rv1, rv2, rv3;
  {
    const int krow0 = b * 256;
    rk0 = *(const uint4*)(kg + (size_t)krow0 * PJ);
    rk1 = *(const uint4*)(kg + (size_t)(krow0 + 32) * PJ);
    rv0 = *(const uint4*)(vg + krow0);
    rv1 = *(const uint4*)(vg + (size_t)32 * R_ALL + krow0);
    rv2 = *(const uint4*)(vg + (size_t)64 * R_ALL + krow0);
    rv3 = *(const uint4*)(vg + (size_t)96 * R_ALL + krow0);
    *(uint4*)(sm + swo) = rk0;
    *(uint4*)(sm + swo + 32 * 80) = rk1;
    *(uint4*)(sm + 64 * 80 + swo) = rv0;
    *(uint4*)(sm + 64 * 80 + swo + 32 * 80) = rv1;
    *(uint4*)(sm + 64 * 80 + swo + 64 * 80) = rv2;
    *(uint4*)(sm + 64 * 80 + swo + 96 * 80) = rv3;
  }
  __syncthreads();
#pragma unroll 1
  for (int ti = 0; ti < ntiles; ++ti) {
    {
      const int tn = (ti + 1 < ntiles) ? ti + 1 : ti;
      const int krow0 = (tn < 4) ? b * 256 + tn * 64 : R_CTX + b * 2048 + (tn - 4) * 64;
      rk0 = *(const uint4*)(kg + (size_t)krow0 * PJ);
      rk1 = *(const uint4*)(kg + (size_t)(krow0 + 32) * PJ);
      rv0 = *(const uint4*)(vg + krow0);
      rv1 = *(const uint4*)(vg + (size_t)32 * R_ALL + krow0);
      rv2 = *(const uint4*)(vg + (size_t)64 * R_ALL + krow0);
      rv3 = *(const uint4*)(vg + (size_t)96 * R_ALL + krow0);
    }
    const bf16_t* Ks = sm + (ti & 1) * STG;
    const bf16_t* Vs = Ks + 64 * 80;
    const bool kctx = ti < 4;
#pragma unroll
    for (int g2 = 0; g2 < 2; ++g2) {
      const int kpos0 = (kctx ? ti * 64 : (ti - 4) * 64) + g2 * 32;
      const bf16_t* kr = Ks + (g2 * 32 + (l15 >> 2) * 8 + (l15 & 3)) * 80 + quad * 8;
      const bf16x8 kf0 = *(const bf16x8*)(kr), kf1 = *(const bf16x8*)(kr + 32);
      const bf16x8 kf2 = *(const bf16x8*)(kr + 4 * 80), kf3 = *(const bf16x8*)(kr + 4 * 80 + 32);
      bf16x8 pa[2];
#pragma unroll
      for (int qb = 0; qb < 2; ++qb) {
        f32x4 sx = f32x4{0.f, 0.f, 0.f, 0.f}, sy = f32x4{0.f, 0.f, 0.f, 0.f};
        sx = MFMA16(kf0, bq[qb][0], sx);
        sx = MFMA16(kf1, bq[qb][1], sx);
        sy = MFMA16(kf2, bq[qb][0], sy);
        sy = MFMA16(kf3, bq[qb][1], sy);
        const int qlo = q0w + qb * 16;
        const int qpos = qlo + l15;
        float pv[8];
        if (isctx || !kctx) {
          if (kpos0 + 31 <= qlo) {
            const float rf = exp2f(lgf * (float)(qpos - kpos0));
#pragma unroll
            for (int j = 0; j < 8; ++j) pv[j] = ((j < 4) ? sx[j & 3] : sy[j & 3]) * (rf * cfF[j]);
          } else if (kpos0 > qlo + 15) {
            const float rb = exp2f(lgb * (float)(kpos0 - qpos));
#pragma unroll
            for (int j = 0; j < 8; ++j) pv[j] = ((j < 4) ? sx[j & 3] : sy[j & 3]) * (rb * cfB[j]);
          } else {
#pragma unroll
            for (int j = 0; j < 8; ++j) {
              const int d = qpos - (kpos0 + quad * 8 + j);
              const float wgt = (d >= 0) ? exp2f(lgf * (float)d) : exp2f(lgb * (float)(-d));
              pv[j] = ((j < 4) ? sx[j & 3] : sy[j & 3]) * wgt;
            }
          }
        } else {
          const float rf = exp2f(lgf * (float)(qpos + 256 - kpos0));
          const float rb = exp2f(lgb * (float)(2048 - qpos + kpos0));
#pragma unroll
          for (int j = 0; j < 8; ++j) pv[j] = ((j < 4) ? sx[j & 3] : sy[j & 3]) * (rf * cfF[j] + rb * cfB[j]);
        }
        pa[qb] = pack8(pv);
      }
#pragma unroll
      for (int db = 0; db < 8; ++db) {
        const bf16x8 vf = *(const bf16x8*)(Vs + (db * 16 + l15) * 80 + g2 * 32 + quad * 8);
        O[0][db] = MFMA16(vf, pa[0], O[0][db]);
        O[1][db] = MFMA16(vf, pa[1], O[1][db]);
      }
    }
    if (ti + 1 < ntiles) {
      bf16_t* d = sm + ((ti + 1) & 1) * STG;
      *(uint4*)(d + swo) = rk0;
      *(uint4*)(d + swo + 32 * 80) = rk1;
      *(uint4*)(d + 64 * 80 + swo) = rv0;
      *(uint4*)(d + 64 * 80 + swo + 32 * 80) = rv1;
      *(uint4*)(d + 64 * 80 + swo + 64 * 80) = rv2;
      *(uint4*)(d + 64 * 80 + swo + 96 * 80) = rv3;
    }
    __syncthreads();
  }
  bf16_t* obase = dry ? (bf16_t*)(p.ws + WS_END) : proj;
  const size_t omask = dry ? (size_t)0x7FFFFF : ~(size_t)0;
#pragma unroll
  for (int qb = 0; qb < 2; ++qb) {
    float s = 0.f;
#pragma unroll
    for (int db = 0; db < 8; ++db) s += (O[qb][db][0] + O[qb][db][1]) + (O[qb][db][2] + O[qb][db][3]);
    s += __shfl_xor(s, 16);
    s += __shfl_xor(s, 32);
    const float mu = s * (1.f / 128.f);
    float v = 0.f;
#pragma unroll
    for (int db = 0; db < 8; ++db)
#pragma unroll
      for (int j = 0; j < 4; ++j) { const float d = O[qb][db][j] - mu; v += d * d; }
    v += __shfl_xor(v, 16);
    v += __shfl_xor(v, 32);
    const float rs = rsqrtf(v * (1.f / 128.f) + 1e-5f);
    const int orow = seqbase + q0w + qb * 16 + l15;
    uint2 gg[8];
#pragma unroll
    for (int db = 0; db < 8; ++db) gg[db] = *(const uint2*)(proj + (size_t)orow * PJ + PC_RG + h * 128 + db * 16 + quad * 4);
#pragma unroll
    for (int db = 0; db < 8; ++db) {
      const float g0 = __uint_as_float(gg[db].x << 16), g1 = __uint_as_float(gg[db].x & 0xffff0000u);
      const float g2 = __uint_as_float(gg[db].y << 16), g3 = __uint_as_float(gg[db].y & 0xffff0000u);
      uint2 o;
      o.x = pack2(siluf_(g0) * (O[qb][db][0] - mu) * rs, siluf_(g1) * (O[qb][db][1] - mu) * rs);
      o.y = pack2(siluf_(g2) * (O[qb][db][2] - mu) * rs, siluf_(g3) * (O[qb][db][3] - mu) * rs);
      *(uint2*)(obase + (((size_t)orow * PJ + PC_RG + h * 128 + db * 16 + quad * 4) & omask)) = o;
    }
  }
}

__device__ __forceinline__ void na_item(const Params& p, int l, int b, int h, int qidx, bool isctx, bool dry, unsigned char* smem) {
  TIDVARS
  bf16_t* proj = (bf16_t*)(p.ws + OFF_PROJ);
  const bf16_t* vT = (const bf16_t*)(p.ws + OFF_VT);
  const int qrow0 = isctx ? b * 256 + qidx * 64 : R_CTX + b * 2048 + qidx * 64;
  float* rpbs = (float*)smem;
  float* part = (float*)(smem + 2048);
  {
    const float* rp = p.rpb + (size_t)(l * 8 + h) * 465;
    for (int i = tid; i < 465; i += 256) rpbs[i] = rp[i];
  }
  bf16x8 bq[4][2];
#pragma unroll
  for (int qb = 0; qb < 4; ++qb)
#pragma unroll
    for (int ks = 0; ks < 2; ++ks)
      bq[qb][ks] = *(const bf16x8*)(proj + (size_t)(qrow0 + qb * 16 + l15) * PJ + PC_NQ + h * 64 + ks * 32 + quad * 8);
  const int r = qidx;
  const int rs = min(max(r - 4, 0), 24);
  const int winbase = R_CTX + b * 2048 + rs * 64;
  float m_run[4], l_run[4];
  f32x4 O[4][4];
#pragma unroll
  for (int qb = 0; qb < 4; ++qb) {
    m_run[qb] = -1e30f;
    l_run[qb] = 0.f;
#pragma unroll
    for (int i = 0; i < 4; ++i) O[qb][i] = f32x4{0.f, 0.f, 0.f, 0.f};
  }
  const int ngr = isctx ? 2 : 6;
  const bf16_t* kbase = proj + PC_NK + h * 64 + quad * 8 + (size_t)((l15 >> 2) * 8 + (l15 & 3)) * PJ;
  const bf16_t* vbase = vT + (size_t)(512 + h * 64 + l15) * R_ALL + quad * 8;
  bf16x8 kf0, kf1, kf2, kf3, vf0, vf1, vf2, vf3;
  {
    const int krow0 = b * 256 + w * 64;
    const bf16_t* kp = kbase + (size_t)krow0 * PJ;
    kf0 = *(const bf16x8*)(kp);
    kf1 = *(const bf16x8*)(kp + 32);
    kf2 = *(const bf16x8*)(kp + 4 * PJ);
    kf3 = *(const bf16x8*)(kp + 4 * PJ + 32);
    vf0 = *(const bf16x8*)(vbase + krow0);
    vf1 = *(const bf16x8*)(vbase + (size_t)16 * R_ALL + krow0);
    vf2 = *(const bf16x8*)(vbase + (size_t)32 * R_ALL + krow0);
    vf3 = *(const bf16x8*)(vbase + (size_t)48 * R_ALL + krow0);
  }
  __syncthreads();
#pragma unroll 1
  for (int g = 0; g < ngr; ++g) {
    bf16x8 nk0, nk1, nk2, nk3, nv0, nv1, nv2, nv3;
    {
      const int gn = (g + 1 < ngr) ? g + 1 : g;
      const int tn = w + 4 * (gn >> 1);
      const int krow0 = ((tn < 4) ? b * 256 + tn * 64 : winbase + (tn - 4) * 64) + (gn & 1) * 32;
      const bf16_t* kp = kbase + (size_t)krow0 * PJ;
      nk0 = *(const bf16x8*)(kp);
      nk1 = *(const bf16x8*)(kp + 32);
      nk2 = *(const bf16x8*)(kp + 4 * PJ);
      nk3 = *(const bf16x8*)(kp + 4 * PJ + 32);
      nv0 = *(const bf16x8*)(vbase + krow0);
      nv1 = *(const bf16x8*)(vbase + (size_t)16 * R_ALL + krow0);
      nv2 = *(const bf16x8*)(vbase + (size_t)32 * R_ALL + krow0);
      nv3 = *(const bf16x8*)(vbase + (size_t)48 * R_ALL + krow0);
    }
    const int t = w + 4 * (g >> 1);
    const int hb = g & 1;
    const bool win = t >= 4;
    const int a = t - 4;
#pragma unroll
    for (int qb = 0; qb < 4; ++qb) {
      if (win && ((qb == 0 && hb == 1) || (qb == 3 && hb == 0))) continue;
      f32x4 sx = f32x4{0.f, 0.f, 0.f, 0.f}, sy = f32x4{0.f, 0.f, 0.f, 0.f};
      sx = MFMA16(kf0, bq[qb][0], sx);
      sx = MFMA16(kf1, bq[qb][1], sx);
      sy = MFMA16(kf2, bq[qb][0], sy);
      sy = MFMA16(kf3, bq[qb][1], sy);
      float s[8];
#pragma unroll
      for (int j = 0; j < 8; ++j) s[j] = (j < 4) ? sx[j & 3] : sy[j & 3];
      if (win) {
        const int c = qb * 16 + l15;
        const int cs = min(max(c - 8, 0), 48);
#pragma unroll
        for (int j = 0; j < 8; ++j) {
          const int kc = hb * 32 + quad * 8 + j;
          const bool valid = (kc >= cs) && (kc < cs + 16);
          const int bi = min(max((rs + a - r + 7) * 31 + (kc - c + 15), 0), 464);
          const float sb = s[j] + rpbs[bi];
          s[j] = valid ? sb : -1e30f;
        }
      }
      float gmax = s[0];
#pragma unroll
      for (int j = 1; j < 8; ++j) gmax = fmaxf(gmax, s[j]);
      float m_ref = m_run[qb];
      if (__any(gmax > m_ref + 4.f)) {
        gmax = fmaxf(gmax, __shfl_xor(gmax, 16));
        gmax = fmaxf(gmax, __shfl_xor(gmax, 32));
        const float m_new = fmaxf(m_ref, gmax);
        const float alpha = __expf(m_ref - m_new);
        l_run[qb] *= alpha;
#pragma unroll
        for (int db = 0; db < 4; ++db)
#pragma unroll
          for (int j = 0; j < 4; ++j) O[qb][db][j] *= alpha;
        m_ref = m_new;
      }
      float ps = 0.f;
      float pv[8];
#pragma unroll
      for (int j = 0; j < 8; ++j) {
        pv[j] = __expf(s[j] - m_ref);
        ps += pv[j];
      }
      const bf16x8 pa = pack8(pv);
      m_run[qb] = m_ref;
      l_run[qb] += ps;
      O[qb][0] = MFMA16(vf0, pa, O[qb][0]);
      O[qb][1] = MFMA16(vf1, pa, O[qb][1]);
      O[qb][2] = MFMA16(vf2, pa, O[qb][2]);
      O[qb][3] = MFMA16(vf3, pa, O[qb][3]);
    }
    kf0 = nk0; kf1 = nk1; kf2 = nk2; kf3 = nk3;
    vf0 = nv0; vf1 = nv1; vf2 = nv2; vf3 = nv3;
  }
#pragma unroll
  for (int qb = 0; qb < 4; ++qb) {
    float lt = l_run[qb];
    lt += __shfl_xor(lt, 16);
    lt += __shfl_xor(lt, 32);
    l_run[qb] = lt;
    if (qb != w) {
      float* ps_ = part + (w * 3 + (qb > w ? qb - 1 : qb)) * 1152;
#pragma unroll
      for (int db = 0; db < 4; ++db)
#pragma unroll
        for (int j = 0; j < 4; ++j) ps_[(db * 4 + j) * 64 + lane] = O[qb][db][j];
      ps_[1024 + lane] = m_run[qb];
      ps_[1088 + lane] = lt;
    }
  }
  __syncthreads();
  float m_own = 0.f, l_own = 0.f;
  f32x4 Oo[4];
#pragma unroll
  for (int qb = 0; qb < 4; ++qb)
    if (qb == w) {
      m_own = m_run[qb];
      l_own = l_run[qb];
#pragma unroll
      for (int db = 0; db < 4; ++db) Oo[db] = O[qb][db];
    }
  float m_tot = m_own;
#pragma unroll
  for (int v = 0; v < 4; ++v) {
    if (v == w) continue;
    const float* ps_ = part + (v * 3 + (w > v ? w - 1 : w)) * 1152;
    m_tot = fmaxf(m_tot, ps_[1024 + lane]);
  }
  {
    const float f = __expf(m_own - m_tot);
    l_own *= f;
#pragma unroll
    for (int db = 0; db < 4; ++db)
#pragma unroll
      for (int j = 0; j < 4; ++j) Oo[db][j] *= f;
  }
#pragma unroll
  for (int v = 0; v < 4; ++v) {
    if (v == w) continue;
    const float* ps_ = part + (v * 3 + (w > v ? w - 1 : w)) * 1152;
    const float f = __expf(ps_[1024 + lane] - m_tot);
    l_own += ps_[1088 + lane] * f;
#pragma unroll
    for (int db = 0; db < 4; ++db)
#pragma unroll
      for (int j = 0; j < 4; ++j) Oo[db][j] += ps_[(db * 4 + j) * 64 + lane] * f;
  }
  bf16_t* obase = dry ? (bf16_t*)(p.ws + WS_END) : proj;
  const size_t omask = dry ? (size_t)0x7FFFFF : ~(size_t)0;
  const float linv = 1.f / l_own;
  const int orow = qrow0 + w * 16 + l15;
#pragma unroll
  for (int db = 0; db < 4; ++db) {
    uint2 o;
    o.x = pack2(Oo[db][0] * linv, Oo[db][1] * linv);
    o.y = pack2(Oo[db][2] * linv, Oo[db][3] * linv);
    *(uint2*)(obase + (((size_t)orow * PJ + PC_NQ + h * 64 + db * 16 + quad * 4) & omask)) = o;
  }
}

struct S5Frag {
  bf16x8 bf[8];
  bf16x8 cf[4];
  float ar, ai;
};

__device__ __forceinline__ void s5_load_frag(const Params& p, S5Frag& f, int ldg, bool need_c) {
  const int lane = opaque_tid() & 63, l15 = lane & 15, quad = lane >> 4;
  const bf16_t* bbt = (const bf16_t*)(p.ws + OFF_S5BB) + (size_t)ldg * 2048;
  const bf16_t* cm = (const bf16_t*)(p.ws + OFF_S5CM) + (size_t)ldg * 2048;
  const float* ab = (const float*)(p.ws + OFF_S5AB) + (size_t)ldg * 128;
  const bf16x8 z = {0, 0, 0, 0, 0, 0, 0, 0};
#pragma unroll
  for (int pb = 0; pb < 8; ++pb)
    f.bf[pb] = (quad < 2) ? *(const bf16x8*)(bbt + (pb * 16 + l15) * 16 + quad * 8) : z;
  if (need_c) {
#pragma unroll
    for (int ks = 0; ks < 4; ++ks) f.cf[ks] = *(const bf16x8*)(cm + l15 * 128 + ks * 32 + quad * 8);
  }
  f.ar = ab[lane * 2];
  f.ai = ab[lane * 2 + 1];
}

template <int DIR>
__device__ __forceinline__ int s5_row(int b, int s0, int l15) {
  const int s = s0 + l15;
  if (s0 < 256) {
    const int j = DIR ? 255 - s : s;
    return b * 256 + j;
  }
  const int t = s - 256;
  const int tt = DIR ? 2047 - t : t;
  return R_CTX + b * 2048 + tt;
}

template <int DIR, bool WRITE>
__device__ __forceinline__ void s5_chunk(const bf16_t* __restrict__ proj, int b, int g, int cseq,
                                         const S5Frag& f, float& xr, float& xi, float* BUs, bf16_t* Xs,
                                         f32x4 (&yacc)[8]) {
  const int lane = opaque_tid() & 63, l15 = lane & 15, quad = lane >> 4;
  const bf16x8 z = {0, 0, 0, 0, 0, 0, 0, 0};
  const bf16_t* ub = proj + PC_U + g * 16 + (quad & 1) * 8;
  bf16x8 ucur = *(const bf16x8*)(ub + (size_t)s5_row<DIR>(b, cseq * 128, l15) * PJ);
#pragma unroll 1
  for (int sbs = 0; sbs < 8; ++sbs) {
    const int sn = cseq * 128 + ((sbs < 7) ? sbs + 1 : sbs) * 16;
    const bf16x8 unext = *(const bf16x8*)(ub + (size_t)s5_row<DIR>(b, sn, l15) * PJ);
    const bf16x8 uf = (quad < 2) ? ucur : z;
    __builtin_amdgcn_wave_barrier();
#pragma unroll
    for (int pb = 0; pb < 8; ++pb) {
      f32x4 bu = f32x4{0.f, 0.f, 0.f, 0.f};
      bu = MFMA16(uf, f.bf[pb], bu);
#pragma unroll
      for (int j = 0; j < 4; ++j) BUs[(quad * 4 + j) * 132 + pb * 16 + l15] = bu[j];
    }
    __builtin_amdgcn_wave_barrier();
    float2 bbv[16];
#pragma unroll
    for (int t = 0; t < 16; ++t) bbv[t] = *(const float2*)(BUs + t * 132 + 2 * lane);
#pragma unroll
    for (int t = 0; t < 16; ++t) {
      const float2 bb = bbv[t];
      const float nr = f.ar * xr - f.ai * xi + bb.x;
      const float ni = f.ar * xi + f.ai * xr + bb.y;
      xr = nr;
      xi = ni;
      if (WRITE) {
        const int rt = DIR ? 15 - t : t;
        *(unsigned*)(Xs + rt * 144 + 2 * lane) = pack2(xr, xi);
      }
    }
    if (WRITE) {
      __builtin_amdgcn_wave_barrier();
      const int tsb = DIR ? 7 - sbs : sbs;
      f32x4 yt = f32x4{0.f, 0.f, 0.f, 0.f};
#pragma unroll
      for (int ks = 0; ks < 4; ++ks) {
        const bf16x8 xa = *(const bf16x8*)(Xs + l15 * 144 + ks * 32 + quad * 8);
        yt = MFMA16(xa, f.cf[ks], yt);
      }
#pragma unroll
      for (int i = 0; i < 8; ++i)
        if (i == tsb) yacc[i] += yt;
    }
    ucur = unext;
  }
}

__device__ __forceinline__ void s5_item(const Params& p, int l, int b, int g, bool last, unsigned char* smem) {
  TIDVARS
  float* bound = (float*)smem;
  float* BUs = (float*)(smem + 18432 + w * 13056);
  bf16_t* Xs = (bf16_t*)(smem + 18432 + w * 13056 + 8448);
  const bf16_t* proj = (const bf16_t*)(p.ws + OFF_PROJ);
  bf16_t* G = (bf16_t*)(p.ws + OFF_G);
  f32x4 yacc[8];
  {
    const bf16_t* uT = (const bf16_t*)(p.ws + OFF_UT);
    bf16_t* tabs = (bf16_t*)(smem + 18432);
#pragma unroll 1
    for (int dir = 0; dir < 2; ++dir) {
      const int ldg = (l * 2 + dir) * 32 + g;
      __syncthreads();
      {
        const bf16_t* vt = (const bf16_t*)(p.ws + OFF_S5V) + (size_t)ldg * 16384;
#pragma unroll
        for (int i = 0; i < 8; ++i) {
          const int id = tid + i * 256, row = id >> 4, cc = id & 15;
          *(uint4*)(tabs + row * 144 + cc * 8) = *(const uint4*)(vt + row * 128 + cc * 8);
        }
      }
      float bre[4][4], bim[4][4];
      {
        const bf16_t* bbt = (const bf16_t*)(p.ws + OFF_S5BB) + (size_t)ldg * 2048;
#pragma unroll
        for (int nb = 0; nb < 4; ++nb) {
          const int ps = nb * 16 + l15;
          const uint2 r2 = *(const uint2*)(bbt + (2 * ps) * 16 + quad * 4);
          const uint2 i2 = *(const uint2*)(bbt + (2 * ps + 1) * 16 + quad * 4);
          bre[nb][0] = __uint_as_float(r2.x << 16); bre[nb][1] = __uint_as_float(r2.x & 0xffff0000u);
          bre[nb][2] = __uint_as_float(r2.y << 16); bre[nb][3] = __uint_as_float(r2.y & 0xffff0000u);
          bim[nb][0] = __uint_as_float(i2.x << 16); bim[nb][1] = __uint_as_float(i2.x & 0xffff0000u);
          bim[nb][2] = __uint_as_float(i2.y << 16); bim[nb][3] = __uint_as_float(i2.y & 0xffff0000u);
        }
      }
      __syncthreads();
#pragma unroll 1
      for (int c = w; c < 17; c += 4) {
        int rowbase;
        if (dir == 0) rowbase = (c < 2) ? b * 256 + 128 * c : R_CTX + b * 2048 + (c - 2) * 128;
        else rowbase = (c < 2) ? b * 256 + 128 * (1 - c) : R_CTX + b * 2048 + 128 * (17 - c);
        bf16x8 ua[4];
#pragma unroll
        for (int ks = 0; ks < 4; ++ks)
          ua[ks] = *(const bf16x8*)(uT + (size_t)(g * 16 + l15) * R_ALL + rowbase + ks * 32 + quad * 8);
        f32x4 z[8];
#pragma unroll
        for (int nb = 0; nb < 8; ++nb) {
          z[nb] = f32x4{0.f, 0.f, 0.f, 0.f};
#pragma unroll
          for (int ks = 0; ks < 4; ++ks) {
            const bf16x8 wf = *(const bf16x8*)(tabs + (nb * 16 + l15) * 144 + ks * 32 + quad * 8);
            z[nb] = MFMA16(ua[ks], wf, z[nb]);
          }
        }
#pragma unroll
        for (int nb = 0; nb < 4; ++nb) {
          float er = 0.f, ei = 0.f;
#pragma unroll
          for (int j = 0; j < 4; ++j) {
            er += bre[nb][j] * z[nb][j] - bim[nb][j] * z[nb + 4][j];
            ei += bre[nb][j] * z[nb + 4][j] + bim[nb][j] * z[nb][j];
          }
          er += __shfl_xor(er, 16);
          er += __shfl_xor(er, 32);
          ei += __shfl_xor(ei, 16);
          ei += __shfl_xor(ei, 32);
          if (quad == 0) {
            bound[(dir * 18 + c + 1) * 128 + nb * 16 + l15] = er;
            bound[(dir * 18 + c + 1) * 128 + 64 + nb * 16 + l15] = ei;
          }
        }
      }
    }
  }
  __syncthreads();
  if (tid < 128) {
    const int d = tid >> 6, pp = tid & 63;
    const float* at = (const float*)(p.ws + OFF_S5AT) + (size_t)((l * 2 + d) * 32 + g) * 128;
    const float tr = at[pp * 2], ti = at[pp * 2 + 1];
    float xr = 0.f, xi = 0.f;
    bound[(d * 18) * 128 + pp] = 0.f;
    bound[(d * 18) * 128 + 64 + pp] = 0.f;
    for (int c = 1; c < 18; ++c) {
      const float er = bound[(d * 18 + c) * 128 + pp], ei = bound[(d * 18 + c) * 128 + 64 + pp];
      const float nr = tr * xr - ti * xi + er;
      const float ni = tr * xi + ti * xr + ei;
      xr = nr;
      xi = ni;
      bound[(d * 18 + c) * 128 + pp] = xr;
      bound[(d * 18 + c) * 128 + 64 + pp] = xi;
    }
  }
  __syncthreads();
  const float dsk = p.s5_d[l * 512 + g * 16 + l15];
  for (int tc = (last ? 2 : 0) + w; tc < 18; tc += 4) {
#pragma unroll
    for (int i = 0; i < 8; ++i) yacc[i] = f32x4{0.f, 0.f, 0.f, 0.f};
    {
      S5Frag f;
      s5_load_frag(p, f, (l * 2 + 0) * 32 + g, true);
      const int cseq = tc;
      float xr = bound[(0 * 18 + cseq) * 128 + lane], xi = bound[(0 * 18 + cseq) * 128 + 64 + lane];
      s5_chunk<0, true>(proj, b, g, cseq, f, xr, xi, BUs, Xs, yacc);
    }
    {
      S5Frag f;
      s5_load_frag(p, f, (l * 2 + 1) * 32 + g, true);
      const int cseq = (tc < 2) ? 1 - tc : 19 - tc;
      float xr = bound[(1 * 18 + cseq) * 128 + lane], xi = bound[(1 * 18 + cseq) * 128 + 64 + lane];
      s5_chunk<1, true>(proj, b, g, cseq, f, xr, xi, BUs, Xs, yacc);
    }
    const int rowbase = (tc < 2) ? b * 256 + tc * 128 : R_CTX + b * 2048 + (tc - 2) * 128;
#pragma unroll
    for (int tsb = 0; tsb < 8; ++tsb)
#pragma unroll
      for (int j = 0; j < 4; ++j) {
        const int row = rowbase + tsb * 16 + quad * 4 + j;
        const float uu = bf2f(proj[(size_t)row * PJ + PC_U + g * 16 + l15]);
        const float y = yacc[tsb][j] + dsk * uu;
        const float zz = 0.7978845608028654f * (y + 0.044715f * y * y * y);
        const float gl = y / (1.f + __expf(-2.f * zz));
        G[(size_t)row * 512 + g * 16 + l15] = f2bf(gl);
      }
  }
}

#define EPI_LOOP(NI_)                                                        \
  _Pragma("unroll") for (int mi = 0; mi < 4; ++mi)                           \
  _Pragma("unroll") for (int ni = 0; ni < NI_; ++ni)                         \
  _Pragma("unroll") for (int j = 0; j < 4; ++j)

__global__ void __launch_bounds__(256, 2) fwd_megakernel(Params p) {
  cg::grid_group grid = cg::this_grid();
  __shared__ __attribute__((aligned(16))) unsigned char smem[SMEM_BYTES];
  __shared__ int s_item;
  __shared__ uint4 xb_words;
  if (threadIdx.x == 0) xb_words = make_uint4(0u, 0u, 0u, 0u);
  __syncthreads();
  const XcdBarrier xb = xcd_barrier_post((unsigned*)(p.ws + OFF_BAR), (volatile LAS unsigned*)&xb_words);
  const int nblk = gridDim.x, bid = blockIdx.x;
  const int lbid = bid;
#define sA ((bf16_t*)smem)
#define sB (((bf16_t*)smem) + 128 * 72)
#define W ((const bf16_t*)(p.ws + OFF_W))
#define hbuf ((bf16_t*)(p.ws + OFF_H))
#define Gbuf ((bf16_t*)(p.ws + OFF_G))
#define proj ((bf16_t*)(p.ws + OFF_PROJ))
#define mbuf ((bf16_t*)(p.ws + OFF_VT))
#define hid ((bf16_t*)(p.ws + OFF_PROJ))
#define ctxs ((float*)(p.ws + OFF_CTXS))
#define modp ((const float*)(p.ws + OFF_MOD))
#define cnt ((int*)(p.ws + OFF_CNT))

#pragma unroll 1
  for (int rep = 0, nrep = REPS61; rep < nrep; ++rep) {
    TIDVARS
    for (int i = (tid < 2 ? bid * 2 + tid : 1024); i < 1024; i += nblk * 2) {
      const int coord = i >> 4, fi = i & 15;
      const float inv = powf(10000.f, -(float)fi / 16.f);
      const float ang = (float)coord * inv;
      float* rot = (float*)(p.ws + OFF_ROT);
      rot[i] = cosf(ang);
      rot[1024 + i] = sinf(ang);
    }
    for (int i = (tid < 16 ? bid * 16 + tid : 8192); i < 8192; i += nblk * 16) s5_tables(p, i);
    for (int it = bid; it < 192; it += nblk) mod_item(p, it, (float*)smem);
    wconv_range(p, 0, (bid + 320) % nblk, nblk, 4480, (float*)smem);
    if (p.fnorm == nullptr) grid.sync();
    xcd_barrier(xb);
  }

  for (int l = 0; l < 2; ++l) {
    const bool last = (l == 1);
    const float* src_ctx = (l == 0) ? p.ctx : ctxs;
    const float* src_x = (l == 0) ? p.x : p.out;
    const int mt_min = last ? 16 : 0;

#pragma unroll 1
    for (int rep = 0, nrep = REPS62; rep < nrep; ++rep) {
      TIDVARS
      const int nnorm = R_ALL / 8;
      for (int it = bid; it < nnorm; it += nblk) norm_rows(p, l, 0, it * 8 + w, src_ctx, src_x);
      if (last) wconv_range(p, 1, bid, nblk, 4480, (float*)smem);
      xcd_barrier(xb);
    }

#pragma unroll 1
    for (int rep = 0, nrep = REPS(1); rep < nrep; ++rep) {
      for (int tile = lbid; tile < 72 * 28; tile += nblk) {
        const int mt = tile / 28, nt = tile % 28;
        if (last && mt < 8 && nt >= 18) continue;
        inproj_tile(p, mt, nt, (bf16_t*)smem);
      }
      xcd_barrier(xb);
    }

#pragma unroll 1
    for (int rep = 0, nrep = (PROBE >= 21 && PROBE <= 23) ? (1 + (int)(p.fnorm != nullptr)) : REPS(2); rep < nrep; ++rep) {
      TIDVARS
      const bool dry = rep > 0;
      const int n_s5 = 256;
      const int n_ret = 512 + (last ? 0 : 64);
      const int n_na = 2048 + (last ? 0 : 256);
      const int total = n_s5 + n_ret + n_na;
      while (true) {
        __syncthreads();
        if (tid == 0) s_item = atomicAdd(&cnt[l + 2 * rep], 1);
        __syncthreads();
        int it = s_item;
#if PROBE == 21
        if (rep > 0 && it >= n_s5) break;
#elif PROBE == 22
        if (rep > 0) { it += n_s5; if (it >= n_s5 + n_ret) break; }
#elif PROBE == 23
        if (rep > 0) it += n_s5 + n_ret;
#endif
        if (it >= total) break;
        if (it < n_s5) {
          __builtin_amdgcn_s_setprio(3);
          s5_item(p, l, it >> 5, it & 31, last, smem);
          __builtin_amdgcn_s_setprio(0);
        } else if (it < n_s5 + n_ret) {
          it -= n_s5;
          const bool ic = it >= 512;
          const int i2 = it - 512;
          ret_item(p, l, ic ? (i2 >> 3) : (it >> 6), ic ? ((i2 >> 1) & 3) : ((it >> 4) & 3), ic ? (i2 & 1) : (it & 15), ic, dry, smem);
        } else {
          it -= n_s5 + n_ret;
          const bool ic = it >= 2048;
          const int i2 = it - 2048;
          na_item(p, l, ic ? (i2 >> 5) : (it >> 8), ic ? ((i2 >> 2) & 7) : ((it >> 5) & 7), ic ? (i2 & 3) : (it & 31), ic, dry, smem);
        }
      }
      xcd_barrier(xb);
    }

#pragma unroll 1
    for (int rep = 0, nrep = REPS(5); rep < nrep; ++rep) {
      for (int tile = lbid + mt_min * 4; tile < 144 * 4; tile += nblk) {
        const int mt = tile >> 2, nt = tile & 3;
        f32x4 acc[4][4];
        zero_acc<4>(acc);
        gemm_core_v1<4, true>(acc, Gbuf + (size_t)mt * 128 * 512, 512, W + W_GLU + (size_t)nt * 128 * 512, 512, 512, (bf16_t*)smem);
        TIDVARS
        float4 bgl[4];
#pragma unroll
        for (int ni = 0; ni < 4; ++ni) bgl[ni] = *(const float4*)(p.b_glu + l * 512 + nt * 128 + wn * 64 + ni * 16 + quad * 4);
#pragma unroll
        for (int mi = 0; mi < 4; ++mi) {
          const int r = mt * 128 + wm * 64 + mi * 16 + l15;
          uint2 gg[4];
#pragma unroll
          for (int ni = 0; ni < 4; ++ni) gg[ni] = *(const uint2*)(Gbuf + (size_t)r * 512 + nt * 128 + wn * 64 + ni * 16 + quad * 4);
#pragma unroll
          for (int ni = 0; ni < 4; ++ni) {
            const int c = nt * 128 + wn * 64 + ni * 16 + quad * 4;
            const float g0 = __uint_as_float(gg[ni].x << 16), g1 = __uint_as_float(gg[ni].x & 0xffff0000u);
            const float g2 = __uint_as_float(gg[ni].y << 16), g3 = __uint_as_float(gg[ni].y & 0xffff0000u);
            uint2 o;
            o.x = pack2(g0 * sigm(acc[mi][ni][0] + bgl[ni].x), g1 * sigm(acc[mi][ni][1] + bgl[ni].y));
            o.y = pack2(g2 * sigm(acc[mi][ni][2] + bgl[ni].z), g3 * sigm(acc[mi][ni][3] + bgl[ni].w));
            *(uint2*)(proj + (size_t)r * PJ + PC_U + c) = o;
          }
        }
      }
      xcd_barrier(xb);
    }

#pragma unroll 1
    for (int rep = 0, nrep = REPS(3); rep < nrep; ++rep) {
      for (int tile = lbid + mt_min * 16; tile < 144 * 16; tile += nblk) {
        const int mt = tile >> 4, nt = tile & 15;
        f32x4 sg[3][4][2];
#pragma unroll
        for (int g = 0; g < 3; ++g) zero_acc<2>(sg[g]);
        gemm_core_g3(sg, hbuf + (size_t)mt * 128 * 1024, 1024, W + W_IN + (size_t)(3584 + nt * 64) * 1024,
                     (size_t)1024 * 1024, 1024, 1024, (bf16_t*)smem);
        unsigned sgp[3][4][2][2];
#pragma unroll
        for (int g = 0; g < 3; ++g)
#pragma unroll
          for (int mi = 0; mi < 4; ++mi)
#pragma unroll
            for (int ni = 0; ni < 2; ++ni) {
              sgp[g][mi][ni][0] = pack2(sigm(sg[g][mi][ni][0]), sigm(sg[g][mi][ni][1]));
              sgp[g][mi][ni][1] = pack2(sigm(sg[g][mi][ni][2]), sigm(sg[g][mi][ni][3]));
            }
        f32x4 tot[4][2];
        zero_acc<2>(tot);
#pragma unroll 1
        for (int i = 0; i < 3; ++i) {
          f32x4 ab[4][2];
          zero_acc<2>(ab);
          const bf16_t* Ai = proj + (size_t)mt * 128 * PJ + (i == 0 ? PC_U : (i == 1 ? PC_RG : PC_NQ));
          const bf16_t* Wi = W + (i == 0 ? W_BS5 : (i == 1 ? W_BRET : W_BNA)) + (size_t)nt * 64 * 512;
          gemm_core_v1<2, true>(ab, Ai, PJ, Wi, 512, 512, (bf16_t*)smem);
#pragma unroll
          for (int mi = 0; mi < 4; ++mi)
#pragma unroll
            for (int ni = 0; ni < 2; ++ni) {
              const unsigned u0 = sgp[0][mi][ni][0], u1 = sgp[0][mi][ni][1];
              tot[mi][ni][0] += __uint_as_float(u0 << 16) * ab[mi][ni][0];
              tot[mi][ni][1] += __uint_as_float(u0 & 0xffff0000u) * ab[mi][ni][1];
              tot[mi][ni][2] += __uint_as_float(u1 << 16) * ab[mi][ni][2];
              tot[mi][ni][3] += __uint_as_float(u1 & 0xffff0000u) * ab[mi][ni][3];
              sgp[0][mi][ni][0] = sgp[1][mi][ni][0];
              sgp[0][mi][ni][1] = sgp[1][mi][ni][1];
              sgp[1][mi][ni][0] = sgp[2][mi][ni][0];
              sgp[1][mi][ni][1] = sgp[2][mi][ni][1];
            }
        }
        TIDVARS
#pragma unroll
        for (int mi = 0; mi < 4; ++mi)
#pragma unroll
          for (int ni = 0; ni < 2; ++ni) {
            const int r = mt * 128 + wm * 64 + mi * 16 + l15;
            const int c = nt * 64 + wn * 32 + ni * 16 + quad * 4;
            uint2 o;
            o.x = pack2(tot[mi][ni][0], tot[mi][ni][1]);
            o.y = pack2(tot[mi][ni][2], tot[mi][ni][3]);
            *(uint2*)(mbuf + (size_t)r * 1024 + c) = o;
          }
      }
      xcd_barrier(xb);
    }

#pragma unroll 1
    for (int rep = 0, nrep = REPS(5); rep < nrep; ++rep) {
      const bool dry = rep > 0;
      float* dctx = dry ? (float*)(p.ws + WS_END) : ctxs;
      float* dx = dry ? (float*)(p.ws + WS_END) : p.out;
      const size_t omask = dry ? (size_t)0x7FFFFF : ~(size_t)0;
      if (last && !dry) {
        for (int tile = lbid + 64; tile < 72 * 8; tile += nblk)
          resid_big_tile(p, l, tile >> 3, tile & 7, mbuf, 1024, W + W_OUT, 1024, 1024, 2048, src_x, p.out, (bf16_t*)smem);
      } else
      for (int tile = lbid + mt_min * 8; tile < 144 * 8; tile += nblk) {
        const int mt = tile >> 3, nt = tile & 7;
        f32x4 acc[4][4];
        zero_acc<4>(acc);
        gemm_core_v1<4, true>(acc, mbuf + (size_t)mt * 128 * 1024, 1024, W + W_OUT + (size_t)nt * 128 * 1024, 1024, 1024, (bf16_t*)smem);
        TIDVARS
        const bool isc = mt < 16;
        const int modrow = isc ? 8 : (mt - 16) >> 4;
        const float* sbase = isc ? src_ctx : src_x;
        float* dbase = isc ? dctx : dx;
        float4 gv[4];
#pragma unroll
        for (int ni = 0; ni < 4; ++ni)
          gv[ni] = *(const float4*)(modp + (size_t)(l * 9 + modrow) * 6144 + 2048 + nt * 128 + wn * 64 + ni * 16 + quad * 4);
#pragma unroll
        for (int mi = 0; mi < 4; ++mi) {
          const int r = mt * 128 + wm * 64 + mi * 16 + l15;
          const size_t o = (size_t)(isc ? r : r - R_CTX) * 1024 + nt * 128 + wn * 64 + quad * 4;
          float4 sv[4];
#pragma unroll
          for (int ni = 0; ni < 4; ++ni) sv[ni] = *(const float4*)(sbase + o + ni * 16);
#pragma unroll
          for (int ni = 0; ni < 4; ++ni) {
            float4 ov;
            ov.x = sv[ni].x + gv[ni].x * acc[mi][ni][0];
            ov.y = sv[ni].y + gv[ni].y * acc[mi][ni][1];
            ov.z = sv[ni].z + gv[ni].z * acc[mi][ni][2];
            ov.w = sv[ni].w + gv[ni].w * acc[mi][ni][3];
            *(float4*)(dbase + ((o + ni * 16) & omask)) = ov;
          }
        }
      }
      xcd_barrier(xb);
    }

#pragma unroll 1
    for (int rep = 0, nrep = REPS63; rep < nrep; ++rep) {
      for (int it = bid + mt_min * 16; it < R_ALL / 8; it += nblk) {
        TIDVARS
        norm_rows(p, l, 1, it * 8 + w, ctxs, p.out);
      }
      xcd_barrier(xb);
    }

#pragma unroll 1
    for (int rep = 0, nrep = REPS(4); rep < nrep; ++rep) {
      for (int tile = lbid + (mt_min >> 1) * 44; tile < 72 * 44; tile += nblk) {
        const int mt = tile / 44, nt = tile % 44;
        f32x4 acc[8][4];
#pragma unroll
        for (int mi = 0; mi < 8; ++mi)
#pragma unroll
          for (int ni = 0; ni < 4; ++ni) acc[mi][ni] = f32x4{0.f, 0.f, 0.f, 0.f};
        gemm_core_big<true>(acc, hbuf + (size_t)mt * 256 * 1024, 1024, W + W_FG + (size_t)nt * 128 * 1024, 1024, 1024, (bf16_t*)smem);
        TIDVARS
#pragma unroll
        for (int mi = 0; mi < 8; ++mi)
#pragma unroll
          for (int ni = 0; ni < 2; ++ni) {
            const int r = mt * 256 + wm * 128 + mi * 16 + l15;
            const int c = nt * 64 + wn * 32 + ni * 16 + quad * 4;
            uint2 o;
            o.x = pack2(siluf_(acc[mi][ni][0]) * acc[mi][ni + 2][0], siluf_(acc[mi][ni][1]) * acc[mi][ni + 2][1]);
            o.y = pack2(siluf_(acc[mi][ni][2]) * acc[mi][ni + 2][2], siluf_(acc[mi][ni][3]) * acc[mi][ni + 2][3]);
            *(uint2*)(hid + (size_t)r * FFN + c) = o;
          }
      }
      xcd_barrier(xb);
    }

#pragma unroll 1
    for (int rep = 0, nrep = REPS(5); rep < nrep; ++rep) {
      const bool dry = rep > 0;
      float* dctx = dry ? (float*)(p.ws + WS_END) : ctxs;
      float* dx = dry ? (float*)(p.ws + WS_END) : p.out;
      const size_t omask = dry ? (size_t)0x7FFFFF : ~(size_t)0;
      if (last && !dry) {
        for (int tile = lbid + 64; tile < 72 * 8; tile += nblk)
          resid_big_tile(p, l, tile >> 3, tile & 7, hid, FFN, W + W_FD, FFN, FFN, 5120, p.out, p.out, (bf16_t*)smem);
      } else
      for (int tile = lbid + mt_min * 8; tile < 144 * 8; tile += nblk) {
        const int mt = tile >> 3, nt = tile & 7;
        f32x4 acc[4][4];
        zero_acc<4>(acc);
        gemm_core_v1<4, true>(acc, hid + (size_t)mt * 128 * FFN, FFN, W + W_FD + (size_t)nt * 128 * FFN, FFN, FFN, (bf16_t*)smem);
        TIDVARS
        const bool isc = mt < 16;
        const int modrow = isc ? 8 : (mt - 16) >> 4;
        const float* sbase = isc ? (const float*)ctxs : (const float*)p.out;
        float* dbase = isc ? dctx : dx;
        float4 gv[4];
#pragma unroll
        for (int ni = 0; ni < 4; ++ni)
          gv[ni] = *(const float4*)(modp + (size_t)(l * 9 + modrow) * 6144 + 5120 + nt * 128 + wn * 64 + ni * 16 + quad * 4);
#pragma unroll
        for (int mi = 0; mi < 4; ++mi) {
          const int r = mt * 128 + wm * 64 + mi * 16 + l15;
          const size_t o = (size_t)(isc ? r : r - R_CTX) * 1024 + nt * 128 + wn * 64 + quad * 4;
          float4 sv[4];
#pragma unroll
          for (int ni = 0; ni < 4; ++ni) sv[ni] = *(const float4*)(sbase + o + ni * 16);
#pragma unroll
          for (int ni = 0; ni < 4; ++ni) {
            float4 ov;
            ov.x = sv[ni].x + gv[ni].x * acc[mi][ni][0];
            ov.y = sv[ni].y + gv[ni].y * acc[mi][ni][1];
            ov.z = sv[ni].z + gv[ni].z * acc[mi][ni][2];
            ov.w = sv[ni].w + gv[ni].w * acc[mi][ni][3];
            *(float4*)(dbase + ((o + ni * 16) & omask)) = ov;
          }
        }
      }
      xcd_barrier(xb);
    }
#if PROBE == 7
    for (int i = 0; i < 10; ++i) xcd_barrier(xb);
#endif
  }

  for (int it = bid; it < (NB * SEQ) / 4; it += nblk) {
    TIDVARS
    const int r = it * 4 + w;
    float* row = p.out + (size_t)r * 1024;
    float4 v[4];
    float ss = 0.f;
#pragma unroll
    for (int i = 0; i < 4; ++i) {
      v[i] = *(const float4*)(row + i * 256 + lane * 4);
      ss += v[i].x * v[i].x + v[i].y * v[i].y + v[i].z * v[i].z + v[i].w * v[i].w;
    }
    ss = wave_sum(ss);
    const float rstd = rsqrtf(ss * (1.f / 1024.f) + 1e-6f);
#pragma unroll
    for (int i = 0; i < 4; ++i) {
      const float4 fn = *(const float4*)(p.fnorm + i * 256 + lane * 4);
      float4 o;
      o.x = v[i].x * rstd * fn.x;
      o.y = v[i].y * rstd * fn.y;
      o.z = v[i].z * rstd * fn.z;
      o.w = v[i].w * rstd * fn.w;
      *(float4*)(row + i * 256 + lane * 4) = o;
    }
  }
}

extern "C" void kernel_launch(void* const* d_in, const int* in_sizes, int n_in, void* d_out, int out_size,
                              void* d_ws, size_t ws_size, hipStream_t stream) {
  static int grid_blocks = 0;
  if (!grid_blocks) {
    int dev = 0, cus = 0, per_cu = 0;
    hipGetDevice(&dev);
    hipDeviceGetAttribute(&cus, hipDeviceAttributeMultiprocessorCount, dev);
    hipOccupancyMaxActiveBlocksPerMultiprocessor(&per_cu, fwd_megakernel, 256, 0);
    if (per_cu > 2) per_cu = 2;
    if (per_cu < 1) per_cu = 1;
    grid_blocks = cus * per_cu;
  }
  if (ws_size < WS_END) fprintf(stderr, "workspace too small: %zu < %zu\n", ws_size, (size_t)WS_END);
  Params p{};
  const float** pp = (const float**)&p;
  for (int i = 0; i < 27; ++i) pp[i] = (const float*)d_in[i];
  p.out = (float*)d_out;
  p.ws = (unsigned char*)d_ws;
  hipMemsetAsync((unsigned char*)d_ws + OFF_CNT, 0, 256 + 16384, stream);
  void* args[] = {&p};
  hipError_t e = hipLaunchCooperativeKernel((void*)fwd_megakernel, dim3(grid_blocks), dim3(256), args, 0, stream);
  if (e != hipSuccess) fprintf(stderr, "cooperative launch failed: %s (grid %d)\n", hipGetErrorString(e), grid_blocks);
}
```
